# Optimizing an MI355X kernel written in HIP

```python
import jax, jax.numpy as jnp
from jax import lax
import numpy as np

D_MODEL = 2048
BATCH = 1
SEQ = 16384
DEPTH = 1

HEAD_DIM = 128
N_HEADS_A = D_MODEL // 256
N_KV_A = max(1, N_HEADS_A // 4)
N_HEADS_B = D_MODEL // 256
GRID_W = 64
NA_ROWS = 8
NA_COLS = 16
Q_BLOCK = 128
ROPE_THETA = 10000.0
ROPE_AXIS_DIM = HEAD_DIM // 2
D_FF = -(-(8 * D_MODEL) // (3 * 256)) * 256
NORM_EPS = 1e-6
IN_SPLITS = (
    N_HEADS_A * HEAD_DIM,
    N_KV_A * HEAD_DIM,
    N_KV_A * HEAD_DIM,
    N_HEADS_B * HEAD_DIM,
    N_HEADS_B * HEAD_DIM,
    N_HEADS_B * HEAD_DIM,
    D_MODEL,
    D_MODEL,
)
D_IN = sum(IN_SPLITS)

kernel_name = "hybrid_gqa_natten_gated_encoder_block"


def rms_norm(x, w):
    xf = x.astype(jnp.float32)
    y = xf * lax.rsqrt(jnp.mean(xf * xf, axis=-1, keepdims=True) + NORM_EPS)
    return (y * w.astype(jnp.float32)).astype(x.dtype)


def axial_rope_tables(S):
    t = jnp.arange(S, dtype=jnp.int32)
    row = (t // GRID_W).astype(jnp.float32)
    col = (t % GRID_W).astype(jnp.float32)
    inv = ROPE_THETA ** (-jnp.arange(0, ROPE_AXIS_DIM, 2, dtype=jnp.float32) / ROPE_AXIS_DIM)
    ang = jnp.concatenate([row[:, None] * inv[None], col[:, None] * inv[None]], axis=-1)
    return jnp.cos(ang), jnp.sin(ang)


def apply_rope(x, cos, sin):
    xf = x.astype(jnp.float32).reshape(*x.shape[:-1], HEAD_DIM // 2, 2)
    x0, x1 = xf[..., 0], xf[..., 1]
    c = cos[None, :, None, :]
    s = sin[None, :, None, :]
    out = jnp.stack([x0 * c - x1 * s, x0 * s + x1 * c], axis=-1)
    return out.reshape(x.shape).astype(x.dtype)


def global_gqa(q, k, v):
    B, S, HQ, hd = q.shape
    KVH = k.shape[2]
    G = HQ // KVH
    nb = S // Q_BLOCK
    scale = hd ** -0.5
    qb = q.reshape(B, nb, Q_BLOCK, KVH, G, hd).transpose(1, 0, 2, 3, 4, 5)

    def one_block(qblk):
        s = jnp.einsum('bqkgd,bskd->bkgqs', qblk, k).astype(jnp.float32) * scale
        p = jax.nn.softmax(s, axis=-1).astype(v.dtype)
        return jnp.einsum('bkgqs,bskd->bqkgd', p, v)

    o = lax.map(one_block, qb)
    return o.transpose(1, 0, 2, 3, 4, 5).reshape(B, S, HQ * hd)


def neighbourhood_attention(q, k, v, rpb):
    B, S, H, hd = q.shape
    rows = S // GRID_W
    kr = min(NA_ROWS, rows)
    nk = kr * NA_COLS
    nb = S // Q_BLOCK
    scale = hd ** -0.5
    t = jnp.arange(S, dtype=jnp.int32)
    r = t // GRID_W
    col = t % GRID_W
    rs = jnp.clip(r - kr // 2, 0, rows - kr)
    cs = jnp.clip(col - NA_COLS // 2, 0, GRID_W - NA_COLS)
    key_r = rs[:, None, None] + jnp.arange(kr, dtype=jnp.int32)[None, :, None]
    key_c = cs[:, None, None] + jnp.arange(NA_COLS, dtype=jnp.int32)[None, None, :]
    shape3 = (S, kr, NA_COLS)
    idx = (key_r * GRID_W + key_c).reshape(nb, Q_BLOCK, nk)
    rel_r = jnp.broadcast_to(key_r - r[:, None, None] + (NA_ROWS - 1), shape3).reshape(nb, Q_BLOCK, nk)
    rel_c = jnp.broadcast_to(key_c - col[:, None, None] + (NA_COLS - 1), shape3).reshape(nb, Q_BLOCK, nk)
    qb = q.reshape(B, nb, Q_BLOCK, H, hd).transpose(1, 0, 2, 3, 4)

    def one_block(args):
        qblk, ib, rr, rc = args
        kb = k[:, ib]
        vb = v[:, ib]
        bias = rpb[:, rr, rc].astype(jnp.float32)
        s = jnp.einsum('bqhd,bqnhd->bhqn', qblk, kb).astype(jnp.float32) * scale + bias[None]
        p = jax.nn.softmax(s, axis=-1).astype(v.dtype)
        return jnp.einsum('bhqn,bqnhd->bqhd', p, vb)

    o = lax.map(one_block, (qb, idx, rel_r, rel_c))
    return o.transpose(1, 0, 2, 3, 4).reshape(B, S, H * hd)


def setup_inputs(seed: int = 0) -> dict:
    key = jax.random.key(seed)
    ks = jax.random.split(key, 20)
    f32 = jnp.float32
    D = D_MODEL

    def w(k, shape, fan_in):
        return jax.random.normal(k, shape, f32) * (fan_in ** -0.5)

    def gain(k, shape):
        return 1.0 + 0.05 * jax.random.normal(k, shape, f32)

    return {
        "x": jax.random.normal(ks[0], (BATCH, SEQ, D), f32),
        "c": jax.random.normal(ks[1], (BATCH, D), f32),
        "w_ada": w(ks[2], (DEPTH, D, 6 * D), D) * 0.5,
        "b_ada": 0.02 * jax.random.normal(ks[3], (DEPTH, 6 * D), f32),
        "norm1_w": gain(ks[4], (DEPTH, D)),
        "w_in": w(ks[5], (DEPTH, D, D_IN), D),
        "q_norm_w": gain(ks[6], (DEPTH, HEAD_DIM)),
        "k_norm_w": gain(ks[7], (DEPTH, HEAD_DIM)),
        "nat_rpb": 0.1 * jax.random.normal(ks[8], (DEPTH, N_HEADS_B, 2 * NA_ROWS - 1, 2 * NA_COLS - 1), f32),
        "w_oa": w(ks[9], (DEPTH, N_HEADS_A * HEAD_DIM, D), N_HEADS_A * HEAD_DIM),
        "w_ob": w(ks[10], (DEPTH, N_HEADS_B * HEAD_DIM, D), N_HEADS_B * HEAD_DIM),
        "w_out": w(ks[11], (DEPTH, D, D), D),
        "norm2_w": gain(ks[12], (DEPTH, D)),
        "w_ffn_gate": w(ks[13], (DEPTH, D, D_FF), D),
        "w_ffn_up": w(ks[14], (DEPTH, D, D_FF), D),
        "w_ffn_down": w(ks[15], (DEPTH, D_FF, D), D_FF),
        "final_w": gain(ks[16], (D,)),
    }


def reference(x, c, w_ada, b_ada, norm1_w, w_in, q_norm_w, k_norm_w, nat_rpb,
              w_oa, w_ob, w_out, norm2_w, w_ffn_gate, w_ffn_up, w_ffn_down, final_w):
    B, S, D = x.shape
    cos, sin = axial_rope_tables(S)
    offs = np.cumsum(IN_SPLITS)[:-1].tolist()
    c_act = jax.nn.silu(c)
    for l in range(DEPTH):
        mod = c_act @ w_ada[l] + b_ada[l]
        sh1, sc1, g1, sh2, sc2, g2 = [m[:, None, :] for m in jnp.split(mod, 6, axis=-1)]

        h = rms_norm(x, norm1_w[l]) * (1.0 + sc1) + sh1
        proj = h @ w_in[l]
        qa, ka, va, qb, kb, vb, ga, gb = jnp.split(proj, offs, axis=-1)
        qa = qa.reshape(B, S, N_HEADS_A, HEAD_DIM)
        ka = ka.reshape(B, S, N_KV_A, HEAD_DIM)
        va = va.reshape(B, S, N_KV_A, HEAD_DIM)
        qa = apply_rope(rms_norm(qa, q_norm_w[l]), cos, sin)
        ka = apply_rope(rms_norm(ka, k_norm_w[l]), cos, sin)
        ya = global_gqa(qa, ka, va)
        yb = neighbourhood_attention(
            qb.reshape(B, S, N_HEADS_B, HEAD_DIM),
            kb.reshape(B, S, N_HEADS_B, HEAD_DIM),
            vb.reshape(B, S, N_HEADS_B, HEAD_DIM),
            nat_rpb[l])
        merged = jax.nn.sigmoid(ga) * (ya @ w_oa[l]) + jax.nn.sigmoid(gb) * (yb @ w_ob[l])
        x = x + g1 * (merged @ w_out[l])

        h2 = rms_norm(x, norm2_w[l]) * (1.0 + sc2) + sh2
        ff = (jax.nn.silu(h2 @ w_ffn_gate[l]) * (h2 @ w_ffn_up[l])) @ w_ffn_down[l]
        x = x + g2 * ff
    return rms_norm(x, final_w)
```

```cpp
#include <hip/hip_runtime.h>
#include <hip/hip_bf16.h>
#include <hip/hip_cooperative_groups.h>
#include <cstdio>
#include <cstdint>
#include <cmath>
#define N_LAUNCHES 1
namespace pg8 {
#define PG8_LAS __attribute__((address_space(3)))
typedef unsigned short bf16_t;
typedef short bf16x8 __attribute__((ext_vector_type(8)));
typedef float f32x4 __attribute__((ext_vector_type(4)));
typedef unsigned u32x4 __attribute__((ext_vector_type(4)));
constexpr int BM = 256, BK = 64, HALF = 128, HTB = HALF * BK * 2  , STAGE_BYTES = 8 * HTB, NXCD = 8, WGM = 8;

__host__ __device__ __forceinline__ int lds_byte(int r, int c) { const int st = (r >> 4) * 2 + (c >> 5), rr = r & 15, cc = c & 31, ob = rr * 64 + cc * 2; return st * 1024 + (ob ^ (((ob >> 9) & 1) << 5)); }
__host__ __device__ __forceinline__ void stage_rc(int b, int& R, int& C) { const int st = b / 1024, sb = b % 1024, swz = sb ^ (((sb >> 9) & 1) << 5); R = (st >> 1) * 16 + swz / 64; C = (st & 1) * 32 + (swz % 64) / 2; }
__host__ __device__ __forceinline__ int perm32(int rho) { const int n = rho >> 4, i = rho & 15; return 8 * (i >> 2) + 4 * n + (i & 3); }

struct Unit { int pm, pn; };
struct Gemm { const bf16_t* A; const bf16_t* Bt; int M, N, K; };

struct StaticOrder {
    int nM, nN, nwg, G, c;
    __host__ __device__ void init(int M, int N, int G_, int c_) { nM = M / BM; nN = N / BM; nwg = nM * nN; G = G_; c = c_; }
    __host__ __device__ bool next(int i, Unit& u) const {
        const long L = (long)i * G + c; if (L >= nwg) return false;
        int wgid = (int)L; { const int q = nwg / NXCD, r = nwg % NXCD, xcd = wgid % NXCD, off = wgid / NXCD; wgid = (xcd < r ? xcd * (q + 1) : r * (q + 1) + (xcd - r) * q) + off; }
        const int nig = WGM * nN, gid = wgid / nig, fm = gid * WGM, gsz = (nM - fm) < WGM ? (nM - fm) : WGM;
        u.pm = fm + ((wgid % nig) % gsz); u.pn = (wgid % nig) / gsz; return true;
    }
    __device__ __forceinline__ void a_ready(const Unit&) const {}
    __device__ __forceinline__ void done(const Unit&) const {}
};

__device__ __forceinline__ unsigned cvt_pk_bf16(float lo, float hi) { unsigned r; asm volatile("v_cvt_pk_bf16_f32 %0, %1, %2" : "=v"(r) : "v"(lo), "v"(hi)); return r; }
__device__ __forceinline__ float bflo(unsigned w) { return __uint_as_float(w << 16); }
__device__ __forceinline__ float bfhi(unsigned w) { return __uint_as_float(w & 0xffff0000u); }
struct EpiProj {
    static constexpr bool PERM = true, AFTER_DRAIN = false;
    bf16_t *QAB, *KVA, *KB, *VB, *GA, *GB;
    __device__ __forceinline__ void operator()(const f32x4 (&acc)[2][2][4][2], const Unit& u, int wr, int wc, int fr, int fq) const {
        const int pn = u.pn; bf16_t* base; int ldc, colt;
        if (pn < 4) { base = QAB; ldc = 2048; colt = pn * 256; }
        else if (pn < 6) { base = KVA; ldc = 512; colt = (pn - 4) * 256; }
        else if (pn < 10) { base = QAB; ldc = 2048; colt = 1024 + (pn - 6) * 256; }
        else if (pn < 14) { base = KB; ldc = 1024; colt = (pn - 10) * 256; }
        else if (pn < 18) { base = VB; ldc = 1024; colt = (pn - 14) * 256; }
        else if (pn < 26) { base = GA; ldc = 2048; colt = (pn - 18) * 256; }
        else { base = GB; ldc = 2048; colt = (pn - 26) * 256; }
        const int row0 = u.pm * BM + wr * 64 + fr, col0 = colt + wc * 32 + 8 * fq;
#pragma unroll
        for (int ai = 0; ai < 2; ++ai)
#pragma unroll
            for (int m = 0; m < 4; ++m) { bf16_t* rowp = base + (size_t)(row0 + ai * HALF + m * 16) * ldc + col0;
#pragma unroll
                for (int bj = 0; bj < 2; ++bj) { const f32x4 v0 = acc[ai][bj][m][0], v1 = acc[ai][bj][m][1];
                    u32x4 w; w.x = cvt_pk_bf16(v0[0], v0[1]); w.y = cvt_pk_bf16(v0[2], v0[3]); w.z = cvt_pk_bf16(v1[0], v1[1]); w.w = cvt_pk_bf16(v1[2], v1[3]);
                    *(u32x4*)(rowp + bj * HALF) = w; } }
    }
};
struct EpiMerged {
    static constexpr bool PERM = true, AFTER_DRAIN = false;
    const bf16_t *GA, *GB; bf16_t* O;
    __device__ __forceinline__ void mid(f32x4 (&acc)[2][2][4][2], const Unit& u, int wr, int wc, int fr, int fq) const {
        int row0 = u.pm * BM + wr * 64 + fr; const int col0 = u.pn * BM + wc * 32 + 8 * fq;
        asm volatile("" : "+v"(row0));
#pragma unroll
        for (int ai = 0; ai < 2; ++ai)
#pragma unroll
            for (int m = 0; m < 4; ++m)
#pragma unroll
                for (int bj = 0; bj < 2; ++bj) { const size_t off = (size_t)(row0 + ai * HALF + m * 16) * 2048 + col0 + bj * HALF;
                    const u32x4 a = *(const u32x4*)(GA + off), b = *(const u32x4*)(GB + off);
#pragma unroll
                    for (int e = 0; e < 4; ++e) { const float ga0 = bflo(a[e]), ga1 = bfhi(a[e]), gb0 = bflo(b[e]), gb1 = bfhi(b[e]);
                        const float r0 = (1.f + __expf(-gb0)) / (1.f + __expf(-ga0)), r1 = (1.f + __expf(-gb1)) / (1.f + __expf(-ga1));
                        acc[ai][bj][m][e >> 1][(e & 1) * 2] *= r0; acc[ai][bj][m][e >> 1][(e & 1) * 2 + 1] *= r1; }
                    asm volatile("" ::: "memory"); }
    }
    __device__ __forceinline__ void operator()(const f32x4 (&acc)[2][2][4][2], const Unit& u, int wr, int wc, int fr, int fq) const {
        const int row0 = u.pm * BM + wr * 64 + fr, col0 = u.pn * BM + wc * 32 + 8 * fq;
#pragma unroll
        for (int ai = 0; ai < 2; ++ai)
#pragma unroll
            for (int m = 0; m < 4; ++m)
#pragma unroll
                for (int bj = 0; bj < 2; ++bj) { const size_t off = (size_t)(row0 + ai * HALF + m * 16) * 2048 + col0 + bj * HALF;
                    const u32x4 b = *(const u32x4*)(GB + off); float o[8];
#pragma unroll
                    for (int e = 0; e < 4; ++e) { const float gb0 = bflo(b[e]), gb1 = bfhi(b[e]);
                        o[2 * e] = acc[ai][bj][m][e >> 1][(e & 1) * 2] / (1.f + __expf(-gb0)); o[2 * e + 1] = acc[ai][bj][m][e >> 1][(e & 1) * 2 + 1] / (1.f + __expf(-gb1)); }
                    u32x4 w; w.x = cvt_pk_bf16(o[0], o[1]); w.y = cvt_pk_bf16(o[2], o[3]); w.z = cvt_pk_bf16(o[4], o[5]); w.w = cvt_pk_bf16(o[6], o[7]);
                    *(u32x4*)(O + off) = w; }
    }
};
struct EpiResid {
    static constexpr bool PERM = false, AFTER_DRAIN = false;
    const float* base; float* out; const float* g;
    __device__ __forceinline__ void operator()(const f32x4 (&acc)[2][2][4][2], const Unit& u, int wr, int wc, int fr, int fq) const {
        const int row0 = u.pm * BM + wr * 64 + fr, col0 = u.pn * BM + wc * 32 + 4 * fq;
        f32x4 gv[2][2];
#pragma unroll
        for (int bj = 0; bj < 2; ++bj)
#pragma unroll
            for (int n = 0; n < 2; ++n) gv[bj][n] = *(const f32x4*)(g + col0 + bj * HALF + n * 16);
#pragma unroll
        for (int ai = 0; ai < 2; ++ai)
#pragma unroll
            for (int m = 0; m < 4; ++m) { const size_t off = (size_t)(row0 + ai * HALF + m * 16) * 2048 + col0;
#pragma unroll
                for (int bj = 0; bj < 2; ++bj)
#pragma unroll
                    for (int n = 0; n < 2; ++n) { const f32x4 bs = *(const f32x4*)(base + off + bj * HALF + n * 16);
                        *(f32x4*)(out + off + bj * HALF + n * 16) = bs + gv[bj][n] * acc[ai][bj][m][n]; } }
    }
};
struct EpiSwiglu {
    static constexpr bool PERM = true, AFTER_DRAIN = false;
    bf16_t* O;
    __device__ __forceinline__ void operator()(const f32x4 (&acc)[2][2][4][2], const Unit& u, int wr, int wc, int fr, int fq) const {
        const int row0 = u.pm * BM + wr * 64 + fr, col0 = u.pn * HALF + wc * 32 + 8 * fq;
#pragma unroll
        for (int ai = 0; ai < 2; ++ai)
#pragma unroll
            for (int m = 0; m < 4; ++m) { float o[8];
#pragma unroll
                for (int n = 0; n < 2; ++n)
#pragma unroll
                    for (int e = 0; e < 4; ++e) { const float gt = acc[ai][0][m][n][e], up = acc[ai][1][m][n][e]; o[4 * n + e] = gt * up / (1.f + __expf(-gt)); }
                u32x4 w; w.x = cvt_pk_bf16(o[0], o[1]); w.y = cvt_pk_bf16(o[2], o[3]); w.z = cvt_pk_bf16(o[4], o[5]); w.w = cvt_pk_bf16(o[6], o[7]);
                *(u32x4*)(O + (size_t)(row0 + ai * HALF + m * 16) * 5632 + col0) = w; }
    }
};
template <class Epi, class Sched, bool ALIGN_EPI = false, bool SP2 = false, bool MID = false>
__device__ __forceinline__ void gemm_phase(PG8_LAS unsigned char* lds, const Gemm g, const Sched& S, const Epi& E) {
    int tid_ = threadIdx.x; asm volatile("" : "+v"(tid_));
    const int tid = tid_, wid = __builtin_amdgcn_readfirstlane(tid >> 6), lane = tid & 63, wr = wid >> 2, wc = wid & 3, fr = lane & 15, fq = lane >> 4;
    const int K = g.K, nt = K / BK;
    unsigned voffA[2], voffB[2];
#pragma unroll
    for (int i = 0; i < 2; ++i) { int R, C; stage_rc(tid * 16 + i * 8192, R, C); const int Rb = Epi::PERM ? ((R & ~31) + perm32(R & 31)) : R;
        voffA[i] = (unsigned)(R * K + C) * 2u; voffB[i] = (unsigned)(Rb * K + C) * 2u; }
    const size_t kstep = (size_t)(BK * 2);
    const size_t hstep = (size_t)HALF * K * 2;
    const size_t tstep = 2 * hstep;
    const unsigned ldsw = (unsigned)wid * 1024u;
    const int aoff = lds_byte(wr * 64 + fr, fq * 8), boff = lds_byte(wc * 32 + fr, fq * 8);
#define PG8_SA(b, h) (((b) * 2 + (h)) * HTB)
#define PG8_SB(b, h) ((4 + (b) * 2 + (h)) * HTB)
#define PG8_STAGE(bufoff, gbase, voff) do { _Pragma("unroll") for (int _i = 0; _i < 2; ++_i) \
        __builtin_amdgcn_global_load_lds((const unsigned*)((const char*)(gbase) + (voff)[_i]), (PG8_LAS unsigned*)(lds + (bufoff) + ldsw + _i * 8192), 16, 0, 0); } while (0)
#define PG8_LDA(dst, b, h) do { _Pragma("unroll") for (int m = 0; m < 4; ++m) _Pragma("unroll") for (int k = 0; k < 2; ++k) dst[m][k] = *(const PG8_LAS bf16x8*)(lds + PG8_SA(b, h) + aoff + m * 2048 + k * 1024); } while (0)
#define PG8_LDB(dst, b, h) do { _Pragma("unroll") for (int n = 0; n < 2; ++n) _Pragma("unroll") for (int k = 0; k < 2; ++k) dst[n][k] = *(const PG8_LAS bf16x8*)(lds + PG8_SB(b, h) + boff + n * 2048 + k * 1024); } while (0)
#define PG8_MMA(ai, bj, At, Bt) do { __builtin_amdgcn_s_setprio(1); _Pragma("unroll") for (int m = 0; m < 4; ++m) _Pragma("unroll") for (int n = 0; n < 2; ++n) _Pragma("unroll") for (int k = 0; k < 2; ++k) \
        acc[ai][bj][m][n] = __builtin_amdgcn_mfma_f32_16x16x32_bf16(Bt[n][k], At[m][k], acc[ai][bj][m][n], 0, 0, 0); __builtin_amdgcn_s_setprio(0); } while (0)
#define PG8_WAIT_V(n) asm volatile("s_waitcnt vmcnt(" #n ")" ::: "memory")
#define PG8_WAIT_L(n) asm volatile("s_waitcnt lgkmcnt(" #n ")" ::: "memory")
#define PG8_BAR __builtin_amdgcn_s_barrier()
#define PG8_SCHED __builtin_amdgcn_sched_barrier(0)
    Unit cur, nxt; int ui = 0;
    if (!S.next(0, cur)) return;
    f32x4 acc[2][2][4][2];
#pragma unroll
    for (int a = 0; a < 2; ++a)
#pragma unroll
        for (int b = 0; b < 2; ++b)
#pragma unroll
            for (int m = 0; m < 4; ++m)
#pragma unroll
                for (int n = 0; n < 2; ++n) acc[a][b][m][n] = (f32x4){0.f, 0.f, 0.f, 0.f};
    bf16x8 At[4][2], B0[2][2], B1[2][2];
    const char* cA = (const char*)g.A + (size_t)cur.pm * tstep; const char* cB = (const char*)g.Bt + (size_t)cur.pn * tstep;
    S.a_ready(cur);
    if constexpr (SP2) {
        PG8_STAGE(PG8_SB(0, 0), cB, voffB); PG8_STAGE(PG8_SB(0, 1), cB + hstep, voffB); PG8_STAGE(PG8_SA(0, 0), cA, voffA); PG8_STAGE(PG8_SA(0, 1), cA + hstep, voffA);
        if (wr == 1) PG8_BAR;
        PG8_WAIT_V(2); PG8_BAR;
        PG8_STAGE(PG8_SB(1, 0), cB + kstep, voffB); PG8_STAGE(PG8_SA(1, 0), cA + kstep, voffA); PG8_STAGE(PG8_SB(1, 1), cB + hstep + kstep, voffB);
        PG8_WAIT_V(6); PG8_BAR;
    } else {
        PG8_STAGE(PG8_SB(0, 0), cB, voffB); PG8_STAGE(PG8_SA(0, 0), cA, voffA); PG8_STAGE(PG8_SB(0, 1), cB + hstep, voffB); PG8_STAGE(PG8_SA(0, 1), cA + hstep, voffA);
        if (wr == 1) PG8_BAR;
        PG8_WAIT_V(4); PG8_BAR;
        PG8_STAGE(PG8_SB(1, 0), cB + kstep, voffB); PG8_STAGE(PG8_SA(1, 0), cA + kstep, voffA); PG8_STAGE(PG8_SB(1, 1), cB + hstep + kstep, voffB);
        PG8_WAIT_V(6); PG8_BAR;
    }
    for (;;) {
        const bool has_next = S.next(ui + 1, nxt);
        const char* nA = has_next ? (const char*)g.A + (size_t)nxt.pm * tstep : cA; const char* nB = has_next ? (const char*)g.Bt + (size_t)nxt.pn * tstep : cB;
        for (int t = 0; t < nt; t += 2) {
            if constexpr (MID) { if (t == (nt >> 1)) E.mid(acc, cur, wr, wc, fr, fq); }
            const bool last = (t == nt - 2);
            const char* a1 = cA + (size_t)(t + 1) * kstep;
            const char* a2 = last ? nA : cA + (size_t)(t + 2) * kstep; const char* b2 = last ? nB : cB + (size_t)(t + 2) * kstep;
            const char* a3 = a2 + kstep; const char* b3 = b2 + kstep;
            if (last && has_next) S.a_ready(nxt);
            if constexpr (SP2) {
            PG8_LDB(B0, 0, 0); PG8_LDB(B1, 0, 1); PG8_SCHED; PG8_LDA(At, 0, 0); PG8_STAGE(PG8_SA(1, 1), a1 + hstep, voffA);
            PG8_WAIT_V(8); PG8_WAIT_L(0); PG8_BAR; PG8_MMA(0, 0, At, B0); PG8_MMA(0, 1, At, B1); PG8_BAR; PG8_SCHED;
            PG8_LDA(At, 0, 1); PG8_STAGE(PG8_SB(0, 0), b2, voffB); PG8_STAGE(PG8_SB(0, 1), b2 + hstep, voffB); PG8_STAGE(PG8_SA(0, 0), a2, voffA);
            PG8_WAIT_V(8); PG8_WAIT_L(0); PG8_BAR; PG8_MMA(1, 0, At, B0); PG8_MMA(1, 1, At, B1); PG8_BAR; PG8_SCHED;
            PG8_LDB(B0, 1, 0); PG8_LDB(B1, 1, 1); PG8_SCHED; PG8_LDA(At, 1, 0); PG8_STAGE(PG8_SA(0, 1), a2 + hstep, voffA);
            PG8_WAIT_V(8); PG8_WAIT_L(0); PG8_BAR; PG8_MMA(0, 0, At, B0); PG8_MMA(0, 1, At, B1); PG8_BAR; PG8_SCHED;
            PG8_LDA(At, 1, 1); PG8_STAGE(PG8_SB(1, 0), b3, voffB); PG8_STAGE(PG8_SB(1, 1), b3 + hstep, voffB); PG8_STAGE(PG8_SA(1, 0), a3, voffA);
            PG8_WAIT_V(8); PG8_WAIT_L(0); PG8_BAR; PG8_MMA(1, 0, At, B0); PG8_MMA(1, 1, At, B1); PG8_BAR; PG8_SCHED;
            } else {
            PG8_LDB(B0, 0, 0); PG8_SCHED; PG8_LDA(At, 0, 0); PG8_STAGE(PG8_SA(1, 1), a1 + hstep, voffA);
            PG8_WAIT_L(8); PG8_BAR; PG8_WAIT_L(0); PG8_MMA(0, 0, At, B0); PG8_BAR; PG8_SCHED;
            PG8_LDB(B1, 0, 1); PG8_STAGE(PG8_SB(0, 0), b2, voffB);
            PG8_BAR; PG8_WAIT_L(0); PG8_MMA(0, 1, At, B1); PG8_BAR;
            PG8_LDA(At, 0, 1); PG8_STAGE(PG8_SA(0, 0), a2, voffA);
            PG8_BAR; PG8_WAIT_L(0); PG8_MMA(1, 0, At, B0); PG8_BAR; PG8_SCHED;
            PG8_STAGE(PG8_SB(0, 1), b2 + hstep, voffB);
            PG8_WAIT_V(6); PG8_BAR; PG8_MMA(1, 1, At, B1); PG8_BAR;
            PG8_LDB(B0, 1, 0); PG8_SCHED; PG8_LDA(At, 1, 0); PG8_STAGE(PG8_SA(0, 1), a2 + hstep, voffA);
            PG8_WAIT_L(8); PG8_BAR; PG8_WAIT_L(0); PG8_MMA(0, 0, At, B0); PG8_BAR; PG8_SCHED;
            PG8_LDB(B1, 1, 1); PG8_STAGE(PG8_SB(1, 0), b3, voffB);
            PG8_BAR; PG8_WAIT_L(0); PG8_MMA(0, 1, At, B1); PG8_BAR;
            PG8_LDA(At, 1, 1); PG8_STAGE(PG8_SA(1, 0), a3, voffA);
            PG8_BAR; PG8_WAIT_L(0); PG8_MMA(1, 0, At, B0); PG8_BAR; PG8_SCHED;
            PG8_STAGE(PG8_SB(1, 1), b3 + hstep, voffB);
            PG8_WAIT_V(6); PG8_BAR; PG8_MMA(1, 1, At, B1); PG8_BAR;
            }
        }
        if constexpr (ALIGN_EPI) { if (wr == 0) PG8_BAR; }
        if constexpr (!Epi::AFTER_DRAIN) { E(acc, cur, wr, wc, fr, fq); S.done(cur); }
        if (!has_next) break;
#pragma unroll
        for (int a = 0; a < 2; ++a)
#pragma unroll
            for (int b = 0; b < 2; ++b)
#pragma unroll
                for (int m = 0; m < 4; ++m)
#pragma unroll
                    for (int n = 0; n < 2; ++n) acc[a][b][m][n] = (f32x4){0.f, 0.f, 0.f, 0.f};
        cur = nxt; cA = nA; cB = nB; ++ui;
        if constexpr (ALIGN_EPI) { if (wr == 1) PG8_BAR; }
    }
    PG8_WAIT_V(0);
    if constexpr (!ALIGN_EPI) { if (wr == 0) PG8_BAR; }
    PG8_BAR;
    if constexpr (Epi::AFTER_DRAIN) { E.fused(acc, cur, wr, wc, fr, fq, lds, wid, lane); S.done(cur); }
#undef PG8_SA
#undef PG8_SB
#undef PG8_STAGE
#undef PG8_LDA
#undef PG8_LDB
#undef PG8_MMA
#undef PG8_WAIT_V
#undef PG8_WAIT_L
#undef PG8_BAR
#undef PG8_SCHED
}
}
namespace att {
using bf16 = __hip_bfloat16;
constexpr int D = 128, NW = 8, QBLK = 32, KVBLK = 64;
constexpr float SCALE = 0.088388347648318440f;
constexpr float THR = 8.f;
constexpr int SDEPTH = 2;
constexpr size_t SHM_V = KVBLK * D * 2, SHM_K = KVBLK * D * 2, SHM_ATTN = 2 * SHM_V + 2 * SHM_K + NW * 64 * 4;
using bf16x8 = __attribute__((ext_vector_type(8))) short;
using s16x4  = __attribute__((ext_vector_type(4))) short;
using f32x16 = __attribute__((ext_vector_type(16))) float;
using f32x8  = __attribute__((ext_vector_type(8))) float;
using u32x4  = __attribute__((ext_vector_type(4))) unsigned;
#define KSWZ(row, colB) ((row) * 256 + ((colB) ^ (((row) & 7) << 4)))
#define SBAR() __builtin_amdgcn_sched_barrier(0)
__device__ __forceinline__ int crow(int r, int hi) { return (r & 3) + 8 * (r >> 2) + 4 * hi; }
__device__ __forceinline__ unsigned cvtpk(float lo, float hi) {
  unsigned r; asm volatile("v_cvt_pk_bf16_f32 %0, %1, %2" : "=v"(r) : "v"(lo), "v"(hi)); return r;
}
template <typename TIn> struct Stage;
template <> struct Stage<bf16>  { using T = bf16x8;
  __device__ static __forceinline__ T ld8(const bf16* p) { return *reinterpret_cast<const bf16x8*>(p); }
  __device__ static __forceinline__ bf16x8 tobf(T x) { return x; } };
template <> struct Stage<float> { using T = f32x8;
  __device__ static __forceinline__ T ld8(const float* p) { return *reinterpret_cast<const f32x8*>(p); }
  __device__ static __forceinline__ bf16x8 tobf(T x) {
    u32x4 w = {cvtpk(x[0], x[1]), cvtpk(x[2], x[3]), cvtpk(x[4], x[5]), cvtpk(x[6], x[7])}; return *reinterpret_cast<bf16x8*>(&w); } };

__device__ __forceinline__ void partialSM(f32x16& p0, f32x16& p1, float& m_reg, float& mn, float& alpha) {
  constexpr float C = SCALE * 1.4426950408889634f;
  float pmax = p0[0]; for (int r = 1; r < 16; ++r) pmax = fmaxf(pmax, p0[r]); for (int r = 0; r < 16; ++r) pmax = fmaxf(pmax, p1[r]);
  { auto rr = __builtin_amdgcn_permlane32_swap(__float_as_uint(pmax), __float_as_uint(pmax), false, false);
    pmax = fmaxf(__uint_as_float(rr[0]), __uint_as_float(rr[1])); }
  if (__builtin_expect(__all(pmax - m_reg <= THR / SCALE), 1)) { mn = m_reg; alpha = 1.f; }
  else { mn = fmaxf(m_reg, pmax); alpha = __builtin_amdgcn_exp2f((m_reg - mn) * C); m_reg = mn; }
  float mnC = -mn * C;
  for (int r = 0; r < 16; ++r) p0[r] = fmaf(p0[r], C, mnC); for (int r = 0; r < 16; ++r) p1[r] = fmaf(p1[r], C, mnC);
  for (int r = 0; r < 16; ++r) p0[r] = __builtin_amdgcn_exp2f(p0[r]);
}
__device__ __forceinline__ void finishSM(f32x16& p0, f32x16& p1, float alpha, float& l_reg, bf16x8& pa0, bf16x8& pa1, bf16x8& pa2, bf16x8& pa3) {
  for (int r = 0; r < 16; ++r) p1[r] = __builtin_amdgcn_exp2f(p1[r]);
  float ps = 0; for (int r = 0; r < 16; ++r) ps += p0[r]; for (int r = 0; r < 16; ++r) ps += p1[r];
  { auto rr = __builtin_amdgcn_permlane32_swap(__float_as_uint(ps), __float_as_uint(ps), false, false);
    ps = __uint_as_float(rr[0]) + __uint_as_float(rr[1]); }
  l_reg = l_reg * alpha + ps;
#define PK4(P, BASE, OUT) do { unsigned a0 = cvtpk(P[BASE + 0], P[BASE + 1]), a1 = cvtpk(P[BASE + 2], P[BASE + 3]);   \
    unsigned b0 = cvtpk(P[BASE + 4], P[BASE + 5]), b1 = cvtpk(P[BASE + 6], P[BASE + 7]);                              \
    auto r0 = __builtin_amdgcn_permlane32_swap(a0, b0, false, false); auto r1 = __builtin_amdgcn_permlane32_swap(a1, b1, false, false); \
    u32x4 w = {r0[0], r1[0], r0[1], r1[1]}; OUT = *reinterpret_cast<bf16x8*>(&w); } while (0)
  PK4(p0, 0, pa0); PK4(p0, 8, pa1); PK4(p1, 0, pa2); PK4(p1, 8, pa3);
#undef PK4
}
__device__ __forceinline__ void qkt(f32x16& p0, f32x16& p1, const bf16* Ks, const bf16x8* qr, int r32, int hi) {
  p0 = f32x16{}; p1 = f32x16{};
  for (int d0 = 0; d0 < 8; ++d0) { int cb = (d0 * 16 + hi * 8) * 2;
    bf16x8 b0 = *reinterpret_cast<const bf16x8*>((const char*)Ks + KSWZ(r32, cb));
    bf16x8 b1 = *reinterpret_cast<const bf16x8*>((const char*)Ks + KSWZ(32 + r32, cb));
    p0 = __builtin_amdgcn_mfma_f32_32x32x16_bf16(b0, qr[d0], p0, 0, 0, 0);
    p1 = __builtin_amdgcn_mfma_f32_32x32x16_bf16(b1, qr[d0], p1, 0, 0, 0); }
}
__device__ __forceinline__ int v_st(int k, int c) { const int kk = (k & ~0xC) | ((k & 4) << 1) | ((k & 8) >> 1); return ((kk >> 3) * 4 + (c >> 5)) * 512 + ((kk & 7) * 32 + (c & 31)) * 2; }
__device__ __forceinline__ int v_rd_base(int lane) { return ((lane & 3) << 3) | (((lane >> 2) & 3) << 6) | (((lane >> 4) & 1) << 5) | (((lane >> 5) & 1) << 8); }
constexpr int v_rd_off(int d0, int ks, int half) { return d0 * 512 + ks * 4096 + half * 2048; }
template <int OFF> __device__ __forceinline__ s16x4 tr_read(int vb) {
  s16x4 r; asm volatile("ds_read_b64_tr_b16 %0, %1 offset:%2" : "=&v"(r) : "v"(vb), "i"(OFF) : "memory"); return r;
}
template <int D0> __device__ __forceinline__ void pv_one(f32x16& od, int vb, bf16x8 pa0, bf16x8 pa1, bf16x8 pa2, bf16x8 pa3) {
  const s16x4 l0 = tr_read<v_rd_off(D0, 0, 0)>(vb), h0 = tr_read<v_rd_off(D0, 0, 1)>(vb), l1 = tr_read<v_rd_off(D0, 1, 0)>(vb), h1 = tr_read<v_rd_off(D0, 1, 1)>(vb);
  const s16x4 l2 = tr_read<v_rd_off(D0, 2, 0)>(vb), h2 = tr_read<v_rd_off(D0, 2, 1)>(vb), l3 = tr_read<v_rd_off(D0, 3, 0)>(vb), h3 = tr_read<v_rd_off(D0, 3, 1)>(vb);
  asm volatile("s_waitcnt lgkmcnt(0)" ::: "memory"); SBAR();
#define PK(L, H) (bf16x8){L[0], L[1], L[2], L[3], H[0], H[1], H[2], H[3]}
  od = __builtin_amdgcn_mfma_f32_32x32x16_bf16(pa0, PK(l0, h0), od, 0, 0, 0);
  od = __builtin_amdgcn_mfma_f32_32x32x16_bf16(pa1, PK(l1, h1), od, 0, 0, 0);
  od = __builtin_amdgcn_mfma_f32_32x32x16_bf16(pa2, PK(l2, h2), od, 0, 0, 0);
  od = __builtin_amdgcn_mfma_f32_32x32x16_bf16(pa3, PK(l3, h3), od, 0, 0, 0);
#undef PK
}
__device__ __forceinline__ void pv_d0(f32x16* o, int vb, bf16x8 pa0, bf16x8 pa1, bf16x8 pa2, bf16x8 pa3) {
  pv_one<0>(o[0], vb, pa0, pa1, pa2, pa3); pv_one<1>(o[1], vb, pa0, pa1, pa2, pa3); pv_one<2>(o[2], vb, pa0, pa1, pa2, pa3); pv_one<3>(o[3], vb, pa0, pa1, pa2, pa3);
}
__device__ __forceinline__ void na_mask(f32x16& p0, f32x16& p1, const float* T, int tb, int kk, bool rowvalid) {
#pragma unroll
  for (int q = 0; q < 4; ++q) {
#pragma unroll
    for (int r = 4 * q; r < 4 * q + 4; ++r) { const int cr = (r & 3) + 8 * (r >> 2);
      const float b0 = T[tb + cr]; const bool v0 = rowvalid && (unsigned)(cr + kk) < 16u; p0[r] = v0 ? p0[r] + b0 : -INFINITY; }
    asm volatile("" ::: "memory");
#pragma unroll
    for (int r = 4 * q; r < 4 * q + 4; ++r) { const int cr = (r & 3) + 8 * (r >> 2);
      const float b1 = T[tb + 32 + cr]; const bool v1 = rowvalid && (unsigned)(cr + 32 + kk) < 16u; p1[r] = v1 ? p1[r] + b1 : -INFINITY; }
    asm volatile("" ::: "memory");
  }
}
template <int LDQ, int LDK, int LDO, bool NA, int SD>
__device__ __forceinline__ void attn_unit(const bf16* Qb, const bf16* __restrict__ Kh, const bf16* __restrict__ Vh, bf16* Ob, int NT, char* lds,
                                          const float* __restrict__ rpb, int qrow0, int krow0) {
  using St = Stage<bf16>;
  int tid_ = threadIdx.x; asm volatile("" : "+v"(tid_));
  const int tid = tid_, wid = __builtin_amdgcn_readfirstlane(tid >> 6), lane = tid & 63, r32 = lane & 31, hi = lane >> 5;
  bf16* V_lds = (bf16*)lds; bf16* K_lds = (bf16*)(lds + 2 * SHM_V);
  float* ws = (float*)(lds + 2 * SHM_V + 2 * SHM_K) + wid * 64; float* li_l = ws; float* al_l = ws + 32;
  float* T = (float*)(lds + SHM_ATTN);
  __syncthreads();
  int na_tb0 = 0, na_kk = 0, na_r = 0, na_rs = 0;
  if constexpr (NA) {
    for (int e = tid; e < 15 * 128; e += 512) { const int rr = e >> 7, x = e & 127; T[e] = (x >= 49 && x <= 79) ? rpb[rr * 31 + x - 49] * (1.0f / SCALE) : 0.f; }
    const int c = (wid & 1) * 32 + r32; int cs = c - 8; cs = cs < 0 ? 0 : (cs > 48 ? 48 : cs);
    na_tb0 = 64 - c + 4 * hi; na_kk = 4 * hi - cs;
    na_r = qrow0 + (wid >> 1); na_rs = na_r - 4; na_rs = na_rs < 0 ? 0 : (na_rs > 248 ? 248 : na_rs);
  }
#define NAMASK(P0, P1, ti) do { if constexpr (NA) { SBAR(); const int kr_ = krow0 + (ti); const bool rv_ = (unsigned)(kr_ - na_rs) < 8u; int rr_ = kr_ - na_r + 7; rr_ = rv_ ? rr_ : 0; \
    na_mask(P0, P1, T, na_tb0 + rr_ * 128, na_kk, rv_); SBAR(); } } while (0)
  float m_reg = -1e30f, l_reg = 0; f32x16 o[4] = {}; bf16x8 qr[8];
  const bf16* Qw = Qb + (long)(wid * QBLK + r32) * LDQ + hi * 8;
#pragma unroll
  for (int d0 = 0; d0 < 8; ++d0) qr[d0] = St::ld8(Qw + d0 * 16);
  const int sr = tid >> 4, sc = (tid & 15) * 8, vst0 = v_st(sr, sc), vst1 = v_st(32 + sr, sc);
  const int vb0 = (int)(uintptr_t)V_lds + v_rd_base(lane);
  struct { typename St::T vs0, vs1, ks0, ks1; } sr_[SD];
#define SLOAD(i, k0) do { sr_[i].vs0 = St::ld8(&Vh[(long)((k0) + sr) * LDK + sc]); sr_[i].vs1 = St::ld8(&Vh[(long)((k0) + 32 + sr) * LDK + sc]); \
    sr_[i].ks0 = St::ld8(&Kh[(long)((k0) + sr) * LDK + sc]); sr_[i].ks1 = St::ld8(&Kh[(long)((k0) + 32 + sr) * LDK + sc]); } while (0)
#define SWRITE(b, i) do { *(bf16x8*)((char*)V_lds + (b) * SHM_V + vst0) = St::tobf(sr_[i].vs0);          \
    *(bf16x8*)((char*)V_lds + (b) * SHM_V + vst1) = St::tobf(sr_[i].vs1); int kc = sc * 2;               \
    *(bf16x8*)((char*)K_lds + (b) * SHM_K + KSWZ(sr, kc)) = St::tobf(sr_[i].ks0);                       \
    *(bf16x8*)((char*)K_lds + (b) * SHM_K + KSWZ(32 + sr, kc)) = St::tobf(sr_[i].ks1); } while (0)
#define SWAIT() do { if constexpr (SD == 2) asm volatile("s_waitcnt vmcnt(4)" ::: "memory"); else asm volatile("s_waitcnt vmcnt(0)" ::: "memory"); } while (0)
#define RESC(a) do { if (__any((a) < 1.f)) { if (hi == 0) al_l[r32] = (a); asm volatile("s_waitcnt lgkmcnt(0)" ::: "memory"); \
    for (int d = 0; d < 4; ++d) for (int r = 0; r < 16; ++r) o[d][r] *= al_l[crow(r, hi)]; } } while (0)
  f32x16 pA0, pA1, pB0, pB1; float mnA, mnB, alA, alB; bf16x8 pa0, pa1, pa2, pa3;
  constexpr int SE = 0, SO = SD - 1;
  SLOAD(SE, 0); asm volatile("s_waitcnt vmcnt(0)" ::: "memory"); SWRITE(0, SE); __syncthreads();
  qkt(pA0, pA1, K_lds, qr, r32, hi); NAMASK(pA0, pA1, 0); partialSM(pA0, pA1, m_reg, mnA, alA);
  SLOAD(SO, KVBLK); if constexpr (SD == 2) { if (2 < NT) SLOAD(SE, 2 * KVBLK); }
  SWAIT(); SWRITE(1, SO); __syncthreads();
  for (int j = 1; j + 1 < NT; j += 2) {
    SBAR(); qkt(pB0, pB1, (bf16*)((char*)K_lds + SHM_K), qr, r32, hi);
    finishSM(pA0, pA1, alA, l_reg, pa0, pa1, pa2, pa3); SBAR();
    SLOAD(SO, (j + SD) * KVBLK); SBAR();
    pv_d0(o, vb0, pa0, pa1, pa2, pa3); NAMASK(pB0, pB1, j); partialSM(pB0, pB1, m_reg, mnB, alB);
    __syncthreads(); SWAIT(); SWRITE(0, SE);
    RESC(alB); __syncthreads();
    SBAR(); qkt(pA0, pA1, K_lds, qr, r32, hi);
    finishSM(pB0, pB1, alB, l_reg, pa0, pa1, pa2, pa3); SBAR();
    if (SD == 1 || j + 3 < NT) SLOAD(SE, (j + 1 + SD) * KVBLK); SBAR();
    pv_d0(o, vb0 + (int)SHM_V, pa0, pa1, pa2, pa3); NAMASK(pA0, pA1, j + 1); partialSM(pA0, pA1, m_reg, mnA, alA);
    __syncthreads(); SWAIT(); SWRITE(1, SO);
    RESC(alA); __syncthreads();
  }
  SBAR(); qkt(pB0, pB1, (bf16*)((char*)K_lds + SHM_K), qr, r32, hi);
  finishSM(pA0, pA1, alA, l_reg, pa0, pa1, pa2, pa3); SBAR();
  pv_d0(o, vb0, pa0, pa1, pa2, pa3); NAMASK(pB0, pB1, NT - 1); partialSM(pB0, pB1, m_reg, mnB, alB);
  __syncthreads(); RESC(alB);
  finishSM(pB0, pB1, alB, l_reg, pa0, pa1, pa2, pa3); SBAR();
  pv_d0(o, vb0 + (int)SHM_V, pa0, pa1, pa2, pa3);
  if (hi == 0) li_l[r32] = l_reg; asm volatile("s_waitcnt lgkmcnt(0)" ::: "memory");
  float rli[16];
#pragma unroll
  for (int r = 0; r < 16; ++r) rli[r] = __builtin_amdgcn_rcpf(li_l[crow(r, hi)]);
  bf16* Ow = Ob + (long)(wid * QBLK) * LDO;
#pragma unroll
  for (int r = 0; r < 16; ++r) { const int orow = crow(r, hi);
#pragma unroll
    for (int d0 = 0; d0 < 4; ++d0) Ow[(long)orow * LDO + d0 * 32 + r32] = __float2bfloat16(o[d0][r] * rli[r]); }
#undef SLOAD
#undef SWRITE
#undef SWAIT
#undef RESC
#undef NAMASK
}
#undef SBAR
}
namespace cg = cooperative_groups;
#define LAS __attribute__((address_space(3)))
typedef unsigned short bf16_t;
typedef float f32x4 __attribute__((ext_vector_type(4)));
typedef unsigned v4u __attribute__((ext_vector_type(4)));
typedef unsigned v2u __attribute__((ext_vector_type(2)));
constexpr int SEQ = 16384, DM = 2048, DIN = 8704, DFF = 5632, NMOD = 6 * DM;
constexpr float NORM_EPS = 1e-6f;
constexpr size_t MiB = 1u << 20;
constexpr size_t WS_MOD = 0, CTL_ZERO_BYTES = 64 * 1024;
constexpr size_t WS_ROPE = 1 * MiB;
constexpr size_t WS_WIN = 2 * MiB, WS_WO = 36 * MiB, WS_WOUT = 44 * MiB, WS_WGU = 52 * MiB, WS_WD = 96 * MiB;
constexpr size_t WS_H = 120 * MiB;
constexpr size_t WS_QAB = 184 * MiB, WS_KVA = 248 * MiB, WS_KB = 264 * MiB, WS_VB = 296 * MiB, WS_GA = 328 * MiB, WS_GB = 392 * MiB, WS_END = 456 * MiB;
constexpr size_t WS_ACT = 184 * MiB;
constexpr int LDS_BYTES = 147456;
constexpr int NPHASE = 11;

__device__ __forceinline__ unsigned f2bf(float f) { unsigned u = __builtin_bit_cast(unsigned, f); return (u + 0x7fffu + ((u >> 16) & 1u)) >> 16; }
__device__ __forceinline__ unsigned pk2(float lo, float hi) { return f2bf(lo) | (f2bf(hi) << 16); }
__device__ __forceinline__ float wave_sum(float v) {
#pragma unroll
    for (int o = 1; o < 64; o <<= 1) v += __shfl_xor(v, o);
    return v;
}
__device__ __forceinline__ void transpose_item(const float* __restrict__ W, int N, bf16_t* __restrict__ WT, int ldt, int koff, int mode, LAS float* scr, int item, int lane) {
    const int nblk = N / 32, kb = item / nblk, nb = item % nblk, k0 = 64 * kb, n0 = 32 * nb;
    const int drow0 = mode == 0 ? n0 : ((n0 >> 7) * 256 + (n0 & 127) + (mode == 2 ? 128 : 0));
#pragma unroll 8
    for (int i = 0; i < 32; ++i) { const int kk = 2 * i + (lane >> 5); scr[kk * 33 + (lane & 31)] = W[(size_t)(k0 + kk) * N + n0 + (lane & 31)]; }
    asm volatile("s_waitcnt lgkmcnt(0)" ::: "memory");
    const int c = lane & 7;
#pragma unroll
    for (int j = 0; j < 4; ++j) { const int n = (lane >> 3) + 8 * j; const LAS float* s = scr + (8 * c) * 33 + n;
        v4u o; o.x = pk2(s[0 * 33], s[1 * 33]); o.y = pk2(s[2 * 33], s[3 * 33]); o.z = pk2(s[4 * 33], s[5 * 33]); o.w = pk2(s[6 * 33], s[7 * 33]);
        *(v4u*)(WT + (size_t)(drow0 + n) * ldt + koff + k0 + 8 * c) = o; }
    asm volatile("s_waitcnt lgkmcnt(0)" ::: "memory");
}
__device__ __forceinline__ void gemv_item(const float* __restrict__ cvec, const float* __restrict__ w_ada, const float* __restrict__ b_ada, float* mod, int item, int lane) {
    const int kc = item / 48, jc = item % 48, col = jc * 256 + 4 * lane;
    f32x4 acc = {0.f, 0.f, 0.f, 0.f};
#pragma unroll 8
    for (int kk = 0; kk < 64; ++kk) { const int k = kc * 64 + kk; const float cv = cvec[k]; const float s = cv / (1.f + expf(-cv));
        const f32x4 w = *(const f32x4*)(w_ada + (size_t)k * NMOD + col); acc += w * s; }
    if (kc == 0) acc += *(const f32x4*)(b_ada + col);
#pragma unroll
    for (int e = 0; e < 4; ++e) __hip_atomic_fetch_add(mod + col + e, acc[e], __ATOMIC_RELAXED, __HIP_MEMORY_SCOPE_AGENT);
}
__device__ __forceinline__ void normmod_rows(const float* X, const float* __restrict__ nw, const float* __restrict__ sc, const float* __restrict__ sh, bf16_t* __restrict__ H, int gw, int NGW, int lane) {
    f32x4 a[8], b[8];
#pragma unroll
    for (int j = 0; j < 8; ++j) { const int col = 4 * lane + 256 * j; const f32x4 w = *(const f32x4*)(nw + col), s = *(const f32x4*)(sc + col); a[j] = w * (s + 1.0f); b[j] = *(const f32x4*)(sh + col); }
    for (int m = gw; m < SEQ; m += NGW) {
        const f32x4* xr = (const f32x4*)(X + (size_t)m * DM) + lane; f32x4 v[8]; float ss = 0.f;
#pragma unroll
        for (int j = 0; j < 8; ++j) { v[j] = xr[64 * j]; ss += (v[j].x * v[j].x + v[j].y * v[j].y) + (v[j].z * v[j].z + v[j].w * v[j].w); }
        const float rstd = rsqrtf(wave_sum(ss) * (1.0f / DM) + NORM_EPS);
        v2u* o8 = (v2u*)(H + (size_t)m * DM) + lane;
#pragma unroll
        for (int j = 0; j < 8; ++j) { const f32x4 y = v[j] * rstd * a[j] + b[j]; v2u w; w.x = pk2(y.x, y.y); w.y = pk2(y.z, y.w); o8[64 * j] = w; }
    }
}
__device__ __forceinline__ void final_rows(float* X, const float* __restrict__ fw, int gw, int NGW, int lane) {
    f32x4 a[8];
#pragma unroll
    for (int j = 0; j < 8; ++j) a[j] = *(const f32x4*)(fw + 4 * lane + 256 * j);
    for (int m = gw; m < SEQ; m += NGW) {
        f32x4* xr = (f32x4*)(X + (size_t)m * DM) + lane; f32x4 v[8]; float ss = 0.f;
#pragma unroll
        for (int j = 0; j < 8; ++j) { v[j] = xr[64 * j]; ss += (v[j].x * v[j].x + v[j].y * v[j].y) + (v[j].z * v[j].z + v[j].w * v[j].w); }
        const float rstd = rsqrtf(wave_sum(ss) * (1.0f / DM) + NORM_EPS);
#pragma unroll
        for (int j = 0; j < 8; ++j) xr[64 * j] = v[j] * rstd * a[j];
    }
}
__device__ __forceinline__ void qknorm_rope(bf16_t* QAB, bf16_t* KVA, const float* __restrict__ qn, const float* __restrict__ kn, const float* __restrict__ tab, int gw, int NGW, int lane) {
    const int li = lane & 15;
    for (int it = gw * 4 + (lane >> 4); it < SEQ * 10; it += NGW * 4) {
        const int t = it / 10, hs = it - t * 10;
        bf16_t* p = (hs < 8 ? QAB + (size_t)t * 2048 + hs * 128 : KVA + (size_t)t * 512 + (hs - 8) * 128) + 8 * li;
        const float* wn = (hs < 8 ? qn : kn) + 8 * li;
        const v4u raw = *(const v4u*)p; float x[8];
#pragma unroll
        for (int e = 0; e < 4; ++e) { x[2 * e] = __uint_as_float(raw[e] << 16); x[2 * e + 1] = __uint_as_float(raw[e] & 0xffff0000u); }
        float ss = 0.f;
#pragma unroll
        for (int e = 0; e < 8; ++e) ss += x[e] * x[e];
        ss += __shfl_xor(ss, 1); ss += __shfl_xor(ss, 2); ss += __shfl_xor(ss, 4); ss += __shfl_xor(ss, 8);
        const float rstd = rsqrtf(ss * (1.0f / 128.0f) + NORM_EPS);
        const f32x4 w0 = *(const f32x4*)wn, w1 = *(const f32x4*)(wn + 4);
        const float wv[8] = {w0.x, w0.y, w0.z, w0.w, w1.x, w1.y, w1.z, w1.w};
        const int row = t >> 6, col = t & 63;
        const float* cs = tab + 2 * (li < 8 ? (row * 32 + 4 * li) : ((256 + col) * 32 + 4 * (li - 8)));
        const f32x4 c0 = *(const f32x4*)cs, c1 = *(const f32x4*)(cs + 4);
        const float cv[4] = {c0.x, c0.z, c1.x, c1.z}, sv[4] = {c0.y, c0.w, c1.y, c1.w};
        v4u o;
#pragma unroll
        for (int e = 0; e < 4; ++e) { const float y0 = x[2 * e] * rstd * wv[2 * e], y1 = x[2 * e + 1] * rstd * wv[2 * e + 1];
            o[e] = pk2(y0 * cv[e] - y1 * sv[e], y0 * sv[e] + y1 * cv[e]); }
        *(v4u*)p = o;
    }
}

struct Args { const float* in[17]; float* out; unsigned char* ws; int ph_lo, ph_hi; };
__global__ void __launch_bounds__(512) fwd(Args args) {
    extern __shared__ __attribute__((aligned(16))) unsigned char lds[];
    cg::grid_group grid = cg::this_grid();
    const int tid0 = threadIdx.x;
    const int G0 = gridDim.x, bx0 = blockIdx.x;
    const int lo = args.ph_lo, hi = args.ph_hi;
#ifndef PHASE_MASK
#define PHASE_MASK 0x7ff
#endif
#define IN(k) (((PHASE_MASK >> (k)) & 1) && lo <= (k) && (k) < hi)
#define SEAM(k) do { if (IN(k) && IN((k) + 1)) grid.sync(); } while (0)
    typedef const __attribute__((address_space(4))) Args* ArgP;
#define ARGP() ({ ArgP p_ = (ArgP)__builtin_amdgcn_kernarg_segment_ptr(); asm volatile("" : "+s"(p_)); p_; })
#define WSP(off, T) ((T*)(A->ws + (off)))
#define OPQ() int G = G0, bx = bx0; asm volatile("" : "+s"(G), "+s"(bx)); int tid = tid0; asm volatile("" : "+v"(tid)); const int lane = tid & 63, wave = __builtin_amdgcn_readfirstlane(tid >> 6), gw = bx * 8 + wave, NGW = G * 8; (void)gw; (void)NGW; (void)lane

    if (IN(0)) { ArgP A = ARGP(); OPQ();
        const float* cvec = A->in[1]; const float* w_ada = A->in[2]; const float* b_ada = A->in[3]; const float* w_in = A->in[5]; const float* w_oa = A->in[9]; const float* w_ob = A->in[10];
        const float* w_out = A->in[11]; const float* w_g = A->in[13]; const float* w_u = A->in[14]; const float* w_d = A->in[15]; float* mod = WSP(WS_MOD, float); float* tab = WSP(WS_ROPE, float);
        bf16_t* WinT = WSP(WS_WIN, bf16_t); bf16_t* WoT = WSP(WS_WO, bf16_t); bf16_t* WoutT = WSP(WS_WOUT, bf16_t); bf16_t* WguT = WSP(WS_WGU, bf16_t); bf16_t* WdT = WSP(WS_WD, bf16_t);
        LAS float* scr = (LAS float*)((LAS unsigned char*)lds + wave * 16384);
        constexpr int I_GEMV = 32 * 48, I_IN = (DM / 64) * (DIN / 32), I_OA = (1024 / 64) * (DM / 32), I_OUT = (DM / 64) * (DM / 32), I_G = (DM / 64) * (DFF / 32), I_D = (DFF / 64) * (DM / 32);
        constexpr int NITEMS = I_GEMV + I_IN + 2 * I_OA + I_OUT + 2 * I_G + I_D;
        for (int it = gw; it < NITEMS; it += NGW) {
            int r = it;
            if (r < I_GEMV) { gemv_item(cvec, w_ada, b_ada, mod, r, lane); continue; } r -= I_GEMV;
            if (r < I_IN) { transpose_item(w_in, DIN, WinT, DM, 0, 0, scr, r, lane); continue; } r -= I_IN;
            if (r < I_OA) { transpose_item(w_oa, DM, WoT, 2048, 0, 0, scr, r, lane); continue; } r -= I_OA;
            if (r < I_OA) { transpose_item(w_ob, DM, WoT, 2048, 1024, 0, scr, r, lane); continue; } r -= I_OA;
            if (r < I_OUT) { transpose_item(w_out, DM, WoutT, DM, 0, 0, scr, r, lane); continue; } r -= I_OUT;
            if (r < I_G) { transpose_item(w_g, DFF, WguT, DM, 0, 1, scr, r, lane); continue; } r -= I_G;
            if (r < I_G) { transpose_item(w_u, DFF, WguT, DM, 0, 2, scr, r, lane); continue; } r -= I_G;
            transpose_item(w_d, DM, WdT, DFF, 0, 0, scr, r, lane);
        }
        for (int e = bx * 512 + tid; e < 320 * 32; e += G * 512) { const int pos = e >> 5, j = e & 31; const float p = (float)(pos < 256 ? pos : pos - 256);
            const float inv = powf(10000.0f, -(float)(2 * j) / 64.0f); const float ang = p * inv; tab[2 * e] = cosf(ang); tab[2 * e + 1] = sinf(ang); }
    }
    SEAM(0);
    if (IN(1)) { ArgP A = ARGP(); OPQ(); float* mod = WSP(WS_MOD, float); normmod_rows(A->in[0], A->in[4], mod + 2048, mod + 0, WSP(WS_H, bf16_t), gw, NGW, lane); }
    SEAM(1);
    if (IN(2)) { ArgP A = ARGP(); OPQ();
        pg8::Gemm g{WSP(WS_H, bf16_t), WSP(WS_WIN, bf16_t), SEQ, DIN, DM}; pg8::StaticOrder S; S.init(SEQ, DIN, G, bx);
        pg8::EpiProj E{WSP(WS_QAB, bf16_t), WSP(WS_KVA, bf16_t), WSP(WS_KB, bf16_t), WSP(WS_VB, bf16_t), WSP(WS_GA, bf16_t), WSP(WS_GB, bf16_t)};
        pg8::gemm_phase<pg8::EpiProj, pg8::StaticOrder, true, true, false>((LAS unsigned char*)lds, g, S, E);
    }
    SEAM(2);
    if (IN(3)) { ArgP A = ARGP(); OPQ(); qknorm_rope(WSP(WS_QAB, bf16_t), WSP(WS_KVA, bf16_t), A->in[6], A->in[7], WSP(WS_ROPE, float), gw, NGW, lane); }
    SEAM(3);
    if (IN(4)) { ArgP A = ARGP(); OPQ();
        using abf = att::bf16; bf16_t* QAB = WSP(WS_QAB, bf16_t); bf16_t* KVA = WSP(WS_KVA, bf16_t); bf16_t* KB = WSP(WS_KB, bf16_t); bf16_t* VB = WSP(WS_VB, bf16_t); const float* rpb = A->in[8];
        for (int u = bx; u < 512; u += G) { const int h = u >> 6, qb = u & 63, kvh = h >> 2;
            att::attn_unit<2048, 512, 2048, false, 1>((const abf*)QAB + (size_t)qb * 256 * 2048 + h * 128, (const abf*)KVA + kvh * 128, (const abf*)KVA + 256 + kvh * 128,
                                                    (abf*)QAB + (size_t)qb * 256 * 2048 + h * 128, SEQ / 64, (char*)lds, nullptr, 0, 0);
        }
        for (int v = bx; v < 512; v += G) { const int h = v >> 6, qb = v & 63; int r_lo = 4 * qb - 4; r_lo = r_lo < 0 ? 0 : (r_lo > 244 ? 244 : r_lo);
            att::attn_unit<2048, 1024, 2048, true, 1>((const abf*)QAB + (size_t)qb * 256 * 2048 + 1024 + h * 128, (const abf*)KB + (size_t)r_lo * 64 * 1024 + h * 128, (const abf*)VB + (size_t)r_lo * 64 * 1024 + h * 128,
                                                   (abf*)QAB + (size_t)qb * 256 * 2048 + 1024 + h * 128, 12, (char*)lds, rpb + h * 15 * 31, 4 * qb, r_lo);
        }
        __syncthreads();
    }
    SEAM(4);
    if (IN(5)) { ArgP A = ARGP(); OPQ();
        pg8::Gemm g{WSP(WS_QAB, bf16_t), WSP(WS_WO, bf16_t), SEQ, DM, DM}; pg8::StaticOrder S; S.init(SEQ, DM, G, bx);
        pg8::EpiMerged E{WSP(WS_GA, bf16_t), WSP(WS_GB, bf16_t), WSP(WS_H, bf16_t)};
        pg8::gemm_phase<pg8::EpiMerged, pg8::StaticOrder, true, true, true>((LAS unsigned char*)lds, g, S, E);
    }
    SEAM(5);
    if (IN(6)) { ArgP A = ARGP(); OPQ();
        pg8::Gemm g{WSP(WS_H, bf16_t), WSP(WS_WOUT, bf16_t), SEQ, DM, DM}; pg8::StaticOrder S; S.init(SEQ, DM, G, bx);
        pg8::EpiResid E{A->in[0], A->out, WSP(WS_MOD, float) + 4096};
        pg8::gemm_phase<pg8::EpiResid, pg8::StaticOrder, true, true, false>((LAS unsigned char*)lds, g, S, E);
    }
    SEAM(6);
    if (IN(7)) { ArgP A = ARGP(); OPQ(); float* mod = WSP(WS_MOD, float); normmod_rows(A->out, A->in[12], mod + 8192, mod + 6144, WSP(WS_H, bf16_t), gw, NGW, lane); }
    SEAM(7);
    if (IN(8)) { ArgP A = ARGP(); OPQ();
        pg8::Gemm g{WSP(WS_H, bf16_t), WSP(WS_WGU, bf16_t), SEQ, 2 * DFF, DM}; pg8::StaticOrder S; S.init(SEQ, 2 * DFF, G, bx);
        pg8::EpiSwiglu E{WSP(WS_ACT, bf16_t)};
        pg8::gemm_phase<pg8::EpiSwiglu, pg8::StaticOrder, true, true, false>((LAS unsigned char*)lds, g, S, E);
    }
    SEAM(8);
    if (IN(9)) { ArgP A = ARGP(); OPQ();
        pg8::Gemm g{WSP(WS_ACT, bf16_t), WSP(WS_WD, bf16_t), SEQ, DM, DFF}; pg8::StaticOrder S; S.init(SEQ, DM, G, bx);
        pg8::EpiResid E{A->out, A->out, WSP(WS_MOD, float) + 10240};
        pg8::gemm_phase<pg8::EpiResid, pg8::StaticOrder, true, true, false>((LAS unsigned char*)lds, g, S, E);
    }
    SEAM(9);
    if (IN(10)) { ArgP A = ARGP(); OPQ(); final_rows(A->out, A->in[16], gw, NGW, lane); }
#undef IN
#undef SEAM
}

#ifndef N_LAUNCHES
#define N_LAUNCHES 1
#endif
extern "C" void kernel_launch(void* const* d_in, const int* in_sizes, int n_in, void* d_out, int out_size, void* d_ws, size_t ws_size, hipStream_t stream) {
    static int grid = 0;
    if (grid == 0) {
        if (n_in != 17 || in_sizes[0] != SEQ * DM || out_size != SEQ * DM || ws_size < WS_END) { fprintf(stderr, "kernel_launch: unexpected shapes: n_in %d in0 %d out %d ws %zu (need %zu)\n", n_in, n_in > 0 ? in_sizes[0] : -1, out_size, ws_size, (size_t)WS_END); grid = -1; return; }
        int dev = 0, cus = 0, per_cu = 0;
        if (hipGetDevice(&dev) != hipSuccess || hipDeviceGetAttribute(&cus, hipDeviceAttributeMultiprocessorCount, dev) != hipSuccess) { fprintf(stderr, "kernel_launch: device query failed\n"); grid = -1; return; }
        if (hipFuncSetAttribute((const void*)fwd, hipFuncAttributeMaxDynamicSharedMemorySize, LDS_BYTES) != hipSuccess) { fprintf(stderr, "kernel_launch: hipFuncSetAttribute failed\n"); grid = -1; return; }
        if (hipOccupancyMaxActiveBlocksPerMultiprocessor(&per_cu, (const void*)fwd, 512, LDS_BYTES) != hipSuccess || per_cu < 1) { fprintf(stderr, "kernel_launch: occupancy query says %d\n", per_cu); per_cu = 1; }
        (void)hipGetLastError();
        grid = cus * per_cu;
        fprintf(stderr, "kernel_launch: grid %d (cus %d x %d)\n", grid, cus, per_cu);
    }
    if (grid < 0) return;
    if (hipMemsetAsync((char*)d_ws + WS_MOD, 0, CTL_ZERO_BYTES, stream) != hipSuccess) { fprintf(stderr, "kernel_launch: memset failed\n"); return; }
    Args a{};
    for (int i = 0; i < 17; ++i) a.in[i] = (const float*)d_in[i];
    a.out = (float*)d_out; a.ws = (unsigned char*)d_ws;
    if (N_LAUNCHES == 1) {
        a.ph_lo = 0; a.ph_hi = NPHASE;
        void* kargs[] = {&a};
        const hipError_t e = hipLaunchCooperativeKernel((const void*)fwd, dim3(grid), dim3(512), kargs, LDS_BYTES, stream);
        if (e != hipSuccess) fprintf(stderr, "kernel_launch: cooperative launch failed: %s (grid %d)\n", hipGetErrorString(e), grid);
    } else {
        for (int p = 0; p < NPHASE; ++p) { a.ph_lo = p; a.ph_hi = p + 1;
            hipLaunchKernelGGL(fwd, dim3(grid), dim3(512), LDS_BYTES, stream, a);
            const hipError_t le = hipPeekAtLastError();
            if (le != hipSuccess) { fprintf(stderr, "kernel_launch: launch %d failed: %s\n", p, hipGetErrorName(le)); break; } }
    }
}
```

```cpp
#include <hip/hip_runtime.h>
#include <hip/hip_bf16.h>
#include <hip/hip_cooperative_groups.h>
#include <cstdio>
#include <cstdint>
#include <cmath>
#define N_LAUNCHES 1
namespace pg8 {
#define PG8_LAS __attribute__((address_space(3)))
typedef unsigned short bf16_t;
typedef short bf16x8 __attribute__((ext_vector_type(8)));
typedef float f32x4 __attribute__((ext_vector_type(4)));
typedef unsigned u32x4 __attribute__((ext_vector_type(4)));
constexpr int BM = 256, BK = 64, HALF = 128, HTB = HALF * BK * 2  , STAGE_BYTES = 8 * HTB, NXCD = 8, WGM = 8;

__host__ __device__ __forceinline__ int lds_byte(int r, int c) { const int st = (r >> 4) * 2 + (c >> 5), rr = r & 15, cc = c & 31, ob = rr * 64 + cc * 2; return st * 1024 + (ob ^ (((ob >> 9) & 1) << 5)); }
__host__ __device__ __forceinline__ void stage_rc(int b, int& R, int& C) { const int st = b / 1024, sb = b % 1024, swz = sb ^ (((sb >> 9) & 1) << 5); R = (st >> 1) * 16 + swz / 64; C = (st & 1) * 32 + (swz % 64) / 2; }
__host__ __device__ __forceinline__ int perm32(int rho) { const int n = rho >> 4, i = rho & 15; return 8 * (i >> 2) + 4 * n + (i & 3); }

struct Unit { int pm, pn; };
struct Gemm { const bf16_t* A; const bf16_t* Bt; int M, N, K; };

struct StaticOrder {
    int nM, nN, nwg, G, c;
    __host__ __device__ void init(int M, int N, int G_, int c_) { nM = M / BM; nN = N / BM; nwg = nM * nN; G = G_; c = c_; }
    __host__ __device__ bool next(int i, Unit& u) const {
        const long L = (long)i * G + c; if (L >= nwg) return false;
        int wgid = (int)L; { const int q = nwg / NXCD, r = nwg % NXCD, xcd = wgid % NXCD, off = wgid / NXCD; wgid = (xcd < r ? xcd * (q + 1) : r * (q + 1) + (xcd - r) * q) + off; }
        const int nig = WGM * nN, gid = wgid / nig, fm = gid * WGM, gsz = (nM - fm) < WGM ? (nM - fm) : WGM;
        u.pm = fm + ((wgid % nig) % gsz); u.pn = (wgid % nig) / gsz; return true;
    }
    __device__ __forceinline__ void a_ready(const Unit&) const {}
    __device__ __forceinline__ void done(const Unit&) const {}
};

__device__ __forceinline__ unsigned cvt_pk_bf16(float lo, float hi) { unsigned r; asm volatile("v_cvt_pk_bf16_f32 %0, %1, %2" : "=v"(r) : "v"(lo), "v"(hi)); return r; }
__device__ __forceinline__ float bflo(unsigned w) { return __uint_as_float(w << 16); }
__device__ __forceinline__ float bfhi(unsigned w) { return __uint_as_float(w & 0xffff0000u); }
struct EpiProj {
    static constexpr bool PERM = true, AFTER_DRAIN = false;
    bf16_t *QAB, *KVA, *KB, *VB, *GA, *GB;
    __device__ __forceinline__ void operator()(const f32x4 (&acc)[2][2][4][2], const Unit& u, int wr, int wc, int fr, int fq) const {
        const int pn = u.pn; bf16_t* base; int ldc, colt;
        if (pn < 4) { base = QAB; ldc = 2048; colt = pn * 256; }
        else if (pn < 6) { base = KVA; ldc = 512; colt = (pn - 4) * 256; }
        else if (pn < 10) { base = QAB; ldc = 2048; colt = 1024 + (pn - 6) * 256; }
        else if (pn < 14) { base = KB; ldc = 1024; colt = (pn - 10) * 256; }
        else if (pn < 18) { base = VB; ldc = 1024; colt = (pn - 14) * 256; }
        else if (pn < 26) { base = GA; ldc = 2048; colt = (pn - 18) * 256; }
        else { base = GB; ldc = 2048; colt = (pn - 26) * 256; }
        const int row0 = u.pm * BM + wr * 64 + fr, col0 = colt + wc * 32 + 8 * fq;
#pragma unroll
        for (int ai = 0; ai < 2; ++ai)
#pragma unroll
            for (int m = 0; m < 4; ++m) { bf16_t* rowp = base + (size_t)(row0 + ai * HALF + m * 16) * ldc + col0;
#pragma unroll
                for (int bj = 0; bj < 2; ++bj) { const f32x4 v0 = acc[ai][bj][m][0], v1 = acc[ai][bj][m][1];
                    u32x4 w; w.x = cvt_pk_bf16(v0[0], v0[1]); w.y = cvt_pk_bf16(v0[2], v0[3]); w.z = cvt_pk_bf16(v1[0], v1[1]); w.w = cvt_pk_bf16(v1[2], v1[3]);
                    *(u32x4*)(rowp + bj * HALF) = w; } }
    }
};
struct EpiMerged {
    static constexpr bool PERM = true, AFTER_DRAIN = false;
    const bf16_t *GA, *GB; bf16_t* O;
    __device__ __forceinline__ void mid(f32x4 (&acc)[2][2][4][2], const Unit& u, int wr, int wc, int fr, int fq) const {
        int row0 = u.pm * BM + wr * 64 + fr; const int col0 = u.pn * BM + wc * 32 + 8 * fq;
        asm volatile("" : "+v"(row0));
#pragma unroll
        for (int ai = 0; ai < 2; ++ai)
#pragma unroll
            for (int m = 0; m < 4; ++m)
#pragma unroll
                for (int bj = 0; bj < 2; ++bj) { const size_t off = (size_t)(row0 + ai * HALF + m * 16) * 2048 + col0 + bj * HALF;
                    const u32x4 a = *(const u32x4*)(GA + off), b = *(const u32x4*)(GB + off);
#pragma unroll
                    for (int e = 0; e < 4; ++e) { const float ga0 = bflo(a[e]), ga1 = bfhi(a[e]), gb0 = bflo(b[e]), gb1 = bfhi(b[e]);
                        const float r0 = (1.f + __expf(-gb0)) / (1.f + __expf(-ga0)), r1 = (1.f + __expf(-gb1)) / (1.f + __expf(-ga1));
                        acc[ai][bj][m][e >> 1][(e & 1) * 2] *= r0; acc[ai][bj][m][e >> 1][(e & 1) * 2 + 1] *= r1; }
                    asm volatile("" ::: "memory"); }
    }
    __device__ __forceinline__ void operator()(const f32x4 (&acc)[2][2][4][2], const Unit& u, int wr, int wc, int fr, int fq) const {
        const int row0 = u.pm * BM + wr * 64 + fr, col0 = u.pn * BM + wc * 32 + 8 * fq;
#pragma unroll
        for (int ai = 0; ai < 2; ++ai)
#pragma unroll
            for (int m = 0; m < 4; ++m)
#pragma unroll
                for (int bj = 0; bj < 2; ++bj) { const size_t off = (size_t)(row0 + ai * HALF + m * 16) * 2048 + col0 + bj * HALF;
                    const u32x4 b = *(const u32x4*)(GB + off); float o[8];
#pragma unroll
                    for (int e = 0; e < 4; ++e) { const float gb0 = bflo(b[e]), gb1 = bfhi(b[e]);
                        o[2 * e] = acc[ai][bj][m][e >> 1][(e & 1) * 2] / (1.f + __expf(-gb0)); o[2 * e + 1] = acc[ai][bj][m][e >> 1][(e & 1) * 2 + 1] / (1.f + __expf(-gb1)); }
                    u32x4 w; w.x = cvt_pk_bf16(o[0], o[1]); w.y = cvt_pk_bf16(o[2], o[3]); w.z = cvt_pk_bf16(o[4], o[5]); w.w = cvt_pk_bf16(o[6], o[7]);
#ifdef PROBE_COARSE_MIX
                    w = (w + 0x00020002u) & 0xfffcfffcu;
#endif
                    *(u32x4*)(O + off) = w; }
    }
};
struct EpiResid {
    static constexpr bool PERM = false, AFTER_DRAIN = false;
    const float* base; float* out; const float* g;
    __device__ __forceinline__ void operator()(const f32x4 (&acc)[2][2][4][2], const Unit& u, int wr, int wc, int fr, int fq) const {
        const int row0 = u.pm * BM + wr * 64 + fr, col0 = u.pn * BM + wc * 32 + 4 * fq;
        f32x4 gv[2][2];
#pragma unroll
        for (int bj = 0; bj < 2; ++bj)
#pragma unroll
            for (int n = 0; n < 2; ++n) gv[bj][n] = *(const f32x4*)(g + col0 + bj * HALF + n * 16);
#pragma unroll
        for (int ai = 0; ai < 2; ++ai)
#pragma unroll
            for (int m = 0; m < 4; ++m) { const size_t off = (size_t)(row0 + ai * HALF + m * 16) * 2048 + col0;
#pragma unroll
                for (int bj = 0; bj < 2; ++bj)
#pragma unroll
                    for (int n = 0; n < 2; ++n) { const f32x4 bs = *(const f32x4*)(base + off + bj * HALF + n * 16);
                        *(f32x4*)(out + off + bj * HALF + n * 16) = bs + gv[bj][n] * acc[ai][bj][m][n]; } }
    }
};
struct EpiSwiglu {
    static constexpr bool PERM = true, AFTER_DRAIN = false;
    bf16_t* O;
    __device__ __forceinline__ void operator()(const f32x4 (&acc)[2][2][4][2], const Unit& u, int wr, int wc, int fr, int fq) const {
        const int row0 = u.pm * BM + wr * 64 + fr, col0 = u.pn * HALF + wc * 32 + 8 * fq;
#pragma unroll
        for (int ai = 0; ai < 2; ++ai)
#pragma unroll
            for (int m = 0; m < 4; ++m) { float o[8];
#pragma unroll
                for (int n = 0; n < 2; ++n)
#pragma unroll
                    for (int e = 0; e < 4; ++e) { const float gt = acc[ai][0][m][n][e], up = acc[ai][1][m][n][e]; o[4 * n + e] = gt * up / (1.f + __expf(-gt)); }
                u32x4 w; w.x = cvt_pk_bf16(o[0], o[1]); w.y = cvt_pk_bf16(o[2], o[3]); w.z = cvt_pk_bf16(o[4], o[5]); w.w = cvt_pk_bf16(o[6], o[7]);
#ifdef PROBE_COARSE_ACT
                w = (w + 0x00020002u) & 0xfffcfffcu;
#endif
                *(u32x4*)(O + (size_t)(row0 + ai * HALF + m * 16) * 5632 + col0) = w; }
    }
};
template <class Epi, class Sched, bool ALIGN_EPI = false, bool SP2 = false, bool MID = false>
__device__ __forceinline__ void gemm_phase(PG8_LAS unsigned char* lds, const Gemm g, const Sched& S, const Epi& E) {
    int tid_ = threadIdx.x; asm volatile("" : "+v"(tid_));
    const int tid = tid_, wid = __builtin_amdgcn_readfirstlane(tid >> 6), lane = tid & 63, wr = wid >> 2, wc = wid & 3, fr = lane & 15, fq = lane >> 4;
    const int K = g.K, nt = K / BK;
    unsigned voffA[2], voffB[2];
#pragma unroll
    for (int i = 0; i < 2; ++i) { int R, C; stage_rc(tid * 16 + i * 8192, R, C); const int Rb = Epi::PERM ? ((R & ~31) + perm32(R & 31)) : R;
        voffA[i] = (unsigned)(R * K + C) * 2u; voffB[i] = (unsigned)(Rb * K + C) * 2u; }
    const size_t kstep = (size_t)(BK * 2);
    const size_t hstep = (size_t)HALF * K * 2;
    const size_t tstep = 2 * hstep;
    const unsigned ldsw = (unsigned)wid * 1024u;
    const int aoff = lds_byte(wr * 64 + fr, fq * 8), boff = lds_byte(wc * 32 + fr, fq * 8);
#define PG8_SA(b, h) (((b) * 2 + (h)) * HTB)
#define PG8_SB(b, h) ((4 + (b) * 2 + (h)) * HTB)
#define PG8_STAGE(bufoff, gbase, voff) do { _Pragma("unroll") for (int _i = 0; _i < 2; ++_i) \
        __builtin_amdgcn_global_load_lds((const unsigned*)((const char*)(gbase) + (voff)[_i]), (PG8_LAS unsigned*)(lds + (bufoff) + ldsw + _i * 8192), 16, 0, 0); } while (0)
#define PG8_LDA(dst, b, h) do { _Pragma("unroll") for (int m = 0; m < 4; ++m) _Pragma("unroll") for (int k = 0; k < 2; ++k) dst[m][k] = *(const PG8_LAS bf16x8*)(lds + PG8_SA(b, h) + aoff + m * 2048 + k * 1024); } while (0)
#define PG8_LDB(dst, b, h) do { _Pragma("unroll") for (int n = 0; n < 2; ++n) _Pragma("unroll") for (int k = 0; k < 2; ++k) dst[n][k] = *(const PG8_LAS bf16x8*)(lds + PG8_SB(b, h) + boff + n * 2048 + k * 1024); } while (0)
#define PG8_MMA(ai, bj, At, Bt) do { __builtin_amdgcn_s_setprio(1); _Pragma("unroll") for (int m = 0; m < 4; ++m) _Pragma("unroll") for (int n = 0; n < 2; ++n) _Pragma("unroll") for (int k = 0; k < 2; ++k) \
        acc[ai][bj][m][n] = __builtin_amdgcn_mfma_f32_16x16x32_bf16(Bt[n][k], At[m][k], acc[ai][bj][m][n], 0, 0, 0); __builtin_amdgcn_s_setprio(0); } while (0)
#define PG8_WAIT_V(n) asm volatile("s_waitcnt vmcnt(" #n ")" ::: "memory")
#define PG8_WAIT_L(n) asm volatile("s_waitcnt lgkmcnt(" #n ")" ::: "memory")
#define PG8_BAR __builtin_amdgcn_s_barrier()
#define PG8_SCHED __builtin_amdgcn_sched_barrier(0)
    Unit cur, nxt; int ui = 0;
    if (!S.next(0, cur)) return;
    f32x4 acc[2][2][4][2];
#pragma unroll
    for (int a = 0; a < 2; ++a)
#pragma unroll
        for (int b = 0; b < 2; ++b)
#pragma unroll
            for (int m = 0; m < 4; ++m)
#pragma unroll
                for (int n = 0; n < 2; ++n) acc[a][b][m][n] = (f32x4){0.f, 0.f, 0.f, 0.f};
    bf16x8 At[4][2], B0[2][2], B1[2][2];
    const char* cA = (const char*)g.A + (size_t)cur.pm * tstep; const char* cB = (const char*)g.Bt + (size_t)cur.pn * tstep;
    S.a_ready(cur);
    if constexpr (SP2) {
        PG8_STAGE(PG8_SB(0, 0), cB, voffB); PG8_STAGE(PG8_SB(0, 1), cB + hstep, voffB); PG8_STAGE(PG8_SA(0, 0), cA, voffA); PG8_STAGE(PG8_SA(0, 1), cA + hstep, voffA);
        if (wr == 1) PG8_BAR;
        PG8_WAIT_V(2); PG8_BAR;
        PG8_STAGE(PG8_SB(1, 0), cB + kstep, voffB); PG8_STAGE(PG8_SA(1, 0), cA + kstep, voffA); PG8_STAGE(PG8_SB(1, 1), cB + hstep + kstep, voffB);
        PG8_WAIT_V(6); PG8_BAR;
    } else {
        PG8_STAGE(PG8_SB(0, 0), cB, voffB); PG8_STAGE(PG8_SA(0, 0), cA, voffA); PG8_STAGE(PG8_SB(0, 1), cB + hstep, voffB); PG8_STAGE(PG8_SA(0, 1), cA + hstep, voffA);
        if (wr == 1) PG8_BAR;
        PG8_WAIT_V(4); PG8_BAR;
        PG8_STAGE(PG8_SB(1, 0), cB + kstep, voffB); PG8_STAGE(PG8_SA(1, 0), cA + kstep, voffA); PG8_STAGE(PG8_SB(1, 1), cB + hstep + kstep, voffB);
        PG8_WAIT_V(6); PG8_BAR;
    }
    for (;;) {
        const bool has_next = S.next(ui + 1, nxt);
        const char* nA = has_next ? (const char*)g.A + (size_t)nxt.pm * tstep : cA; const char* nB = has_next ? (const char*)g.Bt + (size_t)nxt.pn * tstep : cB;
        for (int t = 0; t < nt; t += 2) {
            if constexpr (MID) { if (t == (nt >> 1)) E.mid(acc, cur, wr, wc, fr, fq); }
            const bool last = (t == nt - 2);
            const char* a1 = cA + (size_t)(t + 1) * kstep;
            const char* a2 = last ? nA : cA + (size_t)(t + 2) * kstep; const char* b2 = last ? nB : cB + (size_t)(t + 2) * kstep;
            const char* a3 = a2 + kstep; const char* b3 = b2 + kstep;
            if (last && has_next) S.a_ready(nxt);
            if constexpr (SP2) {
            PG8_LDB(B0, 0, 0); PG8_LDB(B1, 0, 1); PG8_SCHED; PG8_LDA(At, 0, 0); PG8_STAGE(PG8_SA(1, 1), a1 + hstep, voffA);
            PG8_WAIT_V(8); PG8_WAIT_L(0); PG8_BAR; PG8_MMA(0, 0, At, B0); PG8_MMA(0, 1, At, B1); PG8_BAR; PG8_SCHED;
            PG8_LDA(At, 0, 1); PG8_STAGE(PG8_SB(0, 0), b2, voffB); PG8_STAGE(PG8_SB(0, 1), b2 + hstep, voffB); PG8_STAGE(PG8_SA(0, 0), a2, voffA);
            PG8_WAIT_V(8); PG8_WAIT_L(0); PG8_BAR; PG8_MMA(1, 0, At, B0); PG8_MMA(1, 1, At, B1); PG8_BAR; PG8_SCHED;
            PG8_LDB(B0, 1, 0); PG8_LDB(B1, 1, 1); PG8_SCHED; PG8_LDA(At, 1, 0); PG8_STAGE(PG8_SA(0, 1), a2 + hstep, voffA);
            PG8_WAIT_V(8); PG8_WAIT_L(0); PG8_BAR; PG8_MMA(0, 0, At, B0); PG8_MMA(0, 1, At, B1); PG8_BAR; PG8_SCHED;
            PG8_LDA(At, 1, 1); PG8_STAGE(PG8_SB(1, 0), b3, voffB); PG8_STAGE(PG8_SB(1, 1), b3 + hstep, voffB); PG8_STAGE(PG8_SA(1, 0), a3, voffA);
            PG8_WAIT_V(8); PG8_WAIT_L(0); PG8_BAR; PG8_MMA(1, 0, At, B0); PG8_MMA(1, 1, At, B1); PG8_BAR; PG8_SCHED;
            } else {
            PG8_LDB(B0, 0, 0); PG8_SCHED; PG8_LDA(At, 0, 0); PG8_STAGE(PG8_SA(1, 1), a1 + hstep, voffA);
            PG8_WAIT_L(8); PG8_BAR; PG8_WAIT_L(0); PG8_MMA(0, 0, At, B0); PG8_BAR; PG8_SCHED;
            PG8_LDB(B1, 0, 1); PG8_STAGE(PG8_SB(0, 0), b2, voffB);
            PG8_BAR; PG8_WAIT_L(0); PG8_MMA(0, 1, At, B1); PG8_BAR;
            PG8_LDA(At, 0, 1); PG8_STAGE(PG8_SA(0, 0), a2, voffA);
            PG8_BAR; PG8_WAIT_L(0); PG8_MMA(1, 0, At, B0); PG8_BAR; PG8_SCHED;
            PG8_STAGE(PG8_SB(0, 1), b2 + hstep, voffB);
            PG8_WAIT_V(6); PG8_BAR; PG8_MMA(1, 1, At, B1); PG8_BAR;
            PG8_LDB(B0, 1, 0); PG8_SCHED; PG8_LDA(At, 1, 0); PG8_STAGE(PG8_SA(0, 1), a2 + hstep, voffA);
            PG8_WAIT_L(8); PG8_BAR; PG8_WAIT_L(0); PG8_MMA(0, 0, At, B0); PG8_BAR; PG8_SCHED;
            PG8_LDB(B1, 1, 1); PG8_STAGE(PG8_SB(1, 0), b3, voffB);
            PG8_BAR; PG8_WAIT_L(0); PG8_MMA(0, 1, At, B1); PG8_BAR;
            PG8_LDA(At, 1, 1); PG8_STAGE(PG8_SA(1, 0), a3, voffA);
            PG8_BAR; PG8_WAIT_L(0); PG8_MMA(1, 0, At, B0); PG8_BAR; PG8_SCHED;
            PG8_STAGE(PG8_SB(1, 1), b3 + hstep, voffB);
            PG8_WAIT_V(6); PG8_BAR; PG8_MMA(1, 1, At, B1); PG8_BAR;
            }
        }
        if constexpr (ALIGN_EPI) { if (wr == 0) PG8_BAR; }
        if constexpr (!Epi::AFTER_DRAIN) { E(acc, cur, wr, wc, fr, fq); S.done(cur); }
        if (!has_next) break;
#pragma unroll
        for (int a = 0; a < 2; ++a)
#pragma unroll
            for (int b = 0; b < 2; ++b)
#pragma unroll
                for (int m = 0; m < 4; ++m)
#pragma unroll
                    for (int n = 0; n < 2; ++n) acc[a][b][m][n] = (f32x4){0.f, 0.f, 0.f, 0.f};
        cur = nxt; cA = nA; cB = nB; ++ui;
        if constexpr (ALIGN_EPI) { if (wr == 1) PG8_BAR; }
    }
    PG8_WAIT_V(0);
    if constexpr (!ALIGN_EPI) { if (wr == 0) PG8_BAR; }
    PG8_BAR;
    if constexpr (Epi::AFTER_DRAIN) { E.fused(acc, cur, wr, wc, fr, fq, lds, wid, lane); S.done(cur); }
#undef PG8_SA
#undef PG8_SB
#undef PG8_STAGE
#undef PG8_LDA
#undef PG8_LDB
#undef PG8_MMA
#undef PG8_WAIT_V
#undef PG8_WAIT_L
#undef PG8_BAR
#undef PG8_SCHED
}
}
namespace att {
using bf16 = __hip_bfloat16;
constexpr int D = 128, NW = 8, QBLK = 32, KVBLK = 64;
constexpr float SCALE = 0.088388347648318440f;
#ifdef PROBE_THR0
constexpr float THR = 0.f;
#else
constexpr float THR = 8.f;
#endif
constexpr int SDEPTH = 2;
constexpr size_t SHM_V = KVBLK * D * 2, SHM_K = KVBLK * D * 2, SHM_ATTN = 2 * SHM_V + 2 * SHM_K + NW * 64 * 4;
using bf16x8 = __attribute__((ext_vector_type(8))) short;
using s16x4  = __attribute__((ext_vector_type(4))) short;
using f32x16 = __attribute__((ext_vector_type(16))) float;
using f32x8  = __attribute__((ext_vector_type(8))) float;
using u32x4  = __attribute__((ext_vector_type(4))) unsigned;
#define KSWZ(row, colB) ((row) * 256 + ((colB) ^ (((row) & 7) << 4)))
#define SBAR() __builtin_amdgcn_sched_barrier(0)
__device__ __forceinline__ int crow(int r, int hi) { return (r & 3) + 8 * (r >> 2) + 4 * hi; }
__device__ __forceinline__ unsigned cvtpk(float lo, float hi) {
  unsigned r; asm volatile("v_cvt_pk_bf16_f32 %0, %1, %2" : "=v"(r) : "v"(lo), "v"(hi)); return r;
}
template <typename TIn> struct Stage;
template <> struct Stage<bf16>  { using T = bf16x8;
  __device__ static __forceinline__ T ld8(const bf16* p) { return *reinterpret_cast<const bf16x8*>(p); }
  __device__ static __forceinline__ bf16x8 tobf(T x) { return x; } };
template <> struct Stage<float> { using T = f32x8;
  __device__ static __forceinline__ T ld8(const float* p) { return *reinterpret_cast<const f32x8*>(p); }
  __device__ static __forceinline__ bf16x8 tobf(T x) {
    u32x4 w = {cvtpk(x[0], x[1]), cvtpk(x[2], x[3]), cvtpk(x[4], x[5]), cvtpk(x[6], x[7])}; return *reinterpret_cast<bf16x8*>(&w); } };

__device__ __forceinline__ void partialSM(f32x16& p0, f32x16& p1, float& m_reg, float& mn, float& alpha) {
  constexpr float C = SCALE * 1.4426950408889634f;
  float pmax = p0[0]; for (int r = 1; r < 16; ++r) pmax = fmaxf(pmax, p0[r]); for (int r = 0; r < 16; ++r) pmax = fmaxf(pmax, p1[r]);
  { auto rr = __builtin_amdgcn_permlane32_swap(__float_as_uint(pmax), __float_as_uint(pmax), false, false);
    pmax = fmaxf(__uint_as_float(rr[0]), __uint_as_float(rr[1])); }
  if (__builtin_expect(__all(pmax - m_reg <= THR / SCALE), 1)) { mn = m_reg; alpha = 1.f; }
  else { mn = fmaxf(m_reg, pmax); alpha = __builtin_amdgcn_exp2f((m_reg - mn) * C); m_reg = mn; }
  float mnC = -mn * C;
  for (int r = 0; r < 16; ++r) p0[r] = fmaf(p0[r], C, mnC); for (int r = 0; r < 16; ++r) p1[r] = fmaf(p1[r], C, mnC);
  for (int r = 0; r < 16; ++r) p0[r] = __builtin_amdgcn_exp2f(p0[r]);
}
__device__ __forceinline__ void finishSM(f32x16& p0, f32x16& p1, float alpha, float& l_reg, bf16x8& pa0, bf16x8& pa1, bf16x8& pa2, bf16x8& pa3) {
  for (int r = 0; r < 16; ++r) p1[r] = __builtin_amdgcn_exp2f(p1[r]);
  float ps = 0; for (int r = 0; r < 16; ++r) ps += p0[r]; for (int r = 0; r < 16; ++r) ps += p1[r];
  { auto rr = __builtin_amdgcn_permlane32_swap(__float_as_uint(ps), __float_as_uint(ps), false, false);
    ps = __uint_as_float(rr[0]) + __uint_as_float(rr[1]); }
  l_reg = l_reg * alpha + ps;
#define PK4(P, BASE, OUT) do { unsigned a0 = cvtpk(P[BASE + 0], P[BASE + 1]), a1 = cvtpk(P[BASE + 2], P[BASE + 3]);   \
    unsigned b0 = cvtpk(P[BASE + 4], P[BASE + 5]), b1 = cvtpk(P[BASE + 6], P[BASE + 7]);                              \
    auto r0 = __builtin_amdgcn_permlane32_swap(a0, b0, false, false); auto r1 = __builtin_amdgcn_permlane32_swap(a1, b1, false, false); \
    u32x4 w = {r0[0], r1[0], r0[1], r1[1]}; OUT = *reinterpret_cast<bf16x8*>(&w); } while (0)
  PK4(p0, 0, pa0); PK4(p0, 8, pa1); PK4(p1, 0, pa2); PK4(p1, 8, pa3);
#undef PK4
}
__device__ __forceinline__ void qkt(f32x16& p0, f32x16& p1, const bf16* Ks, const bf16x8* qr, int r32, int hi) {
  p0 = f32x16{}; p1 = f32x16{};
  for (int d0 = 0; d0 < 8; ++d0) { int cb = (d0 * 16 + hi * 8) * 2;
    bf16x8 b0 = *reinterpret_cast<const bf16x8*>((const char*)Ks + KSWZ(r32, cb));
    bf16x8 b1 = *reinterpret_cast<const bf16x8*>((const char*)Ks + KSWZ(32 + r32, cb));
    p0 = __builtin_amdgcn_mfma_f32_32x32x16_bf16(b0, qr[d0], p0, 0, 0, 0);
    p1 = __builtin_amdgcn_mfma_f32_32x32x16_bf16(b1, qr[d0], p1, 0, 0, 0); }
}
__device__ __forceinline__ int v_st(int k, int c) { const int kk = (k & ~0xC) | ((k & 4) << 1) | ((k & 8) >> 1); return ((kk >> 3) * 4 + (c >> 5)) * 512 + ((kk & 7) * 32 + (c & 31)) * 2; }
__device__ __forceinline__ int v_rd_base(int lane) { return ((lane & 3) << 3) | (((lane >> 2) & 3) << 6) | (((lane >> 4) & 1) << 5) | (((lane >> 5) & 1) << 8); }
constexpr int v_rd_off(int d0, int ks, int half) { return d0 * 512 + ks * 4096 + half * 2048; }
template <int OFF> __device__ __forceinline__ s16x4 tr_read(int vb) {
  s16x4 r; asm volatile("ds_read_b64_tr_b16 %0, %1 offset:%2" : "=&v"(r) : "v"(vb), "i"(OFF) : "memory"); return r;
}
template <int D0> __device__ __forceinline__ void pv_one(f32x16& od, int vb, bf16x8 pa0, bf16x8 pa1, bf16x8 pa2, bf16x8 pa3) {
  const s16x4 l0 = tr_read<v_rd_off(D0, 0, 0)>(vb), h0 = tr_read<v_rd_off(D0, 0, 1)>(vb), l1 = tr_read<v_rd_off(D0, 1, 0)>(vb), h1 = tr_read<v_rd_off(D0, 1, 1)>(vb);
  const s16x4 l2 = tr_read<v_rd_off(D0, 2, 0)>(vb), h2 = tr_read<v_rd_off(D0, 2, 1)>(vb), l3 = tr_read<v_rd_off(D0, 3, 0)>(vb), h3 = tr_read<v_rd_off(D0, 3, 1)>(vb);
  asm volatile("s_waitcnt lgkmcnt(0)" ::: "memory"); SBAR();
#define PK(L, H) (bf16x8){L[0], L[1], L[2], L[3], H[0], H[1], H[2], H[3]}
  od = __builtin_amdgcn_mfma_f32_32x32x16_bf16(pa0, PK(l0, h0), od, 0, 0, 0);
  od = __builtin_amdgcn_mfma_f32_32x32x16_bf16(pa1, PK(l1, h1), od, 0, 0, 0);
  od = __builtin_amdgcn_mfma_f32_32x32x16_bf16(pa2, PK(l2, h2), od, 0, 0, 0);
  od = __builtin_amdgcn_mfma_f32_32x32x16_bf16(pa3, PK(l3, h3), od, 0, 0, 0);
#undef PK
}
__device__ __forceinline__ void pv_d0(f32x16* o, int vb, bf16x8 pa0, bf16x8 pa1, bf16x8 pa2, bf16x8 pa3) {
  pv_one<0>(o[0], vb, pa0, pa1, pa2, pa3); pv_one<1>(o[1], vb, pa0, pa1, pa2, pa3); pv_one<2>(o[2], vb, pa0, pa1, pa2, pa3); pv_one<3>(o[3], vb, pa0, pa1, pa2, pa3);
}
__device__ __forceinline__ void na_mask(f32x16& p0, f32x16& p1, const float* T, int tb, int kk, bool rowvalid) {
#pragma unroll
  for (int q = 0; q < 4; ++q) {
#pragma unroll
    for (int r = 4 * q; r < 4 * q + 4; ++r) { const int cr = (r & 3) + 8 * (r >> 2);
      const float b0 = T[tb + cr]; const bool v0 = rowvalid && (unsigned)(cr + kk) < 16u; p0[r] = v0 ? p0[r] + b0 : -INFINITY; }
    asm volatile("" ::: "memory");
#pragma unroll
    for (int r = 4 * q; r < 4 * q + 4; ++r) { const int cr = (r & 3) + 8 * (r >> 2);
      const float b1 = T[tb + 32 + cr]; const bool v1 = rowvalid && (unsigned)(cr + 32 + kk) < 16u; p1[r] = v1 ? p1[r] + b1 : -INFINITY; }
    asm volatile("" ::: "memory");
  }
}
template <int LDQ, int LDK, int LDO, bool NA, int SD>
__device__ __forceinline__ void attn_unit(const bf16* Qb, const bf16* __restrict__ Kh, const bf16* __restrict__ Vh, bf16* Ob, int NT, char* lds,
                                          const float* __restrict__ rpb, int qrow0, int krow0) {
  using St = Stage<bf16>;
  int tid_ = threadIdx.x; asm volatile("" : "+v"(tid_));
  const int tid = tid_, wid = __builtin_amdgcn_readfirstlane(tid >> 6), lane = tid & 63, r32 = lane & 31, hi = lane >> 5;
  bf16* V_lds = (bf16*)lds; bf16* K_lds = (bf16*)(lds + 2 * SHM_V);
  float* ws = (float*)(lds + 2 * SHM_V + 2 * SHM_K) + wid * 64; float* li_l = ws; float* al_l = ws + 32;
  float* T = (float*)(lds + SHM_ATTN);
  __syncthreads();
  int na_tb0 = 0, na_kk = 0, na_r = 0, na_rs = 0;
  if constexpr (NA) {
    for (int e = tid; e < 15 * 128; e += 512) { const int rr = e >> 7, x = e & 127; T[e] = (x >= 49 && x <= 79) ? rpb[rr * 31 + x - 49] * (1.0f / SCALE) : 0.f;
#ifdef PROBE_NOBIAS
      T[e] = 0.f;
#endif
    }
    const int c = (wid & 1) * 32 + r32; int cs = c - 8; cs = cs < 0 ? 0 : (cs > 48 ? 48 : cs);
    na_tb0 = 64 - c + 4 * hi; na_kk = 4 * hi - cs;
    na_r = qrow0 + (wid >> 1); na_rs = na_r - 4; na_rs = na_rs < 0 ? 0 : (na_rs > 248 ? 248 : na_rs);
  }
#define NAMASK(P0, P1, ti) do { if constexpr (NA) { SBAR(); const int kr_ = krow0 + (ti); const bool rv_ = (unsigned)(kr_ - na_rs) < 8u; int rr_ = kr_ - na_r + 7; rr_ = rv_ ? rr_ : 0; \
    na_mask(P0, P1, T, na_tb0 + rr_ * 128, na_kk, rv_); SBAR(); } } while (0)
  float m_reg = -1e30f, l_reg = 0; f32x16 o[4] = {}; bf16x8 qr[8];
  const bf16* Qw = Qb + (long)(wid * QBLK + r32) * LDQ + hi * 8;
#pragma unroll
  for (int d0 = 0; d0 < 8; ++d0) qr[d0] = St::ld8(Qw + d0 * 16);
  const int sr = tid >> 4, sc = (tid & 15) * 8, vst0 = v_st(sr, sc), vst1 = v_st(32 + sr, sc);
  const int vb0 = (int)(uintptr_t)V_lds + v_rd_base(lane);
  struct { typename St::T vs0, vs1, ks0, ks1; } sr_[SD];
#define SLOAD(i, k0) do { sr_[i].vs0 = St::ld8(&Vh[(long)((k0) + sr) * LDK + sc]); sr_[i].vs1 = St::ld8(&Vh[(long)((k0) + 32 + sr) * LDK + sc]); \
    sr_[i].ks0 = St::ld8(&Kh[(long)((k0) + sr) * LDK + sc]); sr_[i].ks1 = St::ld8(&Kh[(long)((k0) + 32 + sr) * LDK + sc]); } while (0)
#define SWRITE(b, i) do { *(bf16x8*)((char*)V_lds + (b) * SHM_V + vst0) = St::tobf(sr_[i].vs0);          \
    *(bf16x8*)((char*)V_lds + (b) * SHM_V + vst1) = St::tobf(sr_[i].vs1); int kc = sc * 2;               \
    *(bf16x8*)((char*)K_lds + (b) * SHM_K + KSWZ(sr, kc)) = St::tobf(sr_[i].ks0);                       \
    *(bf16x8*)((char*)K_lds + (b) * SHM_K + KSWZ(32 + sr, kc)) = St::tobf(sr_[i].ks1); } while (0)
#define SWAIT() do { if constexpr (SD == 2) asm volatile("s_waitcnt vmcnt(4)" ::: "memory"); else asm volatile("s_waitcnt vmcnt(0)" ::: "memory"); } while (0)
#define RESC(a) do { if (__any((a) < 1.f)) { if (hi == 0) al_l[r32] = (a); asm volatile("s_waitcnt lgkmcnt(0)" ::: "memory"); \
    for (int d = 0; d < 4; ++d) for (int r = 0; r < 16; ++r) o[d][r] *= al_l[crow(r, hi)]; } } while (0)
  f32x16 pA0, pA1, pB0, pB1; float mnA, mnB, alA, alB; bf16x8 pa0, pa1, pa2, pa3;
  constexpr int SE = 0, SO = SD - 1;
  SLOAD(SE, 0); asm volatile("s_waitcnt vmcnt(0)" ::: "memory"); SWRITE(0, SE); __syncthreads();
  qkt(pA0, pA1, K_lds, qr, r32, hi); NAMASK(pA0, pA1, 0); partialSM(pA0, pA1, m_reg, mnA, alA);
  SLOAD(SO, KVBLK); if constexpr (SD == 2) { if (2 < NT) SLOAD(SE, 2 * KVBLK); }
  SWAIT(); SWRITE(1, SO); __syncthreads();
  for (int j = 1; j + 1 < NT; j += 2) {
    SBAR(); qkt(pB0, pB1, (bf16*)((char*)K_lds + SHM_K), qr, r32, hi);
    finishSM(pA0, pA1, alA, l_reg, pa0, pa1, pa2, pa3); SBAR();
    SLOAD(SO, (j + SD) * KVBLK); SBAR();
    pv_d0(o, vb0, pa0, pa1, pa2, pa3); NAMASK(pB0, pB1, j); partialSM(pB0, pB1, m_reg, mnB, alB);
    __syncthreads(); SWAIT(); SWRITE(0, SE);
    RESC(alB); __syncthreads();
    SBAR(); qkt(pA0, pA1, K_lds, qr, r32, hi);
    finishSM(pB0, pB1, alB, l_reg, pa0, pa1, pa2, pa3); SBAR();
    if (SD == 1 || j + 3 < NT) SLOAD(SE, (j + 1 + SD) * KVBLK); SBAR();
    pv_d0(o, vb0 + (int)SHM_V, pa0, pa1, pa2, pa3); NAMASK(pA0, pA1, j + 1); partialSM(pA0, pA1, m_reg, mnA, alA);
    __syncthreads(); SWAIT(); SWRITE(1, SO);
    RESC(alA); __syncthreads();
  }
  SBAR(); qkt(pB0, pB1, (bf16*)((char*)K_lds + SHM_K), qr, r32, hi);
  finishSM(pA0, pA1, alA, l_reg, pa0, pa1, pa2, pa3); SBAR();
  pv_d0(o, vb0, pa0, pa1, pa2, pa3); NAMASK(pB0, pB1, NT - 1); partialSM(pB0, pB1, m_reg, mnB, alB);
  __syncthreads(); RESC(alB);
  finishSM(pB0, pB1, alB, l_reg, pa0, pa1, pa2, pa3); SBAR();
  pv_d0(o, vb0 + (int)SHM_V, pa0, pa1, pa2, pa3);
  if (hi == 0) li_l[r32] = l_reg; asm volatile("s_waitcnt lgkmcnt(0)" ::: "memory");
  float rli[16];
#pragma unroll
  for (int r = 0; r < 16; ++r) rli[r] = __builtin_amdgcn_rcpf(li_l[crow(r, hi)]);
  bf16* Ow = Ob + (long)(wid * QBLK) * LDO;
#pragma unroll
  for (int r = 0; r < 16; ++r) { const int orow = crow(r, hi);
#pragma unroll
    for (int d0 = 0; d0 < 4; ++d0) { float val_ = o[d0][r] * rli[r];
#ifdef PROBE_ZERO_YB
      if (NA) val_ = 0.f;
#endif
      bf16 bv_ = __float2bfloat16(val_);
#ifdef PROBE_COARSE_MIX
      { unsigned short us_ = __builtin_bit_cast(unsigned short, bv_); us_ = (unsigned short)((us_ + 2u) & 0xfffcu); bv_ = __builtin_bit_cast(bf16, us_); }
#endif
      Ow[(long)orow * LDO + d0 * 32 + r32] = bv_; } }
#undef SLOAD
#undef SWRITE
#undef SWAIT
#undef RESC
#undef NAMASK
}
#undef SBAR
}
namespace cg = cooperative_groups;
#define LAS __attribute__((address_space(3)))
typedef unsigned short bf16_t;
typedef float f32x4 __attribute__((ext_vector_type(4)));
typedef unsigned v4u __attribute__((ext_vector_type(4)));
typedef unsigned v2u __attribute__((ext_vector_type(2)));
constexpr int SEQ = 16384, DM = 2048, DIN = 8704, DFF = 5632, NMOD = 6 * DM;
constexpr float NORM_EPS = 1e-6f;
constexpr size_t MiB = 1u << 20;
constexpr size_t WS_MOD = 0, CTL_ZERO_BYTES = 64 * 1024;
constexpr size_t WS_ROPE = 1 * MiB;
constexpr size_t WS_WIN = 2 * MiB, WS_WO = 36 * MiB, WS_WOUT = 44 * MiB, WS_WGU = 52 * MiB, WS_WD = 96 * MiB;
constexpr size_t WS_H = 120 * MiB;
constexpr size_t WS_QAB = 184 * MiB, WS_KVA = 248 * MiB, WS_KB = 264 * MiB, WS_VB = 296 * MiB, WS_GA = 328 * MiB, WS_GB = 392 * MiB, WS_END = 456 * MiB;
constexpr size_t WS_ACT = 184 * MiB;
constexpr size_t WS_BAR = 49152;
constexpr int LDS_BYTES = 147456, LDS_MISC = 131072;
constexpr int NPHASE = 11;

__device__ __forceinline__ unsigned f2bf(float f) { unsigned u = __builtin_bit_cast(unsigned, f); return (u + 0x7fffu + ((u >> 16) & 1u)) >> 16; }
__device__ __forceinline__ unsigned pk2(float lo, float hi) { return f2bf(lo) | (f2bf(hi) << 16); }
__device__ __forceinline__ float wave_sum(float v) {
#pragma unroll
    for (int o = 1; o < 64; o <<= 1) v += __shfl_xor(v, o);
    return v;
}
__device__ __forceinline__ void transpose_item(const float* __restrict__ W, int N, bf16_t* __restrict__ WT, int ldt, int koff, int mode, LAS float* scr, int item, int lane) {
    const int nblk = N / 32, kb = item / nblk, nb = item % nblk, k0 = 64 * kb, n0 = 32 * nb;
    const int drow0 = mode == 0 ? n0 : ((n0 >> 7) * 256 + (n0 & 127) + (mode == 2 ? 128 : 0));
#pragma unroll 8
    for (int i = 0; i < 32; ++i) { const int kk = 2 * i + (lane >> 5); scr[kk * 33 + (lane & 31)] = W[(size_t)(k0 + kk) * N + n0 + (lane & 31)]; }
    asm volatile("s_waitcnt lgkmcnt(0)" ::: "memory");
    const int c = lane & 7;
#pragma unroll
    for (int j = 0; j < 4; ++j) { const int n = (lane >> 3) + 8 * j; const LAS float* s = scr + (8 * c) * 33 + n;
        v4u o; o.x = pk2(s[0 * 33], s[1 * 33]); o.y = pk2(s[2 * 33], s[3 * 33]); o.z = pk2(s[4 * 33], s[5 * 33]); o.w = pk2(s[6 * 33], s[7 * 33]);
#ifdef PROBE_COARSE_W
        o = (o + 0x00020002u) & 0xfffcfffcu;
#endif
        *(v4u*)(WT + (size_t)(drow0 + n) * ldt + koff + k0 + 8 * c) = o; }
    asm volatile("s_waitcnt lgkmcnt(0)" ::: "memory");
}
__device__ __forceinline__ void gemv_item(const float* __restrict__ cvec, const float* __restrict__ w_ada, const float* __restrict__ b_ada, float* mod, int item, int lane) {
    const int kc = item / 48, jc = item % 48, col = jc * 256 + 4 * lane;
    f32x4 acc = {0.f, 0.f, 0.f, 0.f};
#pragma unroll 8
    for (int kk = 0; kk < 64; ++kk) { const int k = kc * 64 + kk; const float cv = cvec[k]; const float s = cv / (1.f + expf(-cv));
        const f32x4 w = *(const f32x4*)(w_ada + (size_t)k * NMOD + col); acc += w * s; }
    if (kc == 0) acc += *(const f32x4*)(b_ada + col);
#pragma unroll
    for (int e = 0; e < 4; ++e) __hip_atomic_fetch_add(mod + col + e, acc[e], __ATOMIC_RELAXED, __HIP_MEMORY_SCOPE_AGENT);
}
__device__ __forceinline__ void normmod_rows(const float* X, const float* __restrict__ nw, const float* __restrict__ sc, const float* __restrict__ sh, bf16_t* __restrict__ H, int gw, int NGW, int lane) {
    f32x4 a[8], b[8];
#pragma unroll
    for (int j = 0; j < 8; ++j) { const int col = 4 * lane + 256 * j; const f32x4 w = *(const f32x4*)(nw + col), s = *(const f32x4*)(sc + col); a[j] = w * (s + 1.0f); b[j] = *(const f32x4*)(sh + col); }
    for (int m = gw; m < SEQ; m += NGW) {
        const f32x4* xr = (const f32x4*)(X + (size_t)m * DM) + lane; f32x4 v[8]; float ss = 0.f;
#pragma unroll
        for (int j = 0; j < 8; ++j) { v[j] = xr[64 * j]; ss += (v[j].x * v[j].x + v[j].y * v[j].y) + (v[j].z * v[j].z + v[j].w * v[j].w); }
        const float rstd = rsqrtf(wave_sum(ss) * (1.0f / DM) + NORM_EPS);
        v2u* o8 = (v2u*)(H + (size_t)m * DM) + lane;
#pragma unroll
        for (int j = 0; j < 8; ++j) { const f32x4 y = v[j] * rstd * a[j] + b[j]; v2u w; w.x = pk2(y.x, y.y); w.y = pk2(y.z, y.w);
#ifdef PROBE_COARSE_H
            w = (w + 0x00020002u) & 0xfffcfffcu;
#endif
            o8[64 * j] = w; }
    }
}
__device__ __forceinline__ void final_rows(float* X, const float* __restrict__ fw, int gw, int NGW, int lane) {
    f32x4 a[8];
#pragma unroll
    for (int j = 0; j < 8; ++j) a[j] = *(const f32x4*)(fw + 4 * lane + 256 * j);
    for (int m = gw; m < SEQ; m += NGW) {
        f32x4* xr = (f32x4*)(X + (size_t)m * DM) + lane; f32x4 v[8]; float ss = 0.f;
#pragma unroll
        for (int j = 0; j < 8; ++j) { v[j] = xr[64 * j]; ss += (v[j].x * v[j].x + v[j].y * v[j].y) + (v[j].z * v[j].z + v[j].w * v[j].w); }
        const float rstd = rsqrtf(wave_sum(ss) * (1.0f / DM) + NORM_EPS);
#pragma unroll
        for (int j = 0; j < 8; ++j) xr[64 * j] = v[j] * rstd * a[j];
    }
}
__device__ __forceinline__ void qknorm_rope(bf16_t* QAB, bf16_t* KVA, const float* __restrict__ qn, const float* __restrict__ kn, const float* __restrict__ tab, int gw, int NGW, int lane) {
    const int li = lane & 15;
    for (int it = gw * 4 + (lane >> 4); it < SEQ * 10; it += NGW * 4) {
        const int t = it / 10, hs = it - t * 10;
        bf16_t* p = (hs < 8 ? QAB + (size_t)t * 2048 + hs * 128 : KVA + (size_t)t * 512 + (hs - 8) * 128) + 8 * li;
        const float* wn = (hs < 8 ? qn : kn) + 8 * li;
        const v4u raw = *(const v4u*)p; float x[8];
#pragma unroll
        for (int e = 0; e < 4; ++e) { x[2 * e] = __uint_as_float(raw[e] << 16); x[2 * e + 1] = __uint_as_float(raw[e] & 0xffff0000u); }
        float ss = 0.f;
#pragma unroll
        for (int e = 0; e < 8; ++e) ss += x[e] * x[e];
        ss += __shfl_xor(ss, 1); ss += __shfl_xor(ss, 2); ss += __shfl_xor(ss, 4); ss += __shfl_xor(ss, 8);
        const float rstd = rsqrtf(ss * (1.0f / 128.0f) + NORM_EPS);
        const f32x4 w0 = *(const f32x4*)wn, w1 = *(const f32x4*)(wn + 4);
        const float wv[8] = {w0.x, w0.y, w0.z, w0.w, w1.x, w1.y, w1.z, w1.w};
        const int row = t >> 6, col = t & 63;
        const float* cs = tab + 2 * (li < 8 ? (row * 32 + 4 * li) : ((256 + col) * 32 + 4 * (li - 8)));
        const f32x4 c0 = *(const f32x4*)cs, c1 = *(const f32x4*)(cs + 4);
        const float cv[4] = {c0.x, c0.z, c1.x, c1.z}, sv[4] = {c0.y, c0.w, c1.y, c1.w};
        v4u o;
#pragma unroll
        for (int e = 0; e < 4; ++e) { const float y0 = x[2 * e] * rstd * wv[2 * e], y1 = x[2 * e + 1] * rstd * wv[2 * e + 1];
            o[e] = pk2(y0 * cv[e] - y1 * sv[e], y0 * sv[e] + y1 * cv[e]); }
        *(v4u*)p = o;
    }
}

#define XB_TMO      128
#define XB_XCNT(j)  (256  + 64 * (j))
#define XB_XSUB(j)  (1280 + 64 * (j))
#define XB_XGEN(j)  (2304 + 64 * (j))
#define XB_TOP      3328
#define XB_TOPGEN   3392
#define XCD_BAR_WORDS 3456
#define XB_SPIN_CAP (1u << 18)

__device__ __forceinline__ unsigned xb_ld(unsigned* p)              { return __hip_atomic_load(p, __ATOMIC_RELAXED, __HIP_MEMORY_SCOPE_AGENT); }
__device__ __forceinline__ unsigned xb_add(unsigned* p, unsigned v) { return __hip_atomic_fetch_add(p, v, __ATOMIC_RELAXED, __HIP_MEMORY_SCOPE_AGENT); }
__device__ __forceinline__ unsigned xb_xcc_id() { return (unsigned)__builtin_amdgcn_s_getreg((3 << 11) | 20) & 0xFu; }
#define XB_SPIN(cond, bar) do { unsigned _sp = 0; while (cond) { __builtin_amdgcn_s_sleep(1); \
    if ((++_sp & 255u) == 0u) { if (xb_ld(&(bar)[XB_TMO])) break; if (_sp > XB_SPIN_CAP) { atomicAdd(&(bar)[XB_TMO], 1u); break; } } } } while (0)

struct XcdBarrier {
    unsigned* bar; unsigned x;
    volatile LAS unsigned* st;
};

__device__ __forceinline__ XcdBarrier xcd_barrier_post(unsigned* bar, volatile LAS unsigned* st) {
    XcdBarrier b; b.bar = bar; b.x = xb_xcc_id(); b.st = st;
    if (threadIdx.x == 0) (void)xb_add(&bar[XB_XCNT(b.x)], 1u);
    return b;
}
__device__ __forceinline__ void xcd_barrier_complete(unsigned* bar, unsigned x, unsigned& nloc, unsigned& nx) {
    const unsigned G = gridDim.x * gridDim.y * gridDim.z;
    unsigned sum, cnt, mine, sp = 0u;
    for (;;) {
        sum = 0u; cnt = 0u; mine = 0u;
#pragma unroll
        for (unsigned j = 0; j < 16; ++j) { const unsigned c = xb_ld(&bar[XB_XCNT(j)]); sum += c; cnt += (c > 0u) ? 1u : 0u; mine = (j == x) ? c : mine; }
        if (sum == G) break;
        __builtin_amdgcn_s_sleep(1);
        if ((++sp & 255u) == 0u) { if (xb_ld(&bar[XB_TMO])) break; if (sp > XB_SPIN_CAP) { atomicAdd(&bar[XB_TMO], 1u); break; } }
    }
    nloc = mine > 0u ? mine : 1u; nx = cnt > 0u ? cnt : 1u;
}

__device__ __forceinline__ void xcd_barrier(const XcdBarrier& b) {
    asm volatile("s_waitcnt vmcnt(0)" ::: "memory");
    __syncthreads();
    if (threadIdx.x == 0) {
        unsigned* bar = b.bar;
        __builtin_amdgcn_s_waitcnt(0);
        unsigned nloc = b.st[0], nx = b.st[1];
        if (nloc == 0u) { xcd_barrier_complete(bar, b.x, nloc, nx); b.st[0] = nloc; b.st[1] = nx; }
        const unsigned old = xb_add(&bar[XB_XSUB(b.x)], 1u);
        const unsigned gen = old / nloc;
        if (old + 1u == (gen + 1u) * nloc) {
            __builtin_amdgcn_fence(__ATOMIC_RELEASE, "agent");
            asm volatile("s_waitcnt vmcnt(0)" ::: "memory");
            const unsigned og = xb_add(&bar[XB_TOP], 1u);
            const unsigned tg = og / nx;
            if (og + 1u == (tg + 1u) * nx) xb_add(&bar[XB_TOPGEN], 1u);
            else XB_SPIN(xb_ld(&bar[XB_TOPGEN]) == tg, bar);
            __builtin_amdgcn_fence(__ATOMIC_ACQUIRE, "agent");
            xb_add(&bar[XB_XGEN(b.x)], 1u);
            asm volatile("s_waitcnt vmcnt(0)" ::: "memory");
        } else {
            XB_SPIN(xb_ld(&bar[XB_XGEN(b.x)]) == gen, bar);
            __builtin_amdgcn_fence(__ATOMIC_ACQUIRE, "agent");
            asm volatile("s_waitcnt vmcnt(0)" ::: "memory");
        }
    }
    __syncthreads();
}
struct Args { const float* in[17]; float* out; unsigned char* ws; int ph_lo, ph_hi; };
__global__ void __launch_bounds__(512) fwd(Args args) {
    extern __shared__ __attribute__((aligned(16))) unsigned char lds[];
    cg::grid_group grid = cg::this_grid();
    const int tid0 = threadIdx.x;
    const int G0 = gridDim.x, bx0 = blockIdx.x;
    const int lo = args.ph_lo, hi = args.ph_hi;
    volatile LAS unsigned* bst = (volatile LAS unsigned*)((LAS unsigned char*)lds + LDS_MISC);
    if (tid0 < 2) bst[tid0] = 0u;
    __syncthreads();
    const XcdBarrier bar = xcd_barrier_post((unsigned*)(args.ws + WS_BAR), bst);
#ifndef PHASE_MASK
#define PHASE_MASK 0x7ff
#endif
#define IN(k) (((PHASE_MASK >> (k)) & 1) && lo <= (k) && (k) < hi)
#define SEAM(k) do { if (IN(k) && IN((k) + 1)) { if ((k) == 0) grid.sync(); else xcd_barrier(bar); } } while (0)
    typedef const __attribute__((address_space(4))) Args* ArgP;
#define ARGP() ({ ArgP p_ = (ArgP)__builtin_amdgcn_kernarg_segment_ptr(); asm volatile("" : "+s"(p_)); p_; })
#define WSP(off, T) ((T*)(A->ws + (off)))
#define OPQ() int G = G0, bx = bx0; asm volatile("" : "+s"(G), "+s"(bx)); int tid = tid0; asm volatile("" : "+v"(tid)); const int lane = tid & 63, wave = __builtin_amdgcn_readfirstlane(tid >> 6), gw = bx * 8 + wave, NGW = G * 8; (void)gw; (void)NGW; (void)lane

    if (IN(0)) { ArgP A = ARGP(); OPQ();
        const float* cvec = A->in[1]; const float* w_ada = A->in[2]; const float* b_ada = A->in[3]; const float* w_in = A->in[5]; const float* w_oa = A->in[9]; const float* w_ob = A->in[10];
        const float* w_out = A->in[11]; const float* w_g = A->in[13]; const float* w_u = A->in[14]; const float* w_d = A->in[15]; float* mod = WSP(WS_MOD, float); float* tab = WSP(WS_ROPE, float);
        bf16_t* WinT = WSP(WS_WIN, bf16_t); bf16_t* WoT = WSP(WS_WO, bf16_t); bf16_t* WoutT = WSP(WS_WOUT, bf16_t); bf16_t* WguT = WSP(WS_WGU, bf16_t); bf16_t* WdT = WSP(WS_WD, bf16_t);
        LAS float* scr = (LAS float*)((LAS unsigned char*)lds + wave * 16384);
        constexpr int I_GEMV = 32 * 48, I_IN = (DM / 64) * (DIN / 32), I_OA = (1024 / 64) * (DM / 32), I_OUT = (DM / 64) * (DM / 32), I_G = (DM / 64) * (DFF / 32), I_D = (DFF / 64) * (DM / 32);
        constexpr int NITEMS = I_GEMV + I_IN + 2 * I_OA + I_OUT + 2 * I_G + I_D;
        for (int it = gw; it < NITEMS; it += NGW) {
            int r = it;
            if (r < I_GEMV) { gemv_item(cvec, w_ada, b_ada, mod, r, lane); continue; } r -= I_GEMV;
            if (r < I_IN) { transpose_item(w_in, DIN, WinT, DM, 0, 0, scr, r, lane); continue; } r -= I_IN;
            if (r < I_OA) { transpose_item(w_oa, DM, WoT, 2048, 0, 0, scr, r, lane); continue; } r -= I_OA;
            if (r < I_OA) { transpose_item(w_ob, DM, WoT, 2048, 1024, 0, scr, r, lane); continue; } r -= I_OA;
            if (r < I_OUT) { transpose_item(w_out, DM, WoutT, DM, 0, 0, scr, r, lane); continue; } r -= I_OUT;
            if (r < I_G) { transpose_item(w_g, DFF, WguT, DM, 0, 1, scr, r, lane); continue; } r -= I_G;
            if (r < I_G) { transpose_item(w_u, DFF, WguT, DM, 0, 2, scr, r, lane); continue; } r -= I_G;
            transpose_item(w_d, DM, WdT, DFF, 0, 0, scr, r, lane);
        }
        for (int e = bx * 512 + tid; e < 320 * 32; e += G * 512) { const int pos = e >> 5, j = e & 31; const float p = (float)(pos < 256 ? pos : pos - 256);
            const float inv = powf(10000.0f, -(float)(2 * j) / 64.0f); const float ang = p * inv; tab[2 * e] = cosf(ang); tab[2 * e + 1] = sinf(ang);
#ifdef PROBE_NOROPE
            tab[2 * e] = 1.f; tab[2 * e + 1] = 0.f;
#endif
        }
    }
    SEAM(0);
#ifdef PROBE_XSYNC
    for (int i_ = 0; i_ < 10; ++i_) grid.sync();
#endif
    if (IN(1)) { ArgP A = ARGP(); OPQ(); float* mod = WSP(WS_MOD, float); normmod_rows(A->in[0], A->in[4], mod + 2048, mod + 0, WSP(WS_H, bf16_t), gw, NGW, lane); }
    SEAM(1);
    if (IN(2)) { ArgP A = ARGP(); OPQ();
        pg8::Gemm g{WSP(WS_H, bf16_t), WSP(WS_WIN, bf16_t), SEQ, DIN, DM}; pg8::StaticOrder S; S.init(SEQ, DIN, G, bx);
        pg8::EpiProj E{WSP(WS_QAB, bf16_t), WSP(WS_KVA, bf16_t), WSP(WS_KB, bf16_t), WSP(WS_VB, bf16_t), WSP(WS_GA, bf16_t), WSP(WS_GB, bf16_t)};
        pg8::gemm_phase<pg8::EpiProj, pg8::StaticOrder, true, true, false>((LAS unsigned char*)lds, g, S, E);
    }
    SEAM(2);
#ifdef PROBE_DUP_P2
    if (IN(2)) { ArgP A = ARGP(); OPQ();
        pg8::Gemm g{WSP(WS_H, bf16_t), WSP(WS_WIN, bf16_t), SEQ, DIN, DM}; pg8::StaticOrder S; S.init(SEQ, DIN, G, bx);
        pg8::EpiProj E{WSP(WS_QAB, bf16_t), WSP(WS_KVA, bf16_t), WSP(WS_KB, bf16_t), WSP(WS_VB, bf16_t), WSP(WS_GA, bf16_t), WSP(WS_GB, bf16_t)};
        pg8::gemm_phase<pg8::EpiProj, pg8::StaticOrder, true, true, false>((LAS unsigned char*)lds, g, S, E);
    }
    grid.sync();
#endif
    if (IN(3)) { ArgP A = ARGP(); OPQ(); qknorm_rope(WSP(WS_QAB, bf16_t), WSP(WS_KVA, bf16_t), A->in[6], A->in[7], WSP(WS_ROPE, float), gw, NGW, lane); }
    SEAM(3);
    if (IN(4)) { ArgP A = ARGP(); OPQ();
        using abf = att::bf16; bf16_t* QAB = WSP(WS_QAB, bf16_t); bf16_t* KVA = WSP(WS_KVA, bf16_t); bf16_t* KB = WSP(WS_KB, bf16_t); bf16_t* VB = WSP(WS_VB, bf16_t); const float* rpb = A->in[8];
        for (int u = bx; u < 512; u += G) { const int h = u >> 6, qb = u & 63, kvh = h >> 2;
            att::attn_unit<2048, 512, 2048, false, 1>((const abf*)QAB + (size_t)qb * 256 * 2048 + h * 128, (const abf*)KVA + kvh * 128, (const abf*)KVA + 256 + kvh * 128,
                                                    (abf*)QAB + (size_t)qb * 256 * 2048 + h * 128, SEQ / 64, (char*)lds, nullptr, 0, 0);
        }
        for (int v = bx; v < 512; v += G) { const int h = v >> 6, qb = v & 63; int r_lo = 4 * qb - 4; r_lo = r_lo < 0 ? 0 : (r_lo > 244 ? 244 : r_lo);
            att::attn_unit<2048, 1024, 2048, true, 1>((const abf*)QAB + (size_t)qb * 256 * 2048 + 1024 + h * 128, (const abf*)KB + (size_t)r_lo * 64 * 1024 + h * 128, (const abf*)VB + (size_t)r_lo * 64 * 1024 + h * 128,
                                                   (abf*)QAB + (size_t)qb * 256 * 2048 + 1024 + h * 128, 12, (char*)lds, rpb + h * 15 * 31, 4 * qb, r_lo);
        }
        __syncthreads();
    }
    SEAM(4);
    if (IN(5)) { ArgP A = ARGP(); OPQ();
        pg8::Gemm g{WSP(WS_QAB, bf16_t), WSP(WS_WO, bf16_t), SEQ, DM, DM}; pg8::StaticOrder S; S.init(SEQ, DM, G, bx);
        pg8::EpiMerged E{WSP(WS_GA, bf16_t), WSP(WS_GB, bf16_t), WSP(WS_H, bf16_t)};
        pg8::gemm_phase<pg8::EpiMerged, pg8::StaticOrder, true, true, true>((LAS unsigned char*)lds, g, S, E);
    }
    SEAM(5);
    if (IN(6)) { ArgP A = ARGP(); OPQ();
        pg8::Gemm g{WSP(WS_H, bf16_t), WSP(WS_WOUT, bf16_t), SEQ, DM, DM}; pg8::StaticOrder S; S.init(SEQ, DM, G, bx);
        pg8::EpiResid E{A->in[0], A->out, WSP(WS_MOD, float) + 4096};
        pg8::gemm_phase<pg8::EpiResid, pg8::StaticOrder, true, true, false>((LAS unsigned char*)lds, g, S, E);
    }
    SEAM(6);
    if (IN(7)) { ArgP A = ARGP(); OPQ(); float* mod = WSP(WS_MOD, float); normmod_rows(A->out, A->in[12], mod + 8192, mod + 6144, WSP(WS_H, bf16_t), gw, NGW, lane); }
    SEAM(7);
    if (IN(8)) { ArgP A = ARGP(); OPQ();
        pg8::Gemm g{WSP(WS_H, bf16_t), WSP(WS_WGU, bf16_t), SEQ, 2 * DFF, DM}; pg8::StaticOrder S; S.init(SEQ, 2 * DFF, G, bx);
        pg8::EpiSwiglu E{WSP(WS_ACT, bf16_t)};
        pg8::gemm_phase<pg8::EpiSwiglu, pg8::StaticOrder, true, true, false>((LAS unsigned char*)lds, g, S, E);
    }
    SEAM(8);
    if (IN(9)) { ArgP A = ARGP(); OPQ();
        pg8::Gemm g{WSP(WS_ACT, bf16_t), WSP(WS_WD, bf16_t), SEQ, DM, DFF}; pg8::StaticOrder S; S.init(SEQ, DM, G, bx);
        pg8::EpiResid E{A->out, A->out, WSP(WS_MOD, float) + 10240};
        pg8::gemm_phase<pg8::EpiResid, pg8::StaticOrder, true, true, false>((LAS unsigned char*)lds, g, S, E);
    }
    SEAM(9);
    if (IN(10)) { ArgP A = ARGP(); OPQ(); final_rows(A->out, A->in[16], gw, NGW, lane); }
#undef IN
#undef SEAM
}

#ifndef N_LAUNCHES
#define N_LAUNCHES 1
#endif
extern "C" void kernel_launch(void* const* d_in, const int* in_sizes, int n_in, void* d_out, int out_size, void* d_ws, size_t ws_size, hipStream_t stream) {
    static int grid = 0;
    if (grid == 0) {
        if (n_in != 17 || in_sizes[0] != SEQ * DM || out_size != SEQ * DM || ws_size < WS_END) { fprintf(stderr, "kernel_launch: unexpected shapes: n_in %d in0 %d out %d ws %zu (need %zu)\n", n_in, n_in > 0 ? in_sizes[0] : -1, out_size, ws_size, (size_t)WS_END); grid = -1; return; }
        int dev = 0, cus = 0, per_cu = 0;
        if (hipGetDevice(&dev) != hipSuccess || hipDeviceGetAttribute(&cus, hipDeviceAttributeMultiprocessorCount, dev) != hipSuccess) { fprintf(stderr, "kernel_launch: device query failed\n"); grid = -1; return; }
        if (hipFuncSetAttribute((const void*)fwd, hipFuncAttributeMaxDynamicSharedMemorySize, LDS_BYTES) != hipSuccess) { fprintf(stderr, "kernel_launch: hipFuncSetAttribute failed\n"); grid = -1; return; }
        if (hipOccupancyMaxActiveBlocksPerMultiprocessor(&per_cu, (const void*)fwd, 512, LDS_BYTES) != hipSuccess || per_cu < 1) { fprintf(stderr, "kernel_launch: occupancy query says %d\n", per_cu); per_cu = 1; }
        (void)hipGetLastError();
        grid = cus * per_cu;
        fprintf(stderr, "kernel_launch: grid %d (cus %d x %d)\n", grid, cus, per_cu);
    }
    if (grid < 0) return;
    if (hipMemsetAsync((char*)d_ws + WS_MOD, 0, CTL_ZERO_BYTES, stream) != hipSuccess) { fprintf(stderr, "kernel_launch: memset failed\n"); return; }
    Args a{};
    for (int i = 0; i < 17; ++i) a.in[i] = (const float*)d_in[i];
    a.out = (float*)d_out; a.ws = (unsigned char*)d_ws;
    if (N_LAUNCHES == 1) {
        a.ph_lo = 0; a.ph_hi = NPHASE;
        void* kargs[] = {&a};
        const hipError_t e = hipLaunchCooperativeKernel((const void*)fwd, dim3(grid), dim3(512), kargs, LDS_BYTES, stream);
        if (e != hipSuccess) fprintf(stderr, "kernel_launch: cooperative launch failed: %s (grid %d)\n", hipGetErrorString(e), grid);
    } else {
        for (int p = 0; p < NPHASE; ++p) { a.ph_lo = p; a.ph_hi = p + 1;
            hipLaunchKernelGGL(fwd, dim3(grid), dim3(512), LDS_BYTES, stream, a);
            const hipError_t le = hipPeekAtLastError();
            if (le != hipSuccess) { fprintf(stderr, "kernel_launch: launch %d failed: %s\n", p, hipGetErrorName(le)); break; } }
    }
}
```

```cpp
#include <hip/hip_runtime.h>
#include <hip/hip_bf16.h>
#include <hip/hip_cooperative_groups.h>
#include <cstdio>
#include <cstdint>
#include <cmath>
#define N_LAUNCHES 1
namespace pg8 {
#define PG8_LAS __attribute__((address_space(3)))
typedef unsigned short bf16_t;
typedef short bf16x8 __attribute__((ext_vector_type(8)));
typedef float f32x4 __attribute__((ext_vector_type(4)));
typedef unsigned u32x4 __attribute__((ext_vector_type(4)));
constexpr int BM = 256, BK = 64, HALF = 128, HTB = HALF * BK * 2  , STAGE_BYTES = 8 * HTB, NXCD = 8, WGM = 8;

__host__ __device__ __forceinline__ int lds_byte(int r, int c) { const int st = (r >> 4) * 2 + (c >> 5), rr = r & 15, cc = c & 31, ob = rr * 64 + cc * 2; return st * 1024 + (ob ^ (((ob >> 9) & 1) << 5)); }
__host__ __device__ __forceinline__ void stage_rc(int b, int& R, int& C) { const int st = b / 1024, sb = b % 1024, swz = sb ^ (((sb >> 9) & 1) << 5); R = (st >> 1) * 16 + swz / 64; C = (st & 1) * 32 + (swz % 64) / 2; }
__host__ __device__ __forceinline__ int perm32(int rho) { const int n = rho >> 4, i = rho & 15; return 8 * (i >> 2) + 4 * n + (i & 3); }

struct Unit { int pm, pn; };
struct Gemm { const bf16_t* A; const bf16_t* Bt; int M, N, K, ld; };

struct StaticOrder {
    int nM, nN, nwg, G, c;
    __host__ __device__ void init(int M, int N, int G_, int c_) { nM = M / BM; nN = N / BM; nwg = nM * nN; G = G_; c = c_; }
    __host__ __device__ bool next(int i, Unit& u) const {
        const long L = (long)i * G + c; if (L >= nwg) return false;
        int wgid = (int)L; { const int q = nwg / NXCD, r = nwg % NXCD, xcd = wgid % NXCD, off = wgid / NXCD; wgid = (xcd < r ? xcd * (q + 1) : r * (q + 1) + (xcd - r) * q) + off; }
        const int nig = WGM * nN, gid = wgid / nig, fm = gid * WGM, gsz = (nM - fm) < WGM ? (nM - fm) : WGM;
        u.pm = fm + ((wgid % nig) % gsz); u.pn = (wgid % nig) / gsz; return true;
    }
    __device__ __forceinline__ void a_ready(const Unit&) const {}
    __device__ __forceinline__ void done(const Unit&) const {}
};

__device__ __forceinline__ unsigned cvt_pk_bf16(float lo, float hi) { unsigned r; asm volatile("v_cvt_pk_bf16_f32 %0, %1, %2" : "=v"(r) : "v"(lo), "v"(hi)); return r; }
constexpr int PH = 2176  , PA = 5760  , PKV = 640  , PNB = 1152  ;
__device__ __forceinline__ float bflo(unsigned w) { return __uint_as_float(w << 16); }
__device__ __forceinline__ float bfhi(unsigned w) { return __uint_as_float(w & 0xffff0000u); }
struct EpiProj {
    static constexpr bool PERM = true, AFTER_DRAIN = false;
    bf16_t *QAB, *KVA, *KB, *VB, *GA, *GB;
    __device__ __forceinline__ void operator()(const f32x4 (&acc)[2][2][4][2], const Unit& u, int wr, int wc, int fr, int fq) const {
        const int pn = u.pn; bf16_t* base; int ldc, colt;
        if (pn < 4) { base = QAB; ldc = PH; colt = pn * 256; }
        else if (pn < 6) { base = KVA; ldc = PKV; colt = (pn - 4) * 256; }
        else if (pn < 10) { base = QAB; ldc = PH; colt = 1024 + (pn - 6) * 256; }
        else if (pn < 14) { base = KB; ldc = PNB; colt = (pn - 10) * 256; }
        else if (pn < 18) { base = VB; ldc = PNB; colt = (pn - 14) * 256; }
        else if (pn < 26) { base = GA; ldc = PH; colt = (pn - 18) * 256; }
        else { base = GB; ldc = PH; colt = (pn - 26) * 256; }
        const int row0 = u.pm * BM + wr * 64 + fr, col0 = colt + wc * 32 + 8 * fq;
#pragma unroll
        for (int ai = 0; ai < 2; ++ai)
#pragma unroll
            for (int m = 0; m < 4; ++m) { bf16_t* rowp = base + (size_t)(row0 + ai * HALF + m * 16) * ldc + col0;
#pragma unroll
                for (int bj = 0; bj < 2; ++bj) { const f32x4 v0 = acc[ai][bj][m][0], v1 = acc[ai][bj][m][1];
                    u32x4 w; w.x = cvt_pk_bf16(v0[0], v0[1]); w.y = cvt_pk_bf16(v0[2], v0[3]); w.z = cvt_pk_bf16(v1[0], v1[1]); w.w = cvt_pk_bf16(v1[2], v1[3]);
                    *(u32x4*)(rowp + bj * HALF) = w; } }
    }
};
struct EpiMerged {
    static constexpr bool PERM = true, AFTER_DRAIN = false;
    const bf16_t *GA, *GB; bf16_t* O;
    __device__ __forceinline__ void mid(f32x4 (&acc)[2][2][4][2], const Unit& u, int wr, int wc, int fr, int fq) const {
        int row0 = u.pm * BM + wr * 64 + fr; const int col0 = u.pn * BM + wc * 32 + 8 * fq;
        asm volatile("" : "+v"(row0));
#pragma unroll
        for (int ai = 0; ai < 2; ++ai)
#pragma unroll
            for (int m = 0; m < 4; ++m)
#pragma unroll
                for (int bj = 0; bj < 2; ++bj) { const size_t off = (size_t)(row0 + ai * HALF + m * 16) * PH + col0 + bj * HALF;
                    const u32x4 a = *(const u32x4*)(GA + off), b = *(const u32x4*)(GB + off);
#pragma unroll
                    for (int e = 0; e < 4; ++e) { const float ga0 = bflo(a[e]), ga1 = bfhi(a[e]), gb0 = bflo(b[e]), gb1 = bfhi(b[e]);
                        const float r0 = (1.f + __expf(-gb0)) * __builtin_amdgcn_rcpf(1.f + __expf(-ga0)), r1 = (1.f + __expf(-gb1)) * __builtin_amdgcn_rcpf(1.f + __expf(-ga1));
                        acc[ai][bj][m][e >> 1][(e & 1) * 2] *= r0; acc[ai][bj][m][e >> 1][(e & 1) * 2 + 1] *= r1; }
                    asm volatile("" ::: "memory"); }
    }
    __device__ __forceinline__ void operator()(const f32x4 (&acc)[2][2][4][2], const Unit& u, int wr, int wc, int fr, int fq) const {
        const int row0 = u.pm * BM + wr * 64 + fr, col0 = u.pn * BM + wc * 32 + 8 * fq;
#pragma unroll
        for (int ai = 0; ai < 2; ++ai)
#pragma unroll
            for (int m = 0; m < 4; ++m)
#pragma unroll
                for (int bj = 0; bj < 2; ++bj) { const size_t off = (size_t)(row0 + ai * HALF + m * 16) * PH + col0 + bj * HALF;
                    const u32x4 b = *(const u32x4*)(GB + off); float o[8];
#pragma unroll
                    for (int e = 0; e < 4; ++e) { const float gb0 = bflo(b[e]), gb1 = bfhi(b[e]);
                        o[2 * e] = acc[ai][bj][m][e >> 1][(e & 1) * 2] * __builtin_amdgcn_rcpf(1.f + __expf(-gb0)); o[2 * e + 1] = acc[ai][bj][m][e >> 1][(e & 1) * 2 + 1] * __builtin_amdgcn_rcpf(1.f + __expf(-gb1)); }
                    u32x4 w; w.x = cvt_pk_bf16(o[0], o[1]); w.y = cvt_pk_bf16(o[2], o[3]); w.z = cvt_pk_bf16(o[4], o[5]); w.w = cvt_pk_bf16(o[6], o[7]);
                    *(u32x4*)(O + off) = w; }
    }
};
struct EpiResid {
    static constexpr bool PERM = false, AFTER_DRAIN = false;
    const float* base; float* out; const float* g;
    __device__ __forceinline__ void operator()(const f32x4 (&acc)[2][2][4][2], const Unit& u, int wr, int wc, int fr, int fq) const {
        const int row0 = u.pm * BM + wr * 64 + fr, col0 = u.pn * BM + wc * 32 + 4 * fq;
        f32x4 gv[2][2];
#pragma unroll
        for (int bj = 0; bj < 2; ++bj)
#pragma unroll
            for (int n = 0; n < 2; ++n) gv[bj][n] = *(const f32x4*)(g + col0 + bj * HALF + n * 16);
#pragma unroll
        for (int ai = 0; ai < 2; ++ai)
#pragma unroll
            for (int m = 0; m < 4; ++m) { const size_t off = (size_t)(row0 + ai * HALF + m * 16) * 2048 + col0;
#pragma unroll
                for (int bj = 0; bj < 2; ++bj)
#pragma unroll
                    for (int n = 0; n < 2; ++n) { const f32x4 bs = *(const f32x4*)(base + off + bj * HALF + n * 16);
                        *(f32x4*)(out + off + bj * HALF + n * 16) = bs + gv[bj][n] * acc[ai][bj][m][n]; } }
    }
};
struct EpiSwiglu {
    static constexpr bool PERM = true, AFTER_DRAIN = false;
    bf16_t* O;
    __device__ __forceinline__ void operator()(const f32x4 (&acc)[2][2][4][2], const Unit& u, int wr, int wc, int fr, int fq) const {
        const int row0 = u.pm * BM + wr * 64 + fr, col0 = u.pn * HALF + wc * 32 + 8 * fq;
#pragma unroll
        for (int ai = 0; ai < 2; ++ai)
#pragma unroll
            for (int m = 0; m < 4; ++m) { float o[8];
#pragma unroll
                for (int n = 0; n < 2; ++n)
#pragma unroll
                    for (int e = 0; e < 4; ++e) { const float gt = acc[ai][0][m][n][e], up = acc[ai][1][m][n][e]; o[4 * n + e] = gt * up * __builtin_amdgcn_rcpf(1.f + __expf(-gt)); }
                u32x4 w; w.x = cvt_pk_bf16(o[0], o[1]); w.y = cvt_pk_bf16(o[2], o[3]); w.z = cvt_pk_bf16(o[4], o[5]); w.w = cvt_pk_bf16(o[6], o[7]);
                *(u32x4*)(O + (size_t)(row0 + ai * HALF + m * 16) * PA + col0) = w; }
    }
};

struct EpiNull {
    static constexpr bool PERM = false, AFTER_DRAIN = false;
    float* out;
    __device__ __forceinline__ void operator()(const f32x4 (&acc)[2][2][4][2], const Unit& u, int wr, int wc, int fr, int fq) const {
        f32x4 s = {0.f, 0.f, 0.f, 0.f};
#pragma unroll
        for (int ai = 0; ai < 2; ++ai)
#pragma unroll
            for (int bj = 0; bj < 2; ++bj)
#pragma unroll
                for (int m = 0; m < 4; ++m)
#pragma unroll
                    for (int n = 0; n < 2; ++n) s += acc[ai][bj][m][n];
        if (s[0] + s[1] + s[2] + s[3] == 123456.789f) out[u.pm] = 1.f;
    }
};

struct EpiDelta {
    static constexpr bool PERM = true, AFTER_DRAIN = false;
    bf16_t* O; const float* g;
    __device__ __forceinline__ void operator()(const f32x4 (&acc)[2][2][4][2], const Unit& u, int wr, int wc, int fr, int fq) const {
        const int row0 = u.pm * BM + wr * 64 + fr, col0 = u.pn * BM + wc * 32 + 8 * fq;
        f32x4 gv[2][2];
#pragma unroll
        for (int bj = 0; bj < 2; ++bj)
#pragma unroll
            for (int n = 0; n < 2; ++n) gv[bj][n] = *(const f32x4*)(g + col0 + bj * HALF + 4 * n);
#pragma unroll
        for (int ai = 0; ai < 2; ++ai)
#pragma unroll
            for (int m = 0; m < 4; ++m) { bf16_t* rowp = O + (size_t)(row0 + ai * HALF + m * 16) * PH + col0;
#pragma unroll
                for (int bj = 0; bj < 2; ++bj) { const f32x4 v0 = acc[ai][bj][m][0] * gv[bj][0], v1 = acc[ai][bj][m][1] * gv[bj][1];
                    u32x4 w; w.x = cvt_pk_bf16(v0[0], v0[1]); w.y = cvt_pk_bf16(v0[2], v0[3]); w.z = cvt_pk_bf16(v1[0], v1[1]); w.w = cvt_pk_bf16(v1[2], v1[3]);
                    *(u32x4*)(rowp + bj * HALF) = w; } }
    }
};
template <class Epi, class Sched, bool ALIGN_EPI = false, bool SP2 = false, bool MID = false>
__device__ __forceinline__ void gemm_phase(PG8_LAS unsigned char* lds, const Gemm g, const Sched& S, const Epi& E, int tid_in) {
    int tid_ = tid_in; asm volatile("" : "+v"(tid_));
    const int tid = tid_, wid = __builtin_amdgcn_readfirstlane(tid >> 6), lane = tid & 63, wr = wid >> 2, wc = wid & 3, fr = lane & 15, fq = lane >> 4;
    const int K = g.K, nt = K / BK, LD = g.ld;
    unsigned voffA[2], voffB[2];
#pragma unroll
    for (int i = 0; i < 2; ++i) { int R, C; stage_rc(tid * 16 + i * 8192, R, C); const int Rb = Epi::PERM ? ((R & ~31) + perm32(R & 31)) : R;
        voffA[i] = (unsigned)(R * LD + C) * 2u; voffB[i] = (unsigned)(Rb * LD + C) * 2u; }
    const size_t kstep = (size_t)(BK * 2);
    const size_t hstep = (size_t)HALF * LD * 2;
    const size_t tstep = 2 * hstep;
    const unsigned ldsw = (unsigned)wid * 1024u;
    const int aoff = lds_byte(wr * 64 + fr, fq * 8), boff = lds_byte(wc * 32 + fr, fq * 8);
#define PG8_SA(b, h) (((b) * 2 + (h)) * HTB)
#define PG8_SB(b, h) ((4 + (b) * 2 + (h)) * HTB)
#define PG8_STAGE(bufoff, gbase, voff) do { _Pragma("unroll") for (int _i = 0; _i < 2; ++_i) \
        __builtin_amdgcn_global_load_lds((const unsigned*)((const char*)(gbase) + (voff)[_i]), (PG8_LAS unsigned*)(lds + (bufoff) + ldsw + _i * 8192), 16, 0, 0); } while (0)
#define PG8_LDA(dst, b, h) do { _Pragma("unroll") for (int m = 0; m < 4; ++m) _Pragma("unroll") for (int k = 0; k < 2; ++k) dst[m][k] = *(const PG8_LAS bf16x8*)(lds + PG8_SA(b, h) + aoff + m * 2048 + k * 1024); } while (0)
#define PG8_LDB(dst, b, h) do { _Pragma("unroll") for (int n = 0; n < 2; ++n) _Pragma("unroll") for (int k = 0; k < 2; ++k) dst[n][k] = *(const PG8_LAS bf16x8*)(lds + PG8_SB(b, h) + boff + n * 2048 + k * 1024); } while (0)
#define PG8_MMA(ai, bj, At, Bt) do { __builtin_amdgcn_s_setprio(1); _Pragma("unroll") for (int m = 0; m < 4; ++m) _Pragma("unroll") for (int n = 0; n < 2; ++n) _Pragma("unroll") for (int k = 0; k < 2; ++k) \
        acc[ai][bj][m][n] = __builtin_amdgcn_mfma_f32_16x16x32_bf16(Bt[n][k], At[m][k], acc[ai][bj][m][n], 0, 0, 0); __builtin_amdgcn_s_setprio(0); } while (0)
#define PG8_WAIT_V(n) asm volatile("s_waitcnt vmcnt(" #n ")" ::: "memory")
#define PG8_WAIT_L(n) asm volatile("s_waitcnt lgkmcnt(" #n ")" ::: "memory")
#define PG8_BAR __builtin_amdgcn_s_barrier()
#define PG8_SCHED __builtin_amdgcn_sched_barrier(0)
    Unit cur, nxt; int ui = 0;
    if (!S.next(0, cur)) return;
    f32x4 acc[2][2][4][2];
#pragma unroll
    for (int a = 0; a < 2; ++a)
#pragma unroll
        for (int b = 0; b < 2; ++b)
#pragma unroll
            for (int m = 0; m < 4; ++m)
#pragma unroll
                for (int n = 0; n < 2; ++n) acc[a][b][m][n] = (f32x4){0.f, 0.f, 0.f, 0.f};
    bf16x8 At[4][2], B0[2][2], B1[2][2];
    const char* cA = (const char*)g.A + (size_t)cur.pm * tstep; const char* cB = (const char*)g.Bt + (size_t)cur.pn * tstep;
    S.a_ready(cur);
    if constexpr (SP2) {
        PG8_STAGE(PG8_SB(0, 0), cB, voffB); PG8_STAGE(PG8_SB(0, 1), cB + hstep, voffB); PG8_STAGE(PG8_SA(0, 0), cA, voffA); PG8_STAGE(PG8_SA(0, 1), cA + hstep, voffA);
        if (wr == 1) PG8_BAR;
        PG8_WAIT_V(2); PG8_BAR;
        PG8_STAGE(PG8_SB(1, 0), cB + kstep, voffB); PG8_STAGE(PG8_SA(1, 0), cA + kstep, voffA); PG8_STAGE(PG8_SB(1, 1), cB + hstep + kstep, voffB);
        PG8_WAIT_V(6); PG8_BAR;
    } else {
        PG8_STAGE(PG8_SB(0, 0), cB, voffB); PG8_STAGE(PG8_SA(0, 0), cA, voffA); PG8_STAGE(PG8_SB(0, 1), cB + hstep, voffB); PG8_STAGE(PG8_SA(0, 1), cA + hstep, voffA);
        if (wr == 1) PG8_BAR;
        PG8_WAIT_V(4); PG8_BAR;
        PG8_STAGE(PG8_SB(1, 0), cB + kstep, voffB); PG8_STAGE(PG8_SA(1, 0), cA + kstep, voffA); PG8_STAGE(PG8_SB(1, 1), cB + hstep + kstep, voffB);
        PG8_WAIT_V(6); PG8_BAR;
    }
    for (;;) {
        const bool has_next = S.next(ui + 1, nxt);
        const char* nA = has_next ? (const char*)g.A + (size_t)nxt.pm * tstep : cA; const char* nB = has_next ? (const char*)g.Bt + (size_t)nxt.pn * tstep : cB;
        for (int t = 0; t < nt; t += 2) {
            if constexpr (MID) { if (t == (nt >> 1)) E.mid(acc, cur, wr, wc, fr, fq); }
            const bool last = (t == nt - 2);
            const char* a1 = cA + (size_t)(t + 1) * kstep;
            const char* a2 = last ? nA : cA + (size_t)(t + 2) * kstep; const char* b2 = last ? nB : cB + (size_t)(t + 2) * kstep;
            const char* a3 = a2 + kstep; const char* b3 = b2 + kstep;
            if (last && has_next) S.a_ready(nxt);
            if constexpr (SP2) {
            PG8_LDB(B0, 0, 0); PG8_LDB(B1, 0, 1); PG8_SCHED; PG8_LDA(At, 0, 0); PG8_STAGE(PG8_SA(1, 1), a1 + hstep, voffA);
            PG8_WAIT_V(8); PG8_WAIT_L(0); PG8_BAR; PG8_MMA(0, 0, At, B0); PG8_MMA(0, 1, At, B1); PG8_BAR; PG8_SCHED;
            PG8_LDA(At, 0, 1); PG8_STAGE(PG8_SB(0, 0), b2, voffB); PG8_STAGE(PG8_SB(0, 1), b2 + hstep, voffB); PG8_STAGE(PG8_SA(0, 0), a2, voffA);
            PG8_WAIT_V(8); PG8_WAIT_L(0); PG8_BAR; PG8_MMA(1, 0, At, B0); PG8_MMA(1, 1, At, B1); PG8_BAR; PG8_SCHED;
            PG8_LDB(B0, 1, 0); PG8_LDB(B1, 1, 1); PG8_SCHED; PG8_LDA(At, 1, 0); PG8_STAGE(PG8_SA(0, 1), a2 + hstep, voffA);
            PG8_WAIT_V(8); PG8_WAIT_L(0); PG8_BAR; PG8_MMA(0, 0, At, B0); PG8_MMA(0, 1, At, B1); PG8_BAR; PG8_SCHED;
            PG8_LDA(At, 1, 1); PG8_STAGE(PG8_SB(1, 0), b3, voffB); PG8_STAGE(PG8_SB(1, 1), b3 + hstep, voffB); PG8_STAGE(PG8_SA(1, 0), a3, voffA);
            PG8_WAIT_V(8); PG8_WAIT_L(0); PG8_BAR; PG8_MMA(1, 0, At, B0); PG8_MMA(1, 1, At, B1); PG8_BAR; PG8_SCHED;
            } else {
            PG8_LDB(B0, 0, 0); PG8_SCHED; PG8_LDA(At, 0, 0); PG8_STAGE(PG8_SA(1, 1), a1 + hstep, voffA);
            PG8_WAIT_L(8); PG8_BAR; PG8_WAIT_L(0); PG8_MMA(0, 0, At, B0); PG8_BAR; PG8_SCHED;
            PG8_LDB(B1, 0, 1); PG8_STAGE(PG8_SB(0, 0), b2, voffB);
            PG8_BAR; PG8_WAIT_L(0); PG8_MMA(0, 1, At, B1); PG8_BAR;
            PG8_LDA(At, 0, 1); PG8_STAGE(PG8_SA(0, 0), a2, voffA);
            PG8_BAR; PG8_WAIT_L(0); PG8_MMA(1, 0, At, B0); PG8_BAR; PG8_SCHED;
            PG8_STAGE(PG8_SB(0, 1), b2 + hstep, voffB);
            PG8_WAIT_V(6); PG8_BAR; PG8_MMA(1, 1, At, B1); PG8_BAR;
            PG8_LDB(B0, 1, 0); PG8_SCHED; PG8_LDA(At, 1, 0); PG8_STAGE(PG8_SA(0, 1), a2 + hstep, voffA);
            PG8_WAIT_L(8); PG8_BAR; PG8_WAIT_L(0); PG8_MMA(0, 0, At, B0); PG8_BAR; PG8_SCHED;
            PG8_LDB(B1, 1, 1); PG8_STAGE(PG8_SB(1, 0), b3, voffB);
            PG8_BAR; PG8_WAIT_L(0); PG8_MMA(0, 1, At, B1); PG8_BAR;
            PG8_LDA(At, 1, 1); PG8_STAGE(PG8_SA(1, 0), a3, voffA);
            PG8_BAR; PG8_WAIT_L(0); PG8_MMA(1, 0, At, B0); PG8_BAR; PG8_SCHED;
            PG8_STAGE(PG8_SB(1, 1), b3 + hstep, voffB);
            PG8_WAIT_V(6); PG8_BAR; PG8_MMA(1, 1, At, B1); PG8_BAR;
            }
        }
        if constexpr (ALIGN_EPI) { if (wr == 0) PG8_BAR; }
        if constexpr (!Epi::AFTER_DRAIN) { E(acc, cur, wr, wc, fr, fq); S.done(cur); }
        if (!has_next) break;
#pragma unroll
        for (int a = 0; a < 2; ++a)
#pragma unroll
            for (int b = 0; b < 2; ++b)
#pragma unroll
                for (int m = 0; m < 4; ++m)
#pragma unroll
                    for (int n = 0; n < 2; ++n) acc[a][b][m][n] = (f32x4){0.f, 0.f, 0.f, 0.f};
        cur = nxt; cA = nA; cB = nB; ++ui;
        if constexpr (ALIGN_EPI) { if (wr == 1) PG8_BAR; }
    }
    PG8_WAIT_V(0);
    if constexpr (!ALIGN_EPI) { if (wr == 0) PG8_BAR; }
    PG8_BAR;
    if constexpr (Epi::AFTER_DRAIN) { E.fused(acc, cur, wr, wc, fr, fq, lds, wid, lane); S.done(cur); }
#undef PG8_SA
#undef PG8_SB
#undef PG8_STAGE
#undef PG8_LDA
#undef PG8_LDB
#undef PG8_MMA
#undef PG8_WAIT_V
#undef PG8_WAIT_L
#undef PG8_BAR
#undef PG8_SCHED
}
}
namespace att {
using bf16 = __hip_bfloat16;
constexpr int D = 128, NW = 8, QBLK = 32, KVBLK = 64;
constexpr float SCALE = 0.088388347648318440f;
constexpr float THR = 8.f;
constexpr int SDEPTH = 2;
constexpr size_t SHM_V = KVBLK * D * 2, SHM_K = KVBLK * D * 2, SHM_ATTN = 2 * SHM_V + 2 * SHM_K + NW * 64 * 4;
using bf16x8 = __attribute__((ext_vector_type(8))) short;
using s16x4  = __attribute__((ext_vector_type(4))) short;
using f32x16 = __attribute__((ext_vector_type(16))) float;
using f32x8  = __attribute__((ext_vector_type(8))) float;
using u32x4  = __attribute__((ext_vector_type(4))) unsigned;
#define KSWZ(row, colB) ((row) * 256 + ((colB) ^ (((row) & 7) << 4)))
#define SBAR() __builtin_amdgcn_sched_barrier(0)
__device__ __forceinline__ int crow(int r, int hi) { return (r & 3) + 8 * (r >> 2) + 4 * hi; }
__device__ __forceinline__ unsigned cvtpk(float lo, float hi) {
  unsigned r; asm volatile("v_cvt_pk_bf16_f32 %0, %1, %2" : "=v"(r) : "v"(lo), "v"(hi)); return r;
}
template <typename TIn> struct Stage;
template <> struct Stage<bf16>  { using T = bf16x8;
  __device__ static __forceinline__ T ld8(const bf16* p) { return *reinterpret_cast<const bf16x8*>(p); }
  __device__ static __forceinline__ bf16x8 tobf(T x) { return x; } };
template <> struct Stage<float> { using T = f32x8;
  __device__ static __forceinline__ T ld8(const float* p) { return *reinterpret_cast<const f32x8*>(p); }
  __device__ static __forceinline__ bf16x8 tobf(T x) {
    u32x4 w = {cvtpk(x[0], x[1]), cvtpk(x[2], x[3]), cvtpk(x[4], x[5]), cvtpk(x[6], x[7])}; return *reinterpret_cast<bf16x8*>(&w); } };

__device__ __forceinline__ void partialSM(f32x16& p0, f32x16& p1, float& m_reg, float& mn, float& alpha) {
  constexpr float C = SCALE * 1.4426950408889634f;
  float pmax = p0[0]; for (int r = 1; r < 16; ++r) pmax = fmaxf(pmax, p0[r]); for (int r = 0; r < 16; ++r) pmax = fmaxf(pmax, p1[r]);
  { auto rr = __builtin_amdgcn_permlane32_swap(__float_as_uint(pmax), __float_as_uint(pmax), false, false);
    pmax = fmaxf(__uint_as_float(rr[0]), __uint_as_float(rr[1])); }
  if (__builtin_expect(__all(pmax - m_reg <= THR / SCALE), 1)) { mn = m_reg; alpha = 1.f; }
  else { mn = fmaxf(m_reg, pmax); alpha = __builtin_amdgcn_exp2f((m_reg - mn) * C); m_reg = mn; }
  float mnC = -mn * C;
  for (int r = 0; r < 16; ++r) p0[r] = fmaf(p0[r], C, mnC); for (int r = 0; r < 16; ++r) p1[r] = fmaf(p1[r], C, mnC);
  for (int r = 0; r < 16; ++r) p0[r] = __builtin_amdgcn_exp2f(p0[r]);
}
__device__ __forceinline__ void finishSM(f32x16& p0, f32x16& p1, float alpha, float& l_reg, bf16x8& pa0, bf16x8& pa1, bf16x8& pa2, bf16x8& pa3) {
  for (int r = 0; r < 16; ++r) p1[r] = __builtin_amdgcn_exp2f(p1[r]);
  float ps = 0; for (int r = 0; r < 16; ++r) ps += p0[r]; for (int r = 0; r < 16; ++r) ps += p1[r];
  { auto rr = __builtin_amdgcn_permlane32_swap(__float_as_uint(ps), __float_as_uint(ps), false, false);
    ps = __uint_as_float(rr[0]) + __uint_as_float(rr[1]); }
  l_reg = l_reg * alpha + ps;
#define PK4(P, BASE, OUT) do { unsigned a0 = cvtpk(P[BASE + 0], P[BASE + 1]), a1 = cvtpk(P[BASE + 2], P[BASE + 3]);   \
    unsigned b0 = cvtpk(P[BASE + 4], P[BASE + 5]), b1 = cvtpk(P[BASE + 6], P[BASE + 7]);                              \
    auto r0 = __builtin_amdgcn_permlane32_swap(a0, b0, false, false); auto r1 = __builtin_amdgcn_permlane32_swap(a1, b1, false, false); \
    u32x4 w = {r0[0], r1[0], r0[1], r1[1]}; OUT = *reinterpret_cast<bf16x8*>(&w); } while (0)
  PK4(p0, 0, pa0); PK4(p0, 8, pa1); PK4(p1, 0, pa2); PK4(p1, 8, pa3);
#undef PK4
}
__device__ __forceinline__ void qkt(f32x16& p0, f32x16& p1, const bf16* Ks, const bf16x8* qr, int r32, int hi) {
  p0 = f32x16{}; p1 = f32x16{};
  for (int d0 = 0; d0 < 8; ++d0) { int cb = (d0 * 16 + hi * 8) * 2;
    bf16x8 b0 = *reinterpret_cast<const bf16x8*>((const char*)Ks + KSWZ(r32, cb));
    bf16x8 b1 = *reinterpret_cast<const bf16x8*>((const char*)Ks + KSWZ(32 + r32, cb));
    p0 = __builtin_amdgcn_mfma_f32_32x32x16_bf16(b0, qr[d0], p0, 0, 0, 0);
    p1 = __builtin_amdgcn_mfma_f32_32x32x16_bf16(b1, qr[d0], p1, 0, 0, 0); }
}
__device__ __forceinline__ int v_st(int k, int c) { const int kk = (k & ~0xC) | ((k & 4) << 1) | ((k & 8) >> 1); return ((kk >> 3) * 4 + (c >> 5)) * 512 + ((kk & 7) * 32 + (c & 31)) * 2; }
__device__ __forceinline__ int v_rd_base(int lane) { return ((lane & 3) << 3) | (((lane >> 2) & 3) << 6) | (((lane >> 4) & 1) << 5) | (((lane >> 5) & 1) << 8); }
constexpr int v_rd_off(int d0, int ks, int half) { return d0 * 512 + ks * 4096 + half * 2048; }
template <int OFF> __device__ __forceinline__ s16x4 tr_read(int vb) {
  s16x4 r; asm volatile("ds_read_b64_tr_b16 %0, %1 offset:%2" : "=&v"(r) : "v"(vb), "i"(OFF) : "memory"); return r;
}
template <int D0> __device__ __forceinline__ void pv_one(f32x16& od, int vb, bf16x8 pa0, bf16x8 pa1, bf16x8 pa2, bf16x8 pa3) {
  const s16x4 l0 = tr_read<v_rd_off(D0, 0, 0)>(vb), h0 = tr_read<v_rd_off(D0, 0, 1)>(vb), l1 = tr_read<v_rd_off(D0, 1, 0)>(vb), h1 = tr_read<v_rd_off(D0, 1, 1)>(vb);
  const s16x4 l2 = tr_read<v_rd_off(D0, 2, 0)>(vb), h2 = tr_read<v_rd_off(D0, 2, 1)>(vb), l3 = tr_read<v_rd_off(D0, 3, 0)>(vb), h3 = tr_read<v_rd_off(D0, 3, 1)>(vb);
  asm volatile("s_waitcnt lgkmcnt(0)" ::: "memory"); SBAR();
#define PK(L, H) (bf16x8){L[0], L[1], L[2], L[3], H[0], H[1], H[2], H[3]}
  od = __builtin_amdgcn_mfma_f32_32x32x16_bf16(pa0, PK(l0, h0), od, 0, 0, 0);
  od = __builtin_amdgcn_mfma_f32_32x32x16_bf16(pa1, PK(l1, h1), od, 0, 0, 0);
  od = __builtin_amdgcn_mfma_f32_32x32x16_bf16(pa2, PK(l2, h2), od, 0, 0, 0);
  od = __builtin_amdgcn_mfma_f32_32x32x16_bf16(pa3, PK(l3, h3), od, 0, 0, 0);
#undef PK
}
__device__ __forceinline__ void pv_d0(f32x16* o, int vb, bf16x8 pa0, bf16x8 pa1, bf16x8 pa2, bf16x8 pa3) {
  pv_one<0>(o[0], vb, pa0, pa1, pa2, pa3); pv_one<1>(o[1], vb, pa0, pa1, pa2, pa3); pv_one<2>(o[2], vb, pa0, pa1, pa2, pa3); pv_one<3>(o[3], vb, pa0, pa1, pa2, pa3);
}
__device__ __forceinline__ void na_mask(f32x16& p0, f32x16& p1, const float* T, int tb, int kk, bool rowvalid) {
#pragma unroll
  for (int q = 0; q < 4; ++q) {
#pragma unroll
    for (int r = 4 * q; r < 4 * q + 4; ++r) { const int cr = (r & 3) + 8 * (r >> 2);
      const float b0 = T[tb + cr]; const bool v0 = rowvalid && (unsigned)(cr + kk) < 16u; p0[r] = v0 ? p0[r] + b0 : -INFINITY; }
    asm volatile("" ::: "memory");
#pragma unroll
    for (int r = 4 * q; r < 4 * q + 4; ++r) { const int cr = (r & 3) + 8 * (r >> 2);
      const float b1 = T[tb + 32 + cr]; const bool v1 = rowvalid && (unsigned)(cr + 32 + kk) < 16u; p1[r] = v1 ? p1[r] + b1 : -INFINITY; }
    asm volatile("" ::: "memory");
  }
}
__device__ __forceinline__ void partialSM_fx(f32x16& p0, f32x16& p1, float negMc) {
  (void)negMc;
  for (int r = 0; r < 16; ++r) p0[r] = __builtin_amdgcn_exp2f(p0[r]);
}
__device__ __forceinline__ void finishSM_fx(f32x16& p0, f32x16& p1, float& l_reg, bf16x8& pa0, bf16x8& pa1, bf16x8& pa2, bf16x8& pa3) {
  for (int r = 0; r < 16; ++r) p1[r] = __builtin_amdgcn_exp2f(p1[r]);
  float ps = 0; for (int r = 0; r < 16; ++r) ps += p0[r]; for (int r = 0; r < 16; ++r) ps += p1[r];
  l_reg += ps;
#define PK4(P, BASE, OUT) do { unsigned a0 = cvtpk(P[BASE + 0], P[BASE + 1]), a1 = cvtpk(P[BASE + 2], P[BASE + 3]);   \
    unsigned b0 = cvtpk(P[BASE + 4], P[BASE + 5]), b1 = cvtpk(P[BASE + 6], P[BASE + 7]);                              \
    auto r0 = __builtin_amdgcn_permlane32_swap(a0, b0, false, false); auto r1 = __builtin_amdgcn_permlane32_swap(a1, b1, false, false); \
    u32x4 w = {r0[0], r1[0], r0[1], r1[1]}; OUT = *reinterpret_cast<bf16x8*>(&w); } while (0)
  PK4(p0, 0, pa0); PK4(p0, 8, pa1); PK4(p1, 0, pa2); PK4(p1, 8, pa3);
#undef PK4
}
__device__ __forceinline__ void qkt_i(f32x16& p0, f32x16& p1, const bf16* Ks, const bf16x8* qr, int r32, int hi, float init) {
  for (int r = 0; r < 16; ++r) { p0[r] = init; p1[r] = init; }
  for (int d0 = 0; d0 < 8; ++d0) { int cb = (d0 * 16 + hi * 8) * 2;
    bf16x8 b0 = *reinterpret_cast<const bf16x8*>((const char*)Ks + KSWZ(r32, cb));
    bf16x8 b1 = *reinterpret_cast<const bf16x8*>((const char*)Ks + KSWZ(32 + r32, cb));
    p0 = __builtin_amdgcn_mfma_f32_32x32x16_bf16(b0, qr[d0], p0, 0, 0, 0);
    p1 = __builtin_amdgcn_mfma_f32_32x32x16_bf16(b1, qr[d0], p1, 0, 0, 0); }
}
template <int LDO>
__device__ __forceinline__ void store_o_tile(const f32x16* o, const float* rli, char* lds, int wid, int lane, bf16* Ow) {
  const int r32 = lane & 31, hi = lane >> 5;
  char* T = lds + wid * 8192;
#pragma unroll
  for (int r = 0; r < 16; ++r) { const int orow = crow(r, hi);
#pragma unroll
    for (int d0 = 0; d0 < 4; ++d0) *reinterpret_cast<bf16*>(T + orow * 256 + (d0 * 32 + r32) * 2) = __float2bfloat16(o[d0][r] * rli[r]); }
  asm volatile("s_waitcnt lgkmcnt(0)" ::: "memory");
#pragma unroll
  for (int i = 0; i < 8; ++i) { const int idx = lane + 64 * i, row = idx >> 4, ch = idx & 15;
    const u32x4 w = *reinterpret_cast<const u32x4*>(T + row * 256 + ch * 16);
    *reinterpret_cast<u32x4*>(Ow + (long)row * LDO + ch * 8) = w; }
  asm volatile("s_waitcnt lgkmcnt(0)" ::: "memory");
}
template <int LDQ, int LDK, int LDO, bool NA, int SD, int VOFF>
__device__ __forceinline__ void attn_unit(const bf16* Qb, const bf16* __restrict__ Kh, const bf16* __restrict__ Vh_, bf16* Ob, int NT, char* lds,
                                          const float* __restrict__ rpb  , const float* __restrict__ f1  , int qrow0, int krow0, int tid_in) {
  using St = Stage<bf16>;
  const bf16* __restrict__ Vh = VOFF ? Kh + VOFF : Vh_;
  int tid_ = tid_in; asm volatile("" : "+v"(tid_));
  const int tid = tid_, wid = __builtin_amdgcn_readfirstlane(tid >> 6), lane = tid & 63, r32 = lane & 31, hi = lane >> 5;
  bf16* V_lds = (bf16*)lds; bf16* K_lds = (bf16*)(lds + 2 * SHM_V);
  float* ws = (float*)(lds + 2 * SHM_V + 2 * SHM_K) + wid * 64; float* li_l = ws; float* al_l = ws + 32;
  float* T = (float*)(lds + SHM_ATTN);
  __syncthreads();
  int na_tb0 = 0, na_kk = 0, na_r = 0, na_rs = 0;
  if constexpr (NA) {
    for (int e = tid; e < 15 * 128; e += 512) { const int rr = e >> 7, x = e & 127; T[e] = (x >= 49 && x <= 79) ? rpb[rr * 31 + x - 49] * (1.0f / SCALE) : 0.f;
    }
    const int c = (wid & 1) * 32 + r32; int cs = c - 8; cs = cs < 0 ? 0 : (cs > 48 ? 48 : cs);
    na_tb0 = 64 - c + 4 * hi; na_kk = 4 * hi - cs;
    na_r = qrow0 + (wid >> 1); na_rs = na_r - 4; na_rs = na_rs < 0 ? 0 : (na_rs > 248 ? 248 : na_rs);
  }
  float negMc = 0.f;
  if constexpr (!NA) {
    float mq = fmaxf(fabsf(rpb[lane]), fabsf(rpb[lane + 64])), mk = fmaxf(fabsf(f1[lane]), fabsf(f1[lane + 64]));
#pragma unroll
    for (int o_ = 1; o_ < 64; o_ <<= 1) { mq = fmaxf(mq, __shfl_xor(mq, o_)); mk = fmaxf(mk, __shfl_xor(mk, o_)); }
    const float M = fminf(11.3137085f * 1.01f * mq * mk, 60.f);
    negMc = -M * 1.4426950408889634f;
  }
#define PSM(P0, P1, MN, AL) do { if constexpr (NA) partialSM(P0, P1, m_reg, MN, AL); else partialSM_fx(P0, P1, negMc); } while (0)
#define FSM(P0, P1, AL) do { if constexpr (NA) finishSM(P0, P1, AL, l_reg, pa0, pa1, pa2, pa3); else finishSM_fx(P0, P1, l_reg, pa0, pa1, pa2, pa3); } while (0)
#define NAMASK(P0, P1, ti) do { if constexpr (NA) { SBAR(); const int kr_ = krow0 + (ti); const bool rv_ = (unsigned)(kr_ - na_rs) < 8u; int rr_ = kr_ - na_r + 7; rr_ = rv_ ? rr_ : 0; \
    na_mask(P0, P1, T, na_tb0 + rr_ * 128, na_kk, rv_); SBAR(); } } while (0)
  float m_reg = -1e30f, l_reg = 0; f32x16 o[4] = {}; bf16x8 qr[8];
  const bf16* Qw = Qb + (long)(wid * QBLK + r32) * LDQ + hi * 8;
#pragma unroll
  for (int d0 = 0; d0 < 8; ++d0) qr[d0] = St::ld8(Qw + d0 * 16);
  const int sr = tid >> 4, sc = (tid & 15) * 8, vst0 = v_st(sr, sc), vst1 = v_st(32 + sr, sc);
  const int vb0 = (int)(uintptr_t)V_lds + v_rd_base(lane);
  struct { typename St::T vs0, vs1, ks0, ks1; } sr_[SD];
#define SLOAD(i, k0) do { sr_[i].vs0 = St::ld8(&Vh[(long)((k0) + sr) * LDK + sc]); sr_[i].vs1 = St::ld8(&Vh[(long)((k0) + 32 + sr) * LDK + sc]); \
    sr_[i].ks0 = St::ld8(&Kh[(long)((k0) + sr) * LDK + sc]); sr_[i].ks1 = St::ld8(&Kh[(long)((k0) + 32 + sr) * LDK + sc]); } while (0)
#define SWRITE(b, i) do { *(bf16x8*)((char*)V_lds + (b) * SHM_V + vst0) = St::tobf(sr_[i].vs0);          \
    *(bf16x8*)((char*)V_lds + (b) * SHM_V + vst1) = St::tobf(sr_[i].vs1); int kc = sc * 2;               \
    *(bf16x8*)((char*)K_lds + (b) * SHM_K + KSWZ(sr, kc)) = St::tobf(sr_[i].ks0);                       \
    *(bf16x8*)((char*)K_lds + (b) * SHM_K + KSWZ(32 + sr, kc)) = St::tobf(sr_[i].ks1); } while (0)
#define SWAIT() do { if constexpr (SD == 2) asm volatile("s_waitcnt vmcnt(4)" ::: "memory"); else asm volatile("s_waitcnt vmcnt(0)" ::: "memory"); } while (0)
#define RESC(a) do { if constexpr (NA) if (__any((a) < 1.f)) { if (hi == 0) al_l[r32] = (a); asm volatile("s_waitcnt lgkmcnt(0)" ::: "memory"); \
    for (int d = 0; d < 4; ++d) for (int r = 0; r < 16; ++r) o[d][r] *= al_l[crow(r, hi)]; } } while (0)
  f32x16 pA0, pA1, pB0, pB1; float mnA, mnB, alA, alB; bf16x8 pa0, pa1, pa2, pa3;
  constexpr int SE = 0, SO = SD - 1;
  SLOAD(SE, 0); asm volatile("s_waitcnt vmcnt(0)" ::: "memory"); SWRITE(0, SE); __syncthreads();
  qkt_i(pA0, pA1, K_lds, qr, r32, hi, negMc); NAMASK(pA0, pA1, 0); PSM(pA0, pA1, mnA, alA);
  SLOAD(SO, KVBLK); if constexpr (SD == 2) { if (2 < NT) SLOAD(SE, 2 * KVBLK); }
  SWAIT(); SWRITE(1, SO); __syncthreads();
  for (int j = 1; j + 1 < NT; j += 2) {
    SBAR(); qkt_i(pB0, pB1, (bf16*)((char*)K_lds + SHM_K), qr, r32, hi, negMc);
    FSM(pA0, pA1, alA); SBAR();
    SLOAD(SO, (j + SD) * KVBLK); SBAR();
    pv_d0(o, vb0, pa0, pa1, pa2, pa3); NAMASK(pB0, pB1, j); PSM(pB0, pB1, mnB, alB);
    __syncthreads(); SWAIT(); SWRITE(0, SE);
    RESC(alB); __syncthreads();
    SBAR(); qkt_i(pA0, pA1, K_lds, qr, r32, hi, negMc);
    FSM(pB0, pB1, alB); SBAR();
    if (SD == 1 || j + 3 < NT) SLOAD(SE, (j + 1 + SD) * KVBLK); SBAR();
    pv_d0(o, vb0 + (int)SHM_V, pa0, pa1, pa2, pa3); NAMASK(pA0, pA1, j + 1); PSM(pA0, pA1, mnA, alA);
    __syncthreads(); SWAIT(); SWRITE(1, SO);
    RESC(alA); __syncthreads();
  }
  SBAR(); qkt_i(pB0, pB1, (bf16*)((char*)K_lds + SHM_K), qr, r32, hi, negMc);
  FSM(pA0, pA1, alA); SBAR();
  pv_d0(o, vb0, pa0, pa1, pa2, pa3); NAMASK(pB0, pB1, NT - 1); PSM(pB0, pB1, mnB, alB);
  __syncthreads(); RESC(alB);
  FSM(pB0, pB1, alB); SBAR();
  pv_d0(o, vb0 + (int)SHM_V, pa0, pa1, pa2, pa3);
  if constexpr (!NA) { auto rr_ = __builtin_amdgcn_permlane32_swap(__float_as_uint(l_reg), __float_as_uint(l_reg), false, false); l_reg = __uint_as_float(rr_[0]) + __uint_as_float(rr_[1]); }
  if (hi == 0) li_l[r32] = l_reg; asm volatile("s_waitcnt lgkmcnt(0)" ::: "memory");
  float rli[16];
#pragma unroll
  for (int r = 0; r < 16; ++r) rli[r] = __builtin_amdgcn_rcpf(li_l[crow(r, hi)]);
  __syncthreads();
  store_o_tile<LDO>(o, rli, lds, wid, lane, Ob + (long)(wid * QBLK) * LDO);
#undef SLOAD
#undef SWRITE
#undef SWAIT
#undef RESC
#undef NAMASK
#undef PSM
#undef FSM
}

typedef int v8i_t __attribute__((ext_vector_type(8)));
#define KSWZ8(row, colB) ((row) * 128 + ((colB) ^ ((((row) >> 1) & 7) << 4)))
__device__ __forceinline__ void qkt8(f32x16& p0, f32x16& p1, const char* Ks, const v8i_t* q8, int r32, int hi, float init) {
  for (int r = 0; r < 16; ++r) { p0[r] = init; p1[r] = init; }
#pragma unroll
  for (int s = 0; s < 2; ++s) { const int cb = 64 * s + 32 * hi;
    const u32x4 a00 = *reinterpret_cast<const u32x4*>(Ks + KSWZ8(r32, cb)), a01 = *reinterpret_cast<const u32x4*>(Ks + KSWZ8(r32, cb + 16));
    const u32x4 a10 = *reinterpret_cast<const u32x4*>(Ks + KSWZ8(32 + r32, cb)), a11 = *reinterpret_cast<const u32x4*>(Ks + KSWZ8(32 + r32, cb + 16));
    const v8i_t A0 = {(int)a00.x, (int)a00.y, (int)a00.z, (int)a00.w, (int)a01.x, (int)a01.y, (int)a01.z, (int)a01.w};
    const v8i_t A1 = {(int)a10.x, (int)a10.y, (int)a10.z, (int)a10.w, (int)a11.x, (int)a11.y, (int)a11.z, (int)a11.w};
    p0 = __builtin_amdgcn_mfma_scale_f32_32x32x64_f8f6f4(A0, q8[s], p0, 0, 0, 0, 0, 0, 0);
    p1 = __builtin_amdgcn_mfma_scale_f32_32x32x64_f8f6f4(A1, q8[s], p1, 0, 0, 0, 0, 0, 0); }
}
#define VSWZ8(row, colB) ((row) * 64 + ((colB) ^ ((((row) >> 2) & 3) << 4)))
__device__ __forceinline__ void finishSM_fx8(f32x16& p0, f32x16& p1, float& l_reg, v8i_t& P8) {
  for (int r = 0; r < 16; ++r) p1[r] = __builtin_amdgcn_exp2f(p1[r]);
  float ps = 0; for (int r = 0; r < 16; ++r) ps += p0[r]; for (int r = 0; r < 16; ++r) ps += p1[r];
  l_reg += ps;
#pragma unroll
  for (int i = 0; i < 4; ++i) { int w = 0; w = __builtin_amdgcn_cvt_pk_bf8_f32(p0[4 * i], p0[4 * i + 1], w, false); w = __builtin_amdgcn_cvt_pk_bf8_f32(p0[4 * i + 2], p0[4 * i + 3], w, true); P8[i] = w; }
#pragma unroll
  for (int i = 0; i < 4; ++i) { int w = 0; w = __builtin_amdgcn_cvt_pk_bf8_f32(p1[4 * i], p1[4 * i + 1], w, false); w = __builtin_amdgcn_cvt_pk_bf8_f32(p1[4 * i + 2], p1[4 * i + 3], w, true); P8[4 + i] = w; }
}
__device__ __forceinline__ void pv8(f32x16* o, const char* Vs, const v8i_t P8, int r32, int hi) {
#pragma unroll
  for (int d0 = 0; d0 < 4; ++d0) { const int row = 32 * d0 + r32;
    const u32x4 b0 = *reinterpret_cast<const u32x4*>(Vs + VSWZ8(row, 32 * hi)), b1 = *reinterpret_cast<const u32x4*>(Vs + VSWZ8(row, 32 * hi + 16));
    const v8i_t B = {(int)b0.x, (int)b0.y, (int)b0.z, (int)b0.w, (int)b1.x, (int)b1.y, (int)b1.z, (int)b1.w};
    o[d0] = __builtin_amdgcn_mfma_scale_f32_32x32x64_f8f6f4(P8, B, o[d0], 1  , 0  , 0, 0, 0, 0); }
}
template <int LDQ8, int LDK8, int LDVT, int LDO>
__device__ __forceinline__ void attn_unit_g8(const unsigned char* Q8, const unsigned char* __restrict__ K8h, const unsigned char* __restrict__ V8Th, bf16* Ob, int NT, char* lds,
                                             const float* __restrict__ qnw, const float* __restrict__ knw, int tid_in) {
  int tid_ = tid_in; asm volatile("" : "+v"(tid_));
  const int tid = tid_, wid = __builtin_amdgcn_readfirstlane(tid >> 6), lane = tid & 63, r32 = lane & 31, hi = lane >> 5;
  char* V_lds = lds; char* K_lds = lds + 2 * SHM_V;
  float* ws = (float*)(lds + 2 * SHM_V + 2 * SHM_K) + wid * 64; float* li_l = ws;
  __syncthreads();
  float negMc;
  { float mq = fmaxf(fabsf(qnw[lane]), fabsf(qnw[lane + 64])), mk = fmaxf(fabsf(knw[lane]), fabsf(knw[lane + 64]));
#pragma unroll
    for (int o_ = 1; o_ < 64; o_ <<= 1) { mq = fmaxf(mq, __shfl_xor(mq, o_)); mk = fmaxf(mk, __shfl_xor(mk, o_)); }
    const float M = fminf(11.3137085f * 1.07f * mq * mk, 60.f);
    negMc = __uint_as_float(__builtin_amdgcn_readfirstlane(__float_as_uint(15.0f - M * 1.4426950408889634f))); }
  float l_reg = 0; f32x16 o[4] = {}; v8i_t q8[2];
  { const unsigned char* Qw = Q8 + (long)(wid * QBLK + r32) * LDQ8 + hi * 32;
#pragma unroll
    for (int s = 0; s < 2; ++s) { const u32x4 a = *reinterpret_cast<const u32x4*>(Qw + 64 * s), b = *reinterpret_cast<const u32x4*>(Qw + 64 * s + 16);
      q8[s] = (v8i_t){(int)a.x, (int)a.y, (int)a.z, (int)a.w, (int)b.x, (int)b.y, (int)b.z, (int)b.w}; } }
  const int kr = tid >> 3, kc = (tid & 7) * 16, kst = KSWZ8(kr, kc);
  const int vr = tid >> 2, vc = (tid & 3) * 16, vst = VSWZ8(vr, vc);
  u32x4 vs, ks;
  unsigned vo = (unsigned)(vr * LDVT + vc), ko = (unsigned)(kr * LDK8 + kc);
#define SLOAD(k0) do { vs = *reinterpret_cast<const u32x4*>(V8Th + vo); ks = *reinterpret_cast<const u32x4*>(K8h + ko); vo += KVBLK; ko += KVBLK * LDK8; asm volatile("" : "+v"(vo), "+v"(ko)); } while (0)
#define SWRITE(b) do { *(u32x4*)(V_lds + (b) * SHM_V + vst) = vs; *(u32x4*)(K_lds + (b) * SHM_K + kst) = ks; } while (0)
#define SWAIT() asm volatile("s_waitcnt vmcnt(0)" ::: "memory")
  f32x16 pA0, pA1, pB0, pB1; v8i_t P8;
#define SWRITE4(b) do { *(u32x4*)(V_lds + (b) * 8192 + vst) = vs; *(u32x4*)(K_lds + (b) * 8192 + kst) = ks; } while (0)
#define STEP(PN0, PN1, PO0, PO1, KB, VB, WB, JJ, LOADS) do { \
    SBAR(); qkt8(PN0, PN1, K_lds + (KB) * 8192, q8, r32, hi, negMc); \
    finishSM_fx8(PO0, PO1, l_reg, P8); SBAR(); \
    if (LOADS) SLOAD(((JJ) + 2) * KVBLK); SBAR(); \
    pv8(o, V_lds + (VB) * 8192, P8, r32, hi); partialSM_fx(PN0, PN1, negMc); \
    __syncthreads(); if (LOADS) { SWAIT(); SWRITE4(WB); } } while (0)
  SLOAD(0); SWAIT(); SWRITE4(0);
  SLOAD(KVBLK); SWAIT(); SWRITE4(1); __syncthreads();
  SLOAD(2 * KVBLK);
  qkt8(pA0, pA1, K_lds, q8, r32, hi, negMc); partialSM_fx(pA0, pA1, negMc);
  SWAIT(); SWRITE4(2);
  int j = 1;
  for (; j + 5 < NT; j += 4) {
    STEP(pB0, pB1, pA0, pA1, 1, 0, 3, j, true);
    STEP(pA0, pA1, pB0, pB1, 2, 1, 0, j + 1, true);
    STEP(pB0, pB1, pA0, pA1, 3, 2, 1, j + 2, true);
    STEP(pA0, pA1, pB0, pB1, 0, 3, 2, j + 3, true);
  }
  STEP(pB0, pB1, pA0, pA1, 1, 0, 3, j, true);
  STEP(pA0, pA1, pB0, pB1, 2, 1, 0, j + 1, false);
  SBAR(); qkt8(pB0, pB1, K_lds + 3 * 8192, q8, r32, hi, negMc);
  finishSM_fx8(pA0, pA1, l_reg, P8); SBAR();
  pv8(o, V_lds + 2 * 8192, P8, r32, hi); partialSM_fx(pB0, pB1, negMc);
  finishSM_fx8(pB0, pB1, l_reg, P8); SBAR();
  pv8(o, V_lds + 3 * 8192, P8, r32, hi);
#undef STEP
#undef SWRITE4
  { auto rr_ = __builtin_amdgcn_permlane32_swap(__float_as_uint(l_reg), __float_as_uint(l_reg), false, false); l_reg = __uint_as_float(rr_[0]) + __uint_as_float(rr_[1]); }
  if (hi == 0) li_l[r32] = l_reg; asm volatile("s_waitcnt lgkmcnt(0)" ::: "memory");
  float rli[16];
#pragma unroll
  for (int r = 0; r < 16; ++r) rli[r] = __builtin_amdgcn_rcpf(li_l[crow(r, hi)]);
  __syncthreads();
  store_o_tile<LDO>(o, rli, lds, wid, lane, Ob + (long)(wid * QBLK) * LDO);
#undef SLOAD
#undef SWRITE
#undef SWAIT
}
#undef SBAR
}
namespace cg = cooperative_groups;
#define LAS __attribute__((address_space(3)))
typedef unsigned short bf16_t;
typedef float f32x4 __attribute__((ext_vector_type(4)));
typedef unsigned v4u __attribute__((ext_vector_type(4)));
typedef unsigned v2u __attribute__((ext_vector_type(2)));
constexpr int SEQ = 16384, DM = 2048, DIN = 8704, DFF = 5632, NMOD = 6 * DM;
constexpr float NORM_EPS = 1e-6f;
constexpr size_t MiB = 1u << 20;
constexpr size_t WS_MOD = 0, CTL_ZERO_BYTES = 64 * 1024;
constexpr size_t WS_ROPE = 1 * MiB;
using pg8::PH; using pg8::PA; using pg8::PKV; using pg8::PNB;
constexpr size_t WS_WIN = 2 * MiB, WS_WO = 39 * MiB, WS_WOUT = 48 * MiB, WS_WGU = 57 * MiB, WS_WD = 104 * MiB;
constexpr size_t WS_H = 128 * MiB;
constexpr size_t WS_Q8 = WS_H, WS_K8 = WS_H + 16 * MiB, WS_V8T = WS_H + 20 * MiB;
constexpr size_t WS_QAB = 196 * MiB, WS_KVA = 264 * MiB, WS_KB = 284 * MiB, WS_VB = 320 * MiB, WS_GA = 356 * MiB, WS_GB = 424 * MiB, WS_END = 492 * MiB;
constexpr size_t WS_ACT = 196 * MiB;
static_assert(WS_WIN + (size_t)DIN * PH * 2 <= WS_WO && WS_WO + (size_t)DM * PH * 2 <= WS_WOUT && WS_WOUT + (size_t)DM * PH * 2 <= WS_WGU && WS_WGU + (size_t)2 * DFF * PH * 2 <= WS_WD && WS_WD + (size_t)DM * PA * 2 <= WS_H, "weight map");
static_assert(WS_H + (size_t)SEQ * PH * 2 <= WS_QAB && WS_QAB + (size_t)SEQ * PH * 2 <= WS_KVA && WS_KVA + (size_t)SEQ * PKV * 2 <= WS_KB && WS_KB + (size_t)SEQ * PNB * 2 <= WS_VB && WS_VB + (size_t)SEQ * PNB * 2 <= WS_GA &&
              WS_GA + (size_t)SEQ * PH * 2 <= WS_GB && WS_GB + (size_t)SEQ * PH * 2 <= WS_END && WS_ACT + (size_t)SEQ * PA * 2 <= WS_GB && WS_V8T + 4 * MiB <= WS_QAB, "activation map");
constexpr size_t WS_BAR = 49152;
constexpr int LDS_BYTES = 147456, LDS_MISC = 131072;
constexpr int NPHASE = 11;
#ifndef GEMM_ALIGN
#define GEMM_ALIGN true
#endif
#ifndef GATT_SD
#define GATT_SD 1
#endif
#ifndef STAGGER_SLEEPS
#define STAGGER_SLEEPS 7
#endif

__device__ __forceinline__ unsigned f2bf(float f) { unsigned u = __builtin_bit_cast(unsigned, f); return (u + 0x7fffu + ((u >> 16) & 1u)) >> 16; }
__device__ __forceinline__ unsigned pk2(float lo, float hi) { return f2bf(lo) | (f2bf(hi) << 16); }
__device__ __forceinline__ float wave_sum(float v) {
#pragma unroll
    for (int o = 1; o < 64; o <<= 1) v += __shfl_xor(v, o);
    return v;
}
__device__ __forceinline__ void transpose_item(const float* __restrict__ W, int N, bf16_t* __restrict__ WT, int ldt, int koff, int mode, LAS float* scr, int item, int lane) {
    const int nblk = N / 32, kb = item / nblk, nb = item % nblk, k0 = 64 * kb, n0 = 32 * nb;
    const int drow0 = mode == 0 ? n0 : ((n0 >> 7) * 256 + (n0 & 127) + (mode == 2 ? 128 : 0));
#pragma unroll 8
    for (int i = 0; i < 32; ++i) { const int kk = 2 * i + (lane >> 5); scr[kk * 33 + (lane & 31)] = W[(size_t)(k0 + kk) * N + n0 + (lane & 31)]; }
    asm volatile("s_waitcnt lgkmcnt(0)" ::: "memory");
    const int c = lane & 7;
#pragma unroll
    for (int j = 0; j < 4; ++j) { const int n = (lane >> 3) + 8 * j; const LAS float* s = scr + (8 * c) * 33 + n;
        v4u o; o.x = pk2(s[0 * 33], s[1 * 33]); o.y = pk2(s[2 * 33], s[3 * 33]); o.z = pk2(s[4 * 33], s[5 * 33]); o.w = pk2(s[6 * 33], s[7 * 33]);
        *(v4u*)(WT + (size_t)(drow0 + n) * ldt + koff + k0 + 8 * c) = o; }
    asm volatile("s_waitcnt lgkmcnt(0)" ::: "memory");
}
__device__ __forceinline__ void gemv_item(const float* __restrict__ cvec, const float* __restrict__ w_ada, const float* __restrict__ b_ada, float* mod, int item, int lane) {
    const int kc = item / 48, jc = item % 48, col = jc * 256 + 4 * lane;
    f32x4 acc = {0.f, 0.f, 0.f, 0.f};
#pragma unroll 8
    for (int kk = 0; kk < 64; ++kk) { const int k = kc * 64 + kk; const float cv = cvec[k]; const float s = cv / (1.f + expf(-cv));
        const f32x4 w = *(const f32x4*)(w_ada + (size_t)k * NMOD + col); acc += w * s; }
    if (kc == 0) acc += *(const f32x4*)(b_ada + col);
#pragma unroll
    for (int e = 0; e < 4; ++e) __hip_atomic_fetch_add(mod + col + e, acc[e], __ATOMIC_RELAXED, __HIP_MEMORY_SCOPE_AGENT);
}
__device__ __forceinline__ void normmod_rows(const float* X, const float* __restrict__ nw, const float* __restrict__ sc, const float* __restrict__ sh, bf16_t* __restrict__ H, int gw, int NGW, int lane) {
    f32x4 a[8], b[8];
#pragma unroll
    for (int j = 0; j < 8; ++j) { const int col = 4 * lane + 256 * j; const f32x4 w = *(const f32x4*)(nw + col), s = *(const f32x4*)(sc + col); a[j] = w * (s + 1.0f); b[j] = *(const f32x4*)(sh + col); }
    for (int m = gw; m < SEQ; m += NGW) {
        const f32x4* xr = (const f32x4*)(X + (size_t)m * DM) + lane; f32x4 v[8]; float ss = 0.f;
#pragma unroll
        for (int j = 0; j < 8; ++j) { v[j] = xr[64 * j]; ss += (v[j].x * v[j].x + v[j].y * v[j].y) + (v[j].z * v[j].z + v[j].w * v[j].w); }
        const float rstd = rsqrtf(wave_sum(ss) * (1.0f / DM) + NORM_EPS);
        v2u* o8 = (v2u*)(H + (size_t)m * PH) + lane;
#pragma unroll
        for (int j = 0; j < 8; ++j) { const f32x4 y = v[j] * rstd * a[j] + b[j]; v2u w; w.x = pk2(y.x, y.y); w.y = pk2(y.z, y.w);
            o8[64 * j] = w; }
    }
}
__device__ __forceinline__ f32x4 bf4(v2u w) { f32x4 r; r.x = __uint_as_float(w.x << 16); r.y = __uint_as_float(w.x & 0xffff0000u); r.z = __uint_as_float(w.y << 16); r.w = __uint_as_float(w.y & 0xffff0000u); return r; }
__device__ __forceinline__ void normmod_rows_d(const float* __restrict__ X, const bf16_t* __restrict__ D1, const float* __restrict__ nw, const float* __restrict__ sc, const float* __restrict__ sh, bf16_t* __restrict__ H, int gw, int NGW, int lane) {
    f32x4 a[8], b[8];
#pragma unroll
    for (int j = 0; j < 8; ++j) { const int col = 4 * lane + 256 * j; const f32x4 w = *(const f32x4*)(nw + col), s = *(const f32x4*)(sc + col); a[j] = w * (s + 1.0f); b[j] = *(const f32x4*)(sh + col); }
    for (int m = gw; m < SEQ; m += NGW) {
        const f32x4* xr = (const f32x4*)(X + (size_t)m * DM) + lane; const v2u* dr = (const v2u*)(D1 + (size_t)m * PH) + lane; f32x4 v[8]; float ss = 0.f;
#pragma unroll
        for (int j = 0; j < 8; ++j) { v[j] = xr[64 * j] + bf4(dr[64 * j]); ss += (v[j].x * v[j].x + v[j].y * v[j].y) + (v[j].z * v[j].z + v[j].w * v[j].w); }
        const float rstd = rsqrtf(wave_sum(ss) * (1.0f / DM) + NORM_EPS);
        v2u* o8 = (v2u*)(H + (size_t)m * PH) + lane;
#pragma unroll
        for (int j = 0; j < 8; ++j) { const f32x4 y = v[j] * rstd * a[j] + b[j]; v2u w; w.x = pk2(y.x, y.y); w.y = pk2(y.z, y.w); o8[64 * j] = w; }
    }
}
__device__ __forceinline__ void final_rows_d(const float* __restrict__ X, const bf16_t* __restrict__ D1, const bf16_t* __restrict__ D2, float* __restrict__ OUT, const float* __restrict__ fw, int gw, int NGW, int lane) {
    f32x4 a[8];
#pragma unroll
    for (int j = 0; j < 8; ++j) a[j] = *(const f32x4*)(fw + 4 * lane + 256 * j);
    for (int m = gw; m < SEQ; m += NGW) {
        const f32x4* xr = (const f32x4*)(X + (size_t)m * DM) + lane; const v2u* d1 = (const v2u*)(D1 + (size_t)m * PH) + lane; const v2u* d2 = (const v2u*)(D2 + (size_t)m * PH) + lane; f32x4 v[8]; float ss = 0.f;
#pragma unroll
        for (int j = 0; j < 8; ++j) { v[j] = (xr[64 * j] + bf4(d1[64 * j])) + bf4(d2[64 * j]); ss += (v[j].x * v[j].x + v[j].y * v[j].y) + (v[j].z * v[j].z + v[j].w * v[j].w); }
        const float rstd = rsqrtf(wave_sum(ss) * (1.0f / DM) + NORM_EPS);
        f32x4* orow = (f32x4*)(OUT + (size_t)m * DM) + lane;
#pragma unroll
        for (int j = 0; j < 8; ++j) orow[64 * j] = v[j] * rstd * a[j];
    }
}
__device__ __forceinline__ void final_rows(float* X, const float* __restrict__ fw, int gw, int NGW, int lane) {
    f32x4 a[8];
#pragma unroll
    for (int j = 0; j < 8; ++j) a[j] = *(const f32x4*)(fw + 4 * lane + 256 * j);
    for (int m = gw; m < SEQ; m += NGW) {
        f32x4* xr = (f32x4*)(X + (size_t)m * DM) + lane; f32x4 v[8]; float ss = 0.f;
#pragma unroll
        for (int j = 0; j < 8; ++j) { v[j] = xr[64 * j]; ss += (v[j].x * v[j].x + v[j].y * v[j].y) + (v[j].z * v[j].z + v[j].w * v[j].w); }
        const float rstd = rsqrtf(wave_sum(ss) * (1.0f / DM) + NORM_EPS);
#pragma unroll
        for (int j = 0; j < 8; ++j) xr[64 * j] = v[j] * rstd * a[j];
    }
}
__device__ __forceinline__ void qknorm_rope(bf16_t* QAB, bf16_t* KVA, unsigned char* __restrict__ Q8, unsigned char* __restrict__ K8, const float* __restrict__ qn, const float* __restrict__ kn, const float* __restrict__ tab, int gw, int NGW, int lane) {
    const int li = lane & 15;
    for (int it = gw * 4 + (lane >> 4); it < SEQ * 10; it += NGW * 4) {
        const int t = it / 10, hs = it - t * 10;
        bf16_t* p = (hs < 8 ? QAB + (size_t)t * PH + hs * 128 : KVA + (size_t)t * PKV + (hs - 8) * 128) + 8 * li;
        const float* wn = (hs < 8 ? qn : kn) + 8 * li;
        const v4u raw = *(const v4u*)p; float x[8];
#pragma unroll
        for (int e = 0; e < 4; ++e) { x[2 * e] = __uint_as_float(raw[e] << 16); x[2 * e + 1] = __uint_as_float(raw[e] & 0xffff0000u); }
        float ss = 0.f;
#pragma unroll
        for (int e = 0; e < 8; ++e) ss += x[e] * x[e];
        ss += __shfl_xor(ss, 1); ss += __shfl_xor(ss, 2); ss += __shfl_xor(ss, 4); ss += __shfl_xor(ss, 8);
        const float rstd = rsqrtf(ss * (1.0f / 128.0f) + NORM_EPS) * (hs < 8 ? 0.088388347648318440f * 1.4426950408889634f : 1.0f);
        const f32x4 w0 = *(const f32x4*)wn, w1 = *(const f32x4*)(wn + 4);
        const float wv[8] = {w0.x, w0.y, w0.z, w0.w, w1.x, w1.y, w1.z, w1.w};
        const int row = t >> 6, col = t & 63;
        const float* cs = tab + 2 * (li < 8 ? (row * 32 + 4 * li) : ((256 + col) * 32 + 4 * (li - 8)));
        const f32x4 c0 = *(const f32x4*)cs, c1 = *(const f32x4*)(cs + 4);
        const float cv[4] = {c0.x, c0.z, c1.x, c1.z}, sv[4] = {c0.y, c0.w, c1.y, c1.w};
        float r8[8];
#pragma unroll
        for (int e = 0; e < 4; ++e) { const float y0 = x[2 * e] * rstd * wv[2 * e], y1 = x[2 * e + 1] * rstd * wv[2 * e + 1];
            r8[2 * e] = y0 * cv[e] - y1 * sv[e]; r8[2 * e + 1] = y0 * sv[e] + y1 * cv[e]; }
        int pw0 = 0, pw1 = 0;
        pw0 = __builtin_amdgcn_cvt_pk_fp8_f32(r8[0], r8[1], pw0, false); pw0 = __builtin_amdgcn_cvt_pk_fp8_f32(r8[2], r8[3], pw0, true);
        pw1 = __builtin_amdgcn_cvt_pk_fp8_f32(r8[4], r8[5], pw1, false); pw1 = __builtin_amdgcn_cvt_pk_fp8_f32(r8[6], r8[7], pw1, true);
        unsigned char* d8 = (hs < 8 ? Q8 + (size_t)t * 1024 + hs * 128 : K8 + (size_t)t * 256 + (hs - 8) * 128) + 8 * li;
        v2u o8; o8.x = (unsigned)pw0; o8.y = (unsigned)pw1; *(v2u*)d8 = o8;
    }
}

#define XB_TMO      128
#define XB_XCNT(j)  (256  + 64 * (j))
#define XB_XSUB(j)  (1280 + 64 * (j))
#define XB_XGEN(j)  (2304 + 64 * (j))
#define XB_TOP      3328
#define XB_TOPGEN   3392
#define XCD_BAR_WORDS 3456
#define XB_SPIN_CAP (1u << 18)

__device__ __forceinline__ unsigned xb_ld(unsigned* p)              { return __hip_atomic_load(p, __ATOMIC_RELAXED, __HIP_MEMORY_SCOPE_AGENT); }
__device__ __forceinline__ unsigned xb_add(unsigned* p, unsigned v) { return __hip_atomic_fetch_add(p, v, __ATOMIC_RELAXED, __HIP_MEMORY_SCOPE_AGENT); }
__device__ __forceinline__ unsigned xb_xcc_id() { return (unsigned)__builtin_amdgcn_s_getreg((3 << 11) | 20) & 0xFu; }
#define XB_SPIN(cond, bar) do { unsigned _sp = 0; while (cond) { __builtin_amdgcn_s_sleep(1); \
    if ((++_sp & 255u) == 0u) { if (xb_ld(&(bar)[XB_TMO])) break; if (_sp > XB_SPIN_CAP) { atomicAdd(&(bar)[XB_TMO], 1u); break; } } } } while (0)

struct XcdBarrier {
    unsigned* bar; unsigned x;
    volatile LAS unsigned* st;
};

__device__ __forceinline__ XcdBarrier xcd_barrier_post(unsigned* bar, volatile LAS unsigned* st) {
    XcdBarrier b; b.bar = bar; b.x = xb_xcc_id(); b.st = st;
    if (threadIdx.x == 0) (void)xb_add(&bar[XB_XCNT(b.x)], 1u);
    return b;
}
__device__ __forceinline__ void xcd_barrier_complete(unsigned* bar, unsigned x, unsigned& nloc, unsigned& nx) {
    const unsigned G = gridDim.x * gridDim.y * gridDim.z;
    unsigned sum, cnt, mine, sp = 0u;
    for (;;) {
        sum = 0u; cnt = 0u; mine = 0u;
#pragma unroll
        for (unsigned j = 0; j < 16; ++j) { const unsigned c = xb_ld(&bar[XB_XCNT(j)]); sum += c; cnt += (c > 0u) ? 1u : 0u; mine = (j == x) ? c : mine; }
        if (sum == G) break;
        __builtin_amdgcn_s_sleep(1);
        if ((++sp & 255u) == 0u) { if (xb_ld(&bar[XB_TMO])) break; if (sp > XB_SPIN_CAP) { atomicAdd(&bar[XB_TMO], 1u); break; } }
    }
    nloc = mine > 0u ? mine : 1u; nx = cnt > 0u ? cnt : 1u;
}

__device__ __forceinline__ void xcd_barrier(const XcdBarrier& b, int tid_) {
    asm volatile("s_waitcnt vmcnt(0)" ::: "memory");
    __syncthreads();
    if (tid_ == 0) {
        unsigned* bar = b.bar;
        __builtin_amdgcn_s_waitcnt(0);
        unsigned nloc = b.st[0], nx = b.st[1];
        if (nloc == 0u) { xcd_barrier_complete(bar, b.x, nloc, nx); b.st[0] = nloc; b.st[1] = nx; }
        const unsigned old = xb_add(&bar[XB_XSUB(b.x)], 1u);
        const unsigned gen = old / nloc;
        if (old + 1u == (gen + 1u) * nloc) {
            __builtin_amdgcn_fence(__ATOMIC_RELEASE, "agent");
            asm volatile("s_waitcnt vmcnt(0)" ::: "memory");
            const unsigned og = xb_add(&bar[XB_TOP], 1u);
            const unsigned tg = og / nx;
            if (og + 1u == (tg + 1u) * nx) xb_add(&bar[XB_TOPGEN], 1u);
            else XB_SPIN(xb_ld(&bar[XB_TOPGEN]) == tg, bar);
            __builtin_amdgcn_fence(__ATOMIC_ACQUIRE, "agent");
            xb_add(&bar[XB_XGEN(b.x)], 1u);
            asm volatile("s_waitcnt vmcnt(0)" ::: "memory");
        } else {
            XB_SPIN(xb_ld(&bar[XB_XGEN(b.x)]) == gen, bar);
            __builtin_amdgcn_fence(__ATOMIC_ACQUIRE, "agent");
            asm volatile("s_waitcnt vmcnt(0)" ::: "memory");
        }
    }
    __syncthreads();
}
__device__ __forceinline__ void v8t_item(const bf16_t* __restrict__ KVA, unsigned char* __restrict__ V8T, int item, LAS unsigned char* scr, int lane) {
    const int kvh = item >> 8, T = item & 255;
    const bf16_t* src = KVA + (size_t)(64 * T) * PKV + 256 + kvh * 128;
#pragma unroll 4
    for (int i = 0; i < 16; ++i) { const int key = 4 * i + (lane >> 4), c0 = 8 * (lane & 15);
        const v4u raw = *(const v4u*)(src + (size_t)key * PKV + c0);
        int w0 = 0, w1 = 0;
        w0 = __builtin_amdgcn_cvt_pk_fp8_f32(__uint_as_float(raw.x << 16), __uint_as_float(raw.x & 0xffff0000u), w0, false); w0 = __builtin_amdgcn_cvt_pk_fp8_f32(__uint_as_float(raw.y << 16), __uint_as_float(raw.y & 0xffff0000u), w0, true);
        w1 = __builtin_amdgcn_cvt_pk_fp8_f32(__uint_as_float(raw.z << 16), __uint_as_float(raw.z & 0xffff0000u), w1, false); w1 = __builtin_amdgcn_cvt_pk_fp8_f32(__uint_as_float(raw.w << 16), __uint_as_float(raw.w & 0xffff0000u), w1, true);
        const int kq = key & 31, pos = 32 * ((kq >> 2) & 1) + 16 * (key >> 5) + (kq & 3) + 4 * (kq >> 3);
        LAS unsigned char* d = scr + c0 * 68 + pos;
        d[0 * 68] = (unsigned char)(w0); d[1 * 68] = (unsigned char)(w0 >> 8); d[2 * 68] = (unsigned char)(w0 >> 16); d[3 * 68] = (unsigned char)(w0 >> 24);
        d[4 * 68] = (unsigned char)(w1); d[5 * 68] = (unsigned char)(w1 >> 8); d[6 * 68] = (unsigned char)(w1 >> 16); d[7 * 68] = (unsigned char)(w1 >> 24); }
    asm volatile("s_waitcnt lgkmcnt(0)" ::: "memory");
#pragma unroll
    for (int i = 0; i < 8; ++i) { const int idx = lane + 64 * i, col = idx >> 2, ch = idx & 3; const LAS unsigned* s4 = (const LAS unsigned*)(scr + col * 68 + ch * 16);
        v4u w; w.x = s4[0]; w.y = s4[1]; w.z = s4[2]; w.w = s4[3];
        *(v4u*)(V8T + (size_t)(kvh * 128 + col) * 16384 + 64 * T + ch * 16) = w; }
    asm volatile("s_waitcnt lgkmcnt(0)" ::: "memory");
}
struct Args { const float* in[17]; float* out; unsigned char* ws; int ph_lo, ph_hi; };
__global__ void __launch_bounds__(512) fwd(Args args) {
    extern __shared__ __attribute__((aligned(16))) unsigned char lds[];
    cg::grid_group grid = cg::this_grid();
    const int tid0 = threadIdx.x;
    const int G0 = gridDim.x, bx0 = blockIdx.x;
    const int lo = args.ph_lo, hi = args.ph_hi;
    const int wave0 = __builtin_amdgcn_readfirstlane(tid0 >> 6);
    if (hi > 1000) grid.sync();
    volatile LAS unsigned* bst = (volatile LAS unsigned*)((LAS unsigned char*)lds + LDS_MISC);
    if (tid0 < 2) bst[tid0] = 0u;
    __syncthreads();
    const XcdBarrier bar = xcd_barrier_post((unsigned*)(args.ws + WS_BAR), bst);
#ifndef PHASE_MASK
#define PHASE_MASK 0x7ff
#endif
#define IN(k) (((PHASE_MASK >> (k)) & 1) && lo <= (k) && (k) < hi)
#define SEAM(k) do { if (IN(k) && IN((k) + 1)) { const int t_ = wave0 * 64 + (int)__builtin_amdgcn_mbcnt_hi(~0u, __builtin_amdgcn_mbcnt_lo(~0u, 0u)); xcd_barrier(bar, t_); } } while (0)
    typedef const __attribute__((address_space(4))) Args* ArgP;
#define ARGP() ({ ArgP p_ = (ArgP)__builtin_amdgcn_kernarg_segment_ptr(); asm volatile("" : "+s"(p_)); p_; })
#define WSP(off, T) ((T*)(A->ws + (off)))
#define OPQ() int G = G0, bx = bx0; asm volatile("" : "+s"(G), "+s"(bx)); int tid = wave0 * 64 + (int)__builtin_amdgcn_mbcnt_hi(~0u, __builtin_amdgcn_mbcnt_lo(~0u, 0u)); asm volatile("" : "+v"(tid)); const int lane = tid & 63, wave = __builtin_amdgcn_readfirstlane(tid >> 6), gw = bx * 8 + wave, NGW = G * 8; (void)gw; (void)NGW; (void)lane

    if (IN(0)) { ArgP A = ARGP(); OPQ();
        const float* cvec = A->in[1]; const float* w_ada = A->in[2]; const float* b_ada = A->in[3]; const float* w_in = A->in[5]; const float* w_oa = A->in[9]; const float* w_ob = A->in[10];
        const float* w_out = A->in[11]; const float* w_g = A->in[13]; const float* w_u = A->in[14]; const float* w_d = A->in[15]; float* mod = WSP(WS_MOD, float); float* tab = WSP(WS_ROPE, float);
        bf16_t* WinT = WSP(WS_WIN, bf16_t); bf16_t* WoT = WSP(WS_WO, bf16_t); bf16_t* WoutT = WSP(WS_WOUT, bf16_t); bf16_t* WguT = WSP(WS_WGU, bf16_t); bf16_t* WdT = WSP(WS_WD, bf16_t);
        LAS float* scr = (LAS float*)((LAS unsigned char*)lds + wave * 16384);
        constexpr int I_GEMV = 32 * 48, I_IN = (DM / 64) * (DIN / 32), I_OA = (1024 / 64) * (DM / 32), I_OUT = (DM / 64) * (DM / 32), I_G = (DM / 64) * (DFF / 32), I_D = (DFF / 64) * (DM / 32);
        constexpr int NITEMS = I_GEMV + I_IN + 2 * I_OA + I_OUT + I_D;
        for (int it = gw; it < NITEMS; it += NGW) {
            int r = it;
            if (r < I_GEMV) { gemv_item(cvec, w_ada, b_ada, mod, r, lane); continue; } r -= I_GEMV;
            if (r < I_IN) { transpose_item(w_in, DIN, WinT, PH, 0, 0, scr, r, lane); continue; } r -= I_IN;
            if (r < I_OA) { transpose_item(w_oa, DM, WoT, PH, 0, 0, scr, r, lane); continue; } r -= I_OA;
            if (r < I_OA) { transpose_item(w_ob, DM, WoT, PH, 1024, 0, scr, r, lane); continue; } r -= I_OA;
            if (r < I_OUT) { transpose_item(w_out, DM, WoutT, PH, 0, 0, scr, r, lane); continue; } r -= I_OUT;
            transpose_item(w_d, DM, WdT, PA, 0, 0, scr, r, lane);
        }
        for (int e = bx * 512 + tid; e < 320 * 32; e += G * 512) { const int pos = e >> 5, j = e & 31; const float p = (float)(pos < 256 ? pos : pos - 256);
            const float inv = powf(10000.0f, -(float)(2 * j) / 64.0f); const float ang = p * inv; tab[2 * e] = cosf(ang); tab[2 * e + 1] = sinf(ang);
        }
    }
    SEAM(0);
    if (IN(1)) { ArgP A = ARGP(); OPQ(); float* mod = WSP(WS_MOD, float); normmod_rows(A->in[0], A->in[4], mod + 2048, mod + 0, WSP(WS_H, bf16_t), gw, NGW, lane); }
    SEAM(1);
    if (IN(2)) { ArgP A = ARGP(); OPQ();
        pg8::Gemm g{WSP(WS_H, bf16_t), WSP(WS_WIN, bf16_t), SEQ, DIN, DM, PH}; pg8::StaticOrder S; S.init(SEQ, DIN, G, bx);
        pg8::EpiProj E{WSP(WS_QAB, bf16_t), WSP(WS_KVA, bf16_t), WSP(WS_KB, bf16_t), WSP(WS_VB, bf16_t), WSP(WS_GA, bf16_t), WSP(WS_GB, bf16_t)};
        pg8::gemm_phase<pg8::EpiProj, pg8::StaticOrder, GEMM_ALIGN, true, false>((LAS unsigned char*)lds, g, S, E, tid);
        {
            const int first = S.nwg % G;
            if (bx >= first) {
                constexpr int I_G2 = (DM / 64) * (DFF / 32);
                LAS float* scr = (LAS float*)((LAS unsigned char*)lds + wave * 16384);
                const float* w_g = A->in[13]; const float* w_u = A->in[14]; bf16_t* WguT = WSP(WS_WGU, bf16_t);
                for (int it = (bx - first) * 8 + wave; it < 2 * I_G2; it += (G - first) * 8) {
                    if (it < I_G2) transpose_item(w_g, DFF, WguT, PH, 0, 1, scr, it, lane); else transpose_item(w_u, DFF, WguT, PH, 0, 2, scr, it - I_G2, lane);
                }
            }
        }
    }
    SEAM(2);
    if (IN(3)) { ArgP A = ARGP(); OPQ();
        if ((wave & 3) == 0) { LAS unsigned char* scr = (LAS unsigned char*)lds + wave * 16384; for (int it = bx * 2 + (wave >> 2); it < 512; it += G * 2) v8t_item(WSP(WS_KVA, bf16_t), WSP(WS_V8T, unsigned char), it, scr, lane); }
        qknorm_rope(WSP(WS_QAB, bf16_t), WSP(WS_KVA, bf16_t), WSP(WS_Q8, unsigned char), WSP(WS_K8, unsigned char), A->in[6], A->in[7], WSP(WS_ROPE, float), gw, NGW, lane); }
    SEAM(3);
    if (IN(4)) { ArgP A = ARGP(); OPQ();
        using abf = att::bf16; bf16_t* QAB = WSP(WS_QAB, bf16_t); bf16_t* KVA = WSP(WS_KVA, bf16_t); bf16_t* KB = WSP(WS_KB, bf16_t); bf16_t* VB = WSP(WS_VB, bf16_t); const float* rpb = A->in[8];
        for (int u = bx; u < 512; u += G) { const int h = u >> 6, qb = u & 63, kvh = h >> 2;
            att::attn_unit_g8<1024, 256, 16384, PH>(WSP(WS_Q8, unsigned char) + (size_t)qb * 256 * 1024 + h * 128, WSP(WS_K8, unsigned char) + kvh * 128, WSP(WS_V8T, unsigned char) + (size_t)kvh * 128 * 16384,
                                                    (abf*)QAB + (size_t)qb * 256 * PH + h * 128, SEQ / 64, (char*)lds, A->in[6], A->in[7], tid);
        }
        for (int v = bx; v < 512; v += G) { const int h = v >> 6, qb = v & 63; int r_lo = 4 * qb - 4; r_lo = r_lo < 0 ? 0 : (r_lo > 244 ? 244 : r_lo);
            att::attn_unit<PH, PNB, PH, true, 1, 0>((const abf*)QAB + (size_t)qb * 256 * PH + 1024 + h * 128, (const abf*)KB + (size_t)r_lo * 64 * PNB + h * 128, (const abf*)VB + (size_t)r_lo * 64 * PNB + h * 128,
                                                   (abf*)QAB + (size_t)qb * 256 * PH + 1024 + h * 128, 12, (char*)lds, rpb + h * 15 * 31, nullptr, 4 * qb, r_lo, tid);
        }
        __syncthreads();
    }
    SEAM(4);
    if (IN(5)) { ArgP A = ARGP(); OPQ();
        pg8::Gemm g{WSP(WS_QAB, bf16_t), WSP(WS_WO, bf16_t), SEQ, DM, DM, PH}; pg8::StaticOrder S; S.init(SEQ, DM, G, bx);
        pg8::EpiMerged E{WSP(WS_GA, bf16_t), WSP(WS_GB, bf16_t), WSP(WS_H, bf16_t)};
        pg8::gemm_phase<pg8::EpiMerged, pg8::StaticOrder, GEMM_ALIGN, true, true>((LAS unsigned char*)lds, g, S, E, tid);
    }
    SEAM(5);
    if (IN(6)) { ArgP A = ARGP(); OPQ();
        pg8::Gemm g{WSP(WS_H, bf16_t), WSP(WS_WOUT, bf16_t), SEQ, DM, DM, PH}; pg8::StaticOrder S; S.init(SEQ, DM, G, bx);
        pg8::EpiDelta E{WSP(WS_GB, bf16_t), WSP(WS_MOD, float) + 4096};
        pg8::gemm_phase<pg8::EpiDelta, pg8::StaticOrder, GEMM_ALIGN, true, false>((LAS unsigned char*)lds, g, S, E, tid);
    }
    SEAM(6);
    if (IN(7)) { ArgP A = ARGP(); OPQ(); float* mod = WSP(WS_MOD, float); normmod_rows_d(A->in[0], WSP(WS_GB, bf16_t), A->in[12], mod + 8192, mod + 6144, WSP(WS_H, bf16_t), gw, NGW, lane); }
    SEAM(7);
    if (IN(8)) { ArgP A = ARGP(); OPQ();
        pg8::Gemm g{WSP(WS_H, bf16_t), WSP(WS_WGU, bf16_t), SEQ, 2 * DFF, DM, PH}; pg8::StaticOrder S; S.init(SEQ, 2 * DFF, G, bx);
        pg8::EpiSwiglu E{WSP(WS_ACT, bf16_t)};
        pg8::gemm_phase<pg8::EpiSwiglu, pg8::StaticOrder, GEMM_ALIGN, true, false>((LAS unsigned char*)lds, g, S, E, tid);
    }
    SEAM(8);
    if (IN(9)) { ArgP A = ARGP(); OPQ();
        pg8::Gemm g{WSP(WS_ACT, bf16_t), WSP(WS_WD, bf16_t), SEQ, DM, DFF, PA}; pg8::StaticOrder S; S.init(SEQ, DM, G, bx);
        pg8::EpiDelta E{WSP(WS_H, bf16_t), WSP(WS_MOD, float) + 10240};
        pg8::gemm_phase<pg8::EpiDelta, pg8::StaticOrder, GEMM_ALIGN, true, false>((LAS unsigned char*)lds, g, S, E, tid);
    }
    SEAM(9);
    if (IN(10)) { ArgP A = ARGP(); OPQ(); final_rows_d(A->in[0], WSP(WS_GB, bf16_t), WSP(WS_H, bf16_t), A->out, A->in[16], gw, NGW, lane); }
#undef IN
#undef SEAM
}

#ifndef N_LAUNCHES
#define N_LAUNCHES 1
#endif
extern "C" void kernel_launch(void* const* d_in, const int* in_sizes, int n_in, void* d_out, int out_size, void* d_ws, size_t ws_size, hipStream_t stream) {
    static int grid = 0;
    if (grid == 0) {
        if (n_in != 17 || in_sizes[0] != SEQ * DM || out_size != SEQ * DM || ws_size < WS_END) { fprintf(stderr, "kernel_launch: unexpected shapes: n_in %d in0 %d out %d ws %zu (need %zu)\n", n_in, n_in > 0 ? in_sizes[0] : -1, out_size, ws_size, (size_t)WS_END); grid = -1; return; }
        int dev = 0, cus = 0, per_cu = 0;
        if (hipGetDevice(&dev) != hipSuccess || hipDeviceGetAttribute(&cus, hipDeviceAttributeMultiprocessorCount, dev) != hipSuccess) { fprintf(stderr, "kernel_launch: device query failed\n"); grid = -1; return; }
        if (hipFuncSetAttribute((const void*)fwd, hipFuncAttributeMaxDynamicSharedMemorySize, LDS_BYTES) != hipSuccess) { fprintf(stderr, "kernel_launch: hipFuncSetAttribute failed\n"); grid = -1; return; }
        if (hipOccupancyMaxActiveBlocksPerMultiprocessor(&per_cu, (const void*)fwd, 512, LDS_BYTES) != hipSuccess || per_cu < 1) { fprintf(stderr, "kernel_launch: occupancy query says %d\n", per_cu); per_cu = 1; }
        (void)hipGetLastError();
        grid = cus * per_cu;
        fprintf(stderr, "kernel_launch: grid %d (cus %d x %d)\n", grid, cus, per_cu);
    }
    if (grid < 0) return;
    if (hipMemsetAsync((char*)d_ws + WS_MOD, 0, CTL_ZERO_BYTES, stream) != hipSuccess) { fprintf(stderr, "kernel_launch: memset failed\n"); return; }
    Args a{};
    for (int i = 0; i < 17; ++i) a.in[i] = (const float*)d_in[i];
    a.out = (float*)d_out; a.ws = (unsigned char*)d_ws;
    if (N_LAUNCHES == 1) {
        a.ph_lo = 0; a.ph_hi = NPHASE;
        void* kargs[] = {&a};
        const hipError_t e = hipLaunchCooperativeKernel((const void*)fwd, dim3(grid), dim3(512), kargs, LDS_BYTES, stream);
        if (e != hipSuccess) fprintf(stderr, "kernel_launch: cooperative launch failed: %s (grid %d)\n", hipGetErrorString(e), grid);
    } else {
        for (int p = 0; p < NPHASE; ++p) { a.ph_lo = p; a.ph_hi = p + 1;
            hipLaunchKernelGGL(fwd, dim3(grid), dim3(512), LDS_BYTES, stream, a);
            const hipError_t le = hipPeekAtLastError();
            if (le != hipSuccess) { fprintf(stderr, "kernel_launch: launch %d failed: %s\n", p, hipGetErrorName(le)); break; } }
    }
}
```

```cpp
#include <hip/hip_runtime.h>
#include <hip/hip_bf16.h>
#include <hip/hip_cooperative_groups.h>
#include <cstdio>
#include <cstdint>
#include <cmath>
#define N_LAUNCHES 1
namespace pg8 {
#define PG8_LAS __attribute__((address_space(3)))
typedef unsigned short bf16_t;
typedef short bf16x8 __attribute__((ext_vector_type(8)));
typedef float f32x4 __attribute__((ext_vector_type(4)));
typedef unsigned u32x4 __attribute__((ext_vector_type(4)));
constexpr int BM = 256, BK = 64, HALF = 128, HTB = HALF * BK * 2  , STAGE_BYTES = 8 * HTB, NXCD = 8, WGM = 8;

__host__ __device__ __forceinline__ int lds_byte(int r, int c) { const int st = (r >> 4) * 2 + (c >> 5), rr = r & 15, cc = c & 31, ob = rr * 64 + cc * 2; return st * 1024 + (ob ^ (((ob >> 9) & 1) << 5)); }
__host__ __device__ __forceinline__ void stage_rc(int b, int& R, int& C) { const int st = b / 1024, sb = b % 1024, swz = sb ^ (((sb >> 9) & 1) << 5); R = (st >> 1) * 16 + swz / 64; C = (st & 1) * 32 + (swz % 64) / 2; }
__host__ __device__ __forceinline__ int perm32(int rho) { const int n = rho >> 4, i = rho & 15; return 8 * (i >> 2) + 4 * n + (i & 3); }

struct Unit { int pm, pn; };
struct Gemm { const bf16_t* A; const bf16_t* Bt; int M, N, K, ld; };

struct StaticOrder {
    int nM, nN, nwg, G, c;
    __host__ __device__ void init(int M, int N, int G_, int c_) { nM = M / BM; nN = N / BM; nwg = nM * nN; G = G_; c = c_; }
    __host__ __device__ bool next(int i, Unit& u) const {
        const long L = (long)i * G + c; if (L >= nwg) return false;
        int wgid = (int)L; { const int q = nwg / NXCD, r = nwg % NXCD, xcd = wgid % NXCD, off = wgid / NXCD; wgid = (xcd < r ? xcd * (q + 1) : r * (q + 1) + (xcd - r) * q) + off; }
        const int nig = WGM * nN, gid = wgid / nig, fm = gid * WGM, gsz = (nM - fm) < WGM ? (nM - fm) : WGM;
        u.pm = fm + ((wgid % nig) % gsz); u.pn = (wgid % nig) / gsz; return true;
    }
    __device__ __forceinline__ void a_ready(const Unit&) const {}
    __device__ __forceinline__ void done(const Unit&) const {}
};

__device__ __forceinline__ unsigned cvt_pk_bf16(float lo, float hi) { unsigned r; asm volatile("v_cvt_pk_bf16_f32 %0, %1, %2" : "=v"(r) : "v"(lo), "v"(hi)); return r; }
constexpr int PH = 2176  , PA = 5760  , PKV = 640  , PNB = 1152  ;
__device__ __forceinline__ float bflo(unsigned w) { return __uint_as_float(w << 16); }
__device__ __forceinline__ float bfhi(unsigned w) { return __uint_as_float(w & 0xffff0000u); }
struct EpiProj {
    static constexpr bool PERM = true, AFTER_DRAIN = false;
    bf16_t *QAB, *KVA, *KB, *VB, *GA, *GB;
    __device__ __forceinline__ void operator()(const f32x4 (&acc)[2][2][4][2], const Unit& u, int wr, int wc, int fr, int fq) const {
        const int pn = u.pn; bf16_t* base; int ldc, colt;
        if (pn < 4) { base = QAB; ldc = PH; colt = pn * 256; }
        else if (pn < 6) { base = KVA; ldc = PKV; colt = (pn - 4) * 256; }
        else if (pn < 10) { base = QAB; ldc = PH; colt = 1024 + (pn - 6) * 256; }
        else if (pn < 14) { base = KB; ldc = PNB; colt = (pn - 10) * 256; }
        else if (pn < 18) { base = VB; ldc = PNB; colt = (pn - 14) * 256; }
        else if (pn < 26) { base = GA; ldc = PH; colt = (pn - 18) * 256; }
        else { base = GB; ldc = PH; colt = (pn - 26) * 256; }
        const int row0 = u.pm * BM + wr * 64 + fr, col0 = colt + wc * 32 + 8 * fq;
#pragma unroll
        for (int ai = 0; ai < 2; ++ai)
#pragma unroll
            for (int m = 0; m < 4; ++m) { bf16_t* rowp = base + (size_t)(row0 + ai * HALF + m * 16) * ldc + col0;
#pragma unroll
                for (int bj = 0; bj < 2; ++bj) { const f32x4 v0 = acc[ai][bj][m][0], v1 = acc[ai][bj][m][1];
                    u32x4 w; w.x = cvt_pk_bf16(v0[0], v0[1]); w.y = cvt_pk_bf16(v0[2], v0[3]); w.z = cvt_pk_bf16(v1[0], v1[1]); w.w = cvt_pk_bf16(v1[2], v1[3]);
                    *(u32x4*)(rowp + bj * HALF) = w; } }
    }
};
struct EpiMerged {
    static constexpr bool PERM = true, AFTER_DRAIN = false;
    const bf16_t *GA, *GB; bf16_t* O;
    __device__ __forceinline__ void mid(f32x4 (&acc)[2][2][4][2], const Unit& u, int wr, int wc, int fr, int fq) const {
        int row0 = u.pm * BM + wr * 64 + fr; const int col0 = u.pn * BM + wc * 32 + 8 * fq;
        asm volatile("" : "+v"(row0));
#pragma unroll
        for (int ai = 0; ai < 2; ++ai)
#pragma unroll
            for (int m = 0; m < 4; ++m)
#pragma unroll
                for (int bj = 0; bj < 2; ++bj) { const size_t off = (size_t)(row0 + ai * HALF + m * 16) * PH + col0 + bj * HALF;
                    const u32x4 a = *(const u32x4*)(GA + off), b = *(const u32x4*)(GB + off);
#pragma unroll
                    for (int e = 0; e < 4; ++e) { const float ga0 = bflo(a[e]), ga1 = bfhi(a[e]), gb0 = bflo(b[e]), gb1 = bfhi(b[e]);
                        const float r0 = (1.f + __expf(-gb0)) * __builtin_amdgcn_rcpf(1.f + __expf(-ga0)), r1 = (1.f + __expf(-gb1)) * __builtin_amdgcn_rcpf(1.f + __expf(-ga1));
                        acc[ai][bj][m][e >> 1][(e & 1) * 2] *= r0; acc[ai][bj][m][e >> 1][(e & 1) * 2 + 1] *= r1; }
                    if (bj == 1 && (m & 1)) asm volatile("" ::: "memory"); }
    }
    __device__ __forceinline__ void operator()(const f32x4 (&acc)[2][2][4][2], const Unit& u, int wr, int wc, int fr, int fq) const {
        const int row0 = u.pm * BM + wr * 64 + fr, col0 = u.pn * BM + wc * 32 + 8 * fq;
#pragma unroll
        for (int ai = 0; ai < 2; ++ai)
#pragma unroll
            for (int m = 0; m < 4; ++m)
#pragma unroll
                for (int bj = 0; bj < 2; ++bj) { const size_t off = (size_t)(row0 + ai * HALF + m * 16) * PH + col0 + bj * HALF;
                    const u32x4 b = *(const u32x4*)(GB + off); float o[8];
#pragma unroll
                    for (int e = 0; e < 4; ++e) { const float gb0 = bflo(b[e]), gb1 = bfhi(b[e]);
                        o[2 * e] = acc[ai][bj][m][e >> 1][(e & 1) * 2] * __builtin_amdgcn_rcpf(1.f + __expf(-gb0)); o[2 * e + 1] = acc[ai][bj][m][e >> 1][(e & 1) * 2 + 1] * __builtin_amdgcn_rcpf(1.f + __expf(-gb1)); }
                    u32x4 w; w.x = cvt_pk_bf16(o[0], o[1]); w.y = cvt_pk_bf16(o[2], o[3]); w.z = cvt_pk_bf16(o[4], o[5]); w.w = cvt_pk_bf16(o[6], o[7]);
                    *(u32x4*)(O + off) = w; }
    }
};
struct EpiResid {
    static constexpr bool PERM = false, AFTER_DRAIN = false;
    const float* base; float* out; const float* g;
    __device__ __forceinline__ void operator()(const f32x4 (&acc)[2][2][4][2], const Unit& u, int wr, int wc, int fr, int fq) const {
        const int row0 = u.pm * BM + wr * 64 + fr, col0 = u.pn * BM + wc * 32 + 4 * fq;
        f32x4 gv[2][2];
#pragma unroll
        for (int bj = 0; bj < 2; ++bj)
#pragma unroll
            for (int n = 0; n < 2; ++n) gv[bj][n] = *(const f32x4*)(g + col0 + bj * HALF + n * 16);
#pragma unroll
        for (int ai = 0; ai < 2; ++ai)
#pragma unroll
            for (int m = 0; m < 4; ++m) { const size_t off = (size_t)(row0 + ai * HALF + m * 16) * 2048 + col0;
#pragma unroll
                for (int bj = 0; bj < 2; ++bj)
#pragma unroll
                    for (int n = 0; n < 2; ++n) { const f32x4 bs = *(const f32x4*)(base + off + bj * HALF + n * 16);
                        *(f32x4*)(out + off + bj * HALF + n * 16) = bs + gv[bj][n] * acc[ai][bj][m][n]; } }
    }
};
struct EpiSwiglu {
    static constexpr bool PERM = true, AFTER_DRAIN = false;
    bf16_t* O;
    __device__ __forceinline__ void operator()(const f32x4 (&acc)[2][2][4][2], const Unit& u, int wr, int wc, int fr, int fq) const {
        const int row0 = u.pm * BM + wr * 64 + fr, col0 = u.pn * HALF + wc * 32 + 8 * fq;
#pragma unroll
        for (int ai = 0; ai < 2; ++ai)
#pragma unroll
            for (int m = 0; m < 4; ++m) { float o[8];
#pragma unroll
                for (int n = 0; n < 2; ++n)
#pragma unroll
                    for (int e = 0; e < 4; ++e) { const float gt = acc[ai][0][m][n][e], up = acc[ai][1][m][n][e]; o[4 * n + e] = gt * up * __builtin_amdgcn_rcpf(1.f + __expf(-gt)); }
                u32x4 w; w.x = cvt_pk_bf16(o[0], o[1]); w.y = cvt_pk_bf16(o[2], o[3]); w.z = cvt_pk_bf16(o[4], o[5]); w.w = cvt_pk_bf16(o[6], o[7]);
                *(u32x4*)(O + (size_t)(row0 + ai * HALF + m * 16) * PA + col0) = w; }
    }
};

struct EpiNull {
    static constexpr bool PERM = false, AFTER_DRAIN = false;
    float* out;
    __device__ __forceinline__ void operator()(const f32x4 (&acc)[2][2][4][2], const Unit& u, int wr, int wc, int fr, int fq) const {
        f32x4 s = {0.f, 0.f, 0.f, 0.f};
#pragma unroll
        for (int ai = 0; ai < 2; ++ai)
#pragma unroll
            for (int bj = 0; bj < 2; ++bj)
#pragma unroll
                for (int m = 0; m < 4; ++m)
#pragma unroll
                    for (int n = 0; n < 2; ++n) s += acc[ai][bj][m][n];
        if (s[0] + s[1] + s[2] + s[3] == 123456.789f) out[u.pm] = 1.f;
    }
};

struct EpiDelta {
    static constexpr bool PERM = true, AFTER_DRAIN = false;
    bf16_t* O; const float* g;
    __device__ __forceinline__ void operator()(const f32x4 (&acc)[2][2][4][2], const Unit& u, int wr, int wc, int fr, int fq) const {
        const int row0 = u.pm * BM + wr * 64 + fr, col0 = u.pn * BM + wc * 32 + 8 * fq;
        f32x4 gv[2][2];
#pragma unroll
        for (int bj = 0; bj < 2; ++bj)
#pragma unroll
            for (int n = 0; n < 2; ++n) gv[bj][n] = *(const f32x4*)(g + col0 + bj * HALF + 4 * n);
#pragma unroll
        for (int ai = 0; ai < 2; ++ai)
#pragma unroll
            for (int m = 0; m < 4; ++m) { bf16_t* rowp = O + (size_t)(row0 + ai * HALF + m * 16) * PH + col0;
#pragma unroll
                for (int bj = 0; bj < 2; ++bj) { const f32x4 v0 = acc[ai][bj][m][0] * gv[bj][0], v1 = acc[ai][bj][m][1] * gv[bj][1];
                    u32x4 w; w.x = cvt_pk_bf16(v0[0], v0[1]); w.y = cvt_pk_bf16(v0[2], v0[3]); w.z = cvt_pk_bf16(v1[0], v1[1]); w.w = cvt_pk_bf16(v1[2], v1[3]);
                    *(u32x4*)(rowp + bj * HALF) = w; } }
    }
};
template <class Epi, class Sched, bool ALIGN_EPI = false, bool SP2 = false, bool MID = false>
__device__ __forceinline__ void gemm_phase(PG8_LAS unsigned char* lds, const Gemm g, const Sched& S, const Epi& E, int tid_in) {
    int tid_ = tid_in; asm volatile("" : "+v"(tid_));
    const int tid = tid_, wid = __builtin_amdgcn_readfirstlane(tid >> 6), lane = tid & 63, wr = wid >> 2, wc = wid & 3, fr = lane & 15, fq = lane >> 4;
    const int K = g.K, nt = K / BK, LD = g.ld;
    unsigned voffA[2], voffB[2];
#pragma unroll
    for (int i = 0; i < 2; ++i) { int R, C; stage_rc(tid * 16 + i * 8192, R, C); const int Rb = Epi::PERM ? ((R & ~31) + perm32(R & 31)) : R;
        voffA[i] = (unsigned)(R * LD + C) * 2u; voffB[i] = (unsigned)(Rb * LD + C) * 2u; }
    const size_t kstep = (size_t)(BK * 2);
    const size_t hstep = (size_t)HALF * LD * 2;
    const size_t tstep = 2 * hstep;
    const unsigned ldsw = (unsigned)wid * 1024u;
    const int aoff = lds_byte(wr * 64 + fr, fq * 8), boff = lds_byte(wc * 32 + fr, fq * 8);
#define PG8_SA(b, h) (((b) * 2 + (h)) * HTB)
#define PG8_SB(b, h) ((4 + (b) * 2 + (h)) * HTB)
#define PG8_STAGE(bufoff, gbase, voff) do { _Pragma("unroll") for (int _i = 0; _i < 2; ++_i) \
        __builtin_amdgcn_global_load_lds((const unsigned*)((const char*)(gbase) + (voff)[_i]), (PG8_LAS unsigned*)(lds + (bufoff) + ldsw + _i * 8192), 16, 0, 0); } while (0)
#define PG8_LDA(dst, b, h) do { _Pragma("unroll") for (int m = 0; m < 4; ++m) _Pragma("unroll") for (int k = 0; k < 2; ++k) dst[m][k] = *(const PG8_LAS bf16x8*)(lds + PG8_SA(b, h) + aoff + m * 2048 + k * 1024); } while (0)
#define PG8_LDB(dst, b, h) do { _Pragma("unroll") for (int n = 0; n < 2; ++n) _Pragma("unroll") for (int k = 0; k < 2; ++k) dst[n][k] = *(const PG8_LAS bf16x8*)(lds + PG8_SB(b, h) + boff + n * 2048 + k * 1024); } while (0)
#define PG8_MMA(ai, bj, At, Bt) do { __builtin_amdgcn_s_setprio(1); _Pragma("unroll") for (int m = 0; m < 4; ++m) _Pragma("unroll") for (int n = 0; n < 2; ++n) _Pragma("unroll") for (int k = 0; k < 2; ++k) \
        acc[ai][bj][m][n] = __builtin_amdgcn_mfma_f32_16x16x32_bf16(Bt[n][k], At[m][k], acc[ai][bj][m][n], 0, 0, 0); __builtin_amdgcn_s_setprio(0); } while (0)
#define PG8_WAIT_V(n) asm volatile("s_waitcnt vmcnt(" #n ")" ::: "memory")
#define PG8_WAIT_L(n) asm volatile("s_waitcnt lgkmcnt(" #n ")" ::: "memory")
#define PG8_BAR __builtin_amdgcn_s_barrier()
#define PG8_SCHED __builtin_amdgcn_sched_barrier(0)
    Unit cur, nxt; int ui = 0;
    if (!S.next(0, cur)) return;
    f32x4 acc[2][2][4][2];
#pragma unroll
    for (int a = 0; a < 2; ++a)
#pragma unroll
        for (int b = 0; b < 2; ++b)
#pragma unroll
            for (int m = 0; m < 4; ++m)
#pragma unroll
                for (int n = 0; n < 2; ++n) acc[a][b][m][n] = (f32x4){0.f, 0.f, 0.f, 0.f};
    bf16x8 At[4][2], B0[2][2], B1[2][2];
    const char* cA = (const char*)g.A + (size_t)cur.pm * tstep; const char* cB = (const char*)g.Bt + (size_t)cur.pn * tstep;
    S.a_ready(cur);
    if constexpr (SP2) {
        PG8_STAGE(PG8_SB(0, 0), cB, voffB); PG8_STAGE(PG8_SB(0, 1), cB + hstep, voffB); PG8_STAGE(PG8_SA(0, 0), cA, voffA); PG8_STAGE(PG8_SA(0, 1), cA + hstep, voffA);
        if (wr == 1) PG8_BAR;
        PG8_WAIT_V(2); PG8_BAR;
        PG8_STAGE(PG8_SB(1, 0), cB + kstep, voffB); PG8_STAGE(PG8_SA(1, 0), cA + kstep, voffA); PG8_STAGE(PG8_SB(1, 1), cB + hstep + kstep, voffB);
        PG8_WAIT_V(6); PG8_BAR;
    } else {
        PG8_STAGE(PG8_SB(0, 0), cB, voffB); PG8_STAGE(PG8_SA(0, 0), cA, voffA); PG8_STAGE(PG8_SB(0, 1), cB + hstep, voffB); PG8_STAGE(PG8_SA(0, 1), cA + hstep, voffA);
        if (wr == 1) PG8_BAR;
        PG8_WAIT_V(4); PG8_BAR;
        PG8_STAGE(PG8_SB(1, 0), cB + kstep, voffB); PG8_STAGE(PG8_SA(1, 0), cA + kstep, voffA); PG8_STAGE(PG8_SB(1, 1), cB + hstep + kstep, voffB);
        PG8_WAIT_V(6); PG8_BAR;
    }
    for (;;) {
        const bool has_next = S.next(ui + 1, nxt);
        const char* nA = has_next ? (const char*)g.A + (size_t)nxt.pm * tstep : cA; const char* nB = has_next ? (const char*)g.Bt + (size_t)nxt.pn * tstep : cB;
        for (int t = 0; t < nt; t += 2) {
            if constexpr (MID) { if (t == (nt >> 1)) E.mid(acc, cur, wr, wc, fr, fq); }
            const bool last = (t == nt - 2);
            const char* a1 = cA + (size_t)(t + 1) * kstep;
            const char* a2 = last ? nA : cA + (size_t)(t + 2) * kstep; const char* b2 = last ? nB : cB + (size_t)(t + 2) * kstep;
            const char* a3 = a2 + kstep; const char* b3 = b2 + kstep;
            if (last && has_next) S.a_ready(nxt);
            if constexpr (SP2) {
            PG8_LDB(B0, 0, 0); PG8_LDB(B1, 0, 1); PG8_SCHED; PG8_LDA(At, 0, 0); PG8_STAGE(PG8_SA(1, 1), a1 + hstep, voffA);
            PG8_WAIT_V(8); PG8_WAIT_L(0); PG8_BAR; PG8_MMA(0, 0, At, B0); PG8_MMA(0, 1, At, B1); PG8_BAR; PG8_SCHED;
            PG8_LDA(At, 0, 1); PG8_STAGE(PG8_SB(0, 0), b2, voffB); PG8_STAGE(PG8_SB(0, 1), b2 + hstep, voffB); PG8_STAGE(PG8_SA(0, 0), a2, voffA);
            PG8_WAIT_V(8); PG8_WAIT_L(0); PG8_BAR; PG8_MMA(1, 0, At, B0); PG8_MMA(1, 1, At, B1); PG8_BAR; PG8_SCHED;
            PG8_LDB(B0, 1, 0); PG8_LDB(B1, 1, 1); PG8_SCHED; PG8_LDA(At, 1, 0); PG8_STAGE(PG8_SA(0, 1), a2 + hstep, voffA);
            PG8_WAIT_V(8); PG8_WAIT_L(0); PG8_BAR; PG8_MMA(0, 0, At, B0); PG8_MMA(0, 1, At, B1); PG8_BAR; PG8_SCHED;
            PG8_LDA(At, 1, 1); PG8_STAGE(PG8_SB(1, 0), b3, voffB); PG8_STAGE(PG8_SB(1, 1), b3 + hstep, voffB); PG8_STAGE(PG8_SA(1, 0), a3, voffA);
            PG8_WAIT_V(8); PG8_WAIT_L(0); PG8_BAR; PG8_MMA(1, 0, At, B0); PG8_MMA(1, 1, At, B1); PG8_BAR; PG8_SCHED;
            } else {
            PG8_LDB(B0, 0, 0); PG8_SCHED; PG8_LDA(At, 0, 0); PG8_STAGE(PG8_SA(1, 1), a1 + hstep, voffA);
            PG8_WAIT_L(8); PG8_BAR; PG8_WAIT_L(0); PG8_MMA(0, 0, At, B0); PG8_BAR; PG8_SCHED;
            PG8_LDB(B1, 0, 1); PG8_STAGE(PG8_SB(0, 0), b2, voffB);
            PG8_BAR; PG8_WAIT_L(0); PG8_MMA(0, 1, At, B1); PG8_BAR;
            PG8_LDA(At, 0, 1); PG8_STAGE(PG8_SA(0, 0), a2, voffA);
            PG8_BAR; PG8_WAIT_L(0); PG8_MMA(1, 0, At, B0); PG8_BAR; PG8_SCHED;
            PG8_STAGE(PG8_SB(0, 1), b2 + hstep, voffB);
            PG8_WAIT_V(6); PG8_BAR; PG8_MMA(1, 1, At, B1); PG8_BAR;
            PG8_LDB(B0, 1, 0); PG8_SCHED; PG8_LDA(At, 1, 0); PG8_STAGE(PG8_SA(0, 1), a2 + hstep, voffA);
            PG8_WAIT_L(8); PG8_BAR; PG8_WAIT_L(0); PG8_MMA(0, 0, At, B0); PG8_BAR; PG8_SCHED;
            PG8_LDB(B1, 1, 1); PG8_STAGE(PG8_SB(1, 0), b3, voffB);
            PG8_BAR; PG8_WAIT_L(0); PG8_MMA(0, 1, At, B1); PG8_BAR;
            PG8_LDA(At, 1, 1); PG8_STAGE(PG8_SA(1, 0), a3, voffA);
            PG8_BAR; PG8_WAIT_L(0); PG8_MMA(1, 0, At, B0); PG8_BAR; PG8_SCHED;
            PG8_STAGE(PG8_SB(1, 1), b3 + hstep, voffB);
            PG8_WAIT_V(6); PG8_BAR; PG8_MMA(1, 1, At, B1); PG8_BAR;
            }
        }
        if constexpr (ALIGN_EPI) { if (wr == 0) PG8_BAR; }
        if constexpr (!Epi::AFTER_DRAIN) { E(acc, cur, wr, wc, fr, fq); S.done(cur); }
        if (!has_next) break;
#pragma unroll
        for (int a = 0; a < 2; ++a)
#pragma unroll
            for (int b = 0; b < 2; ++b)
#pragma unroll
                for (int m = 0; m < 4; ++m)
#pragma unroll
                    for (int n = 0; n < 2; ++n) acc[a][b][m][n] = (f32x4){0.f, 0.f, 0.f, 0.f};
        cur = nxt; cA = nA; cB = nB; ++ui;
        if constexpr (ALIGN_EPI) { if (wr == 1) PG8_BAR; }
    }
    PG8_WAIT_V(0);
    if constexpr (!ALIGN_EPI) { if (wr == 0) PG8_BAR; }
    PG8_BAR;
    if constexpr (Epi::AFTER_DRAIN) { E.fused(acc, cur, wr, wc, fr, fq, lds, wid, lane); S.done(cur); }
#undef PG8_SA
#undef PG8_SB
#undef PG8_STAGE
#undef PG8_LDA
#undef PG8_LDB
#undef PG8_MMA
#undef PG8_WAIT_V
#undef PG8_WAIT_L
#undef PG8_BAR
#undef PG8_SCHED
}
}
namespace att {
using bf16 = __hip_bfloat16;
constexpr int D = 128, NW = 8, QBLK = 32, KVBLK = 64;
constexpr float SCALE = 0.088388347648318440f;
constexpr float THR = 8.f;
constexpr int SDEPTH = 2;
constexpr size_t SHM_V = KVBLK * D * 2, SHM_K = KVBLK * D * 2, SHM_ATTN = 2 * SHM_V + 2 * SHM_K + NW * 64 * 4;
using bf16x8 = __attribute__((ext_vector_type(8))) short;
using s16x4  = __attribute__((ext_vector_type(4))) short;
using f32x16 = __attribute__((ext_vector_type(16))) float;
using f32x8  = __attribute__((ext_vector_type(8))) float;
using u32x4  = __attribute__((ext_vector_type(4))) unsigned;
#define KSWZ(row, colB) ((row) * 256 + ((colB) ^ (((row) & 7) << 4)))
#define SBAR() __builtin_amdgcn_sched_barrier(0)
__device__ __forceinline__ int crow(int r, int hi) { return (r & 3) + 8 * (r >> 2) + 4 * hi; }
__device__ __forceinline__ unsigned cvtpk(float lo, float hi) {
  unsigned r; asm volatile("v_cvt_pk_bf16_f32 %0, %1, %2" : "=v"(r) : "v"(lo), "v"(hi)); return r;
}
template <typename TIn> struct Stage;
template <> struct Stage<bf16>  { using T = bf16x8;
  __device__ static __forceinline__ T ld8(const bf16* p) { return *reinterpret_cast<const bf16x8*>(p); }
  __device__ static __forceinline__ bf16x8 tobf(T x) { return x; } };
template <> struct Stage<float> { using T = f32x8;
  __device__ static __forceinline__ T ld8(const float* p) { return *reinterpret_cast<const f32x8*>(p); }
  __device__ static __forceinline__ bf16x8 tobf(T x) {
    u32x4 w = {cvtpk(x[0], x[1]), cvtpk(x[2], x[3]), cvtpk(x[4], x[5]), cvtpk(x[6], x[7])}; return *reinterpret_cast<bf16x8*>(&w); } };

__device__ __forceinline__ void partialSM(f32x16& p0, f32x16& p1, float& m_reg, float& mn, float& alpha) {
  constexpr float C = SCALE * 1.4426950408889634f;
  float pmax = p0[0]; for (int r = 1; r < 16; ++r) pmax = fmaxf(pmax, p0[r]); for (int r = 0; r < 16; ++r) pmax = fmaxf(pmax, p1[r]);
  { auto rr = __builtin_amdgcn_permlane32_swap(__float_as_uint(pmax), __float_as_uint(pmax), false, false);
    pmax = fmaxf(__uint_as_float(rr[0]), __uint_as_float(rr[1])); }
  if (__builtin_expect(__all(pmax - m_reg <= THR / SCALE), 1)) { mn = m_reg; alpha = 1.f; }
  else { mn = fmaxf(m_reg, pmax); alpha = __builtin_amdgcn_exp2f((m_reg - mn) * C); m_reg = mn; }
  float mnC = -mn * C;
  for (int r = 0; r < 16; ++r) p0[r] = fmaf(p0[r], C, mnC); for (int r = 0; r < 16; ++r) p1[r] = fmaf(p1[r], C, mnC);
  for (int r = 0; r < 16; ++r) p0[r] = __builtin_amdgcn_exp2f(p0[r]);
}
__device__ __forceinline__ void finishSM(f32x16& p0, f32x16& p1, float alpha, float& l_reg, bf16x8& pa0, bf16x8& pa1, bf16x8& pa2, bf16x8& pa3) {
  for (int r = 0; r < 16; ++r) p1[r] = __builtin_amdgcn_exp2f(p1[r]);
  float ps = 0; for (int r = 0; r < 16; ++r) ps += p0[r]; for (int r = 0; r < 16; ++r) ps += p1[r];
  { auto rr = __builtin_amdgcn_permlane32_swap(__float_as_uint(ps), __float_as_uint(ps), false, false);
    ps = __uint_as_float(rr[0]) + __uint_as_float(rr[1]); }
  l_reg = l_reg * alpha + ps;
#define PK4(P, BASE, OUT) do { unsigned a0 = cvtpk(P[BASE + 0], P[BASE + 1]), a1 = cvtpk(P[BASE + 2], P[BASE + 3]);   \
    unsigned b0 = cvtpk(P[BASE + 4], P[BASE + 5]), b1 = cvtpk(P[BASE + 6], P[BASE + 7]);                              \
    auto r0 = __builtin_amdgcn_permlane32_swap(a0, b0, false, false); auto r1 = __builtin_amdgcn_permlane32_swap(a1, b1, false, false); \
    u32x4 w = {r0[0], r1[0], r0[1], r1[1]}; OUT = *reinterpret_cast<bf16x8*>(&w); } while (0)
  PK4(p0, 0, pa0); PK4(p0, 8, pa1); PK4(p1, 0, pa2); PK4(p1, 8, pa3);
#undef PK4
}
__device__ __forceinline__ void qkt(f32x16& p0, f32x16& p1, const bf16* Ks, const bf16x8* qr, int r32, int hi) {
  p0 = f32x16{}; p1 = f32x16{};
  for (int d0 = 0; d0 < 8; ++d0) { int cb = (d0 * 16 + hi * 8) * 2;
    bf16x8 b0 = *reinterpret_cast<const bf16x8*>((const char*)Ks + KSWZ(r32, cb));
    bf16x8 b1 = *reinterpret_cast<const bf16x8*>((const char*)Ks + KSWZ(32 + r32, cb));
    p0 = __builtin_amdgcn_mfma_f32_32x32x16_bf16(b0, qr[d0], p0, 0, 0, 0);
    p1 = __builtin_amdgcn_mfma_f32_32x32x16_bf16(b1, qr[d0], p1, 0, 0, 0); }
}
__device__ __forceinline__ int v_st(int k, int c) { const int kk = (k & ~0xC) | ((k & 4) << 1) | ((k & 8) >> 1); return ((kk >> 3) * 4 + (c >> 5)) * 512 + ((kk & 7) * 32 + (c & 31)) * 2; }
__device__ __forceinline__ int v_rd_base(int lane) { return ((lane & 3) << 3) | (((lane >> 2) & 3) << 6) | (((lane >> 4) & 1) << 5) | (((lane >> 5) & 1) << 8); }
constexpr int v_rd_off(int d0, int ks, int half) { return d0 * 512 + ks * 4096 + half * 2048; }
template <int OFF> __device__ __forceinline__ s16x4 tr_read(int vb) {
  s16x4 r; asm volatile("ds_read_b64_tr_b16 %0, %1 offset:%2" : "=&v"(r) : "v"(vb), "i"(OFF) : "memory"); return r;
}
template <int D0> __device__ __forceinline__ void pv_one(f32x16& od, int vb, bf16x8 pa0, bf16x8 pa1, bf16x8 pa2, bf16x8 pa3) {
  const s16x4 l0 = tr_read<v_rd_off(D0, 0, 0)>(vb), h0 = tr_read<v_rd_off(D0, 0, 1)>(vb), l1 = tr_read<v_rd_off(D0, 1, 0)>(vb), h1 = tr_read<v_rd_off(D0, 1, 1)>(vb);
  const s16x4 l2 = tr_read<v_rd_off(D0, 2, 0)>(vb), h2 = tr_read<v_rd_off(D0, 2, 1)>(vb), l3 = tr_read<v_rd_off(D0, 3, 0)>(vb), h3 = tr_read<v_rd_off(D0, 3, 1)>(vb);
  asm volatile("s_waitcnt lgkmcnt(0)" ::: "memory"); SBAR();
#define PK(L, H) (bf16x8){L[0], L[1], L[2], L[3], H[0], H[1], H[2], H[3]}
  od = __builtin_amdgcn_mfma_f32_32x32x16_bf16(pa0, PK(l0, h0), od, 0, 0, 0);
  od = __builtin_amdgcn_mfma_f32_32x32x16_bf16(pa1, PK(l1, h1), od, 0, 0, 0);
  od = __builtin_amdgcn_mfma_f32_32x32x16_bf16(pa2, PK(l2, h2), od, 0, 0, 0);
  od = __builtin_amdgcn_mfma_f32_32x32x16_bf16(pa3, PK(l3, h3), od, 0, 0, 0);
#undef PK
}
__device__ __forceinline__ void pv_d0(f32x16* o, int vb, bf16x8 pa0, bf16x8 pa1, bf16x8 pa2, bf16x8 pa3) {
  pv_one<0>(o[0], vb, pa0, pa1, pa2, pa3); pv_one<1>(o[1], vb, pa0, pa1, pa2, pa3); pv_one<2>(o[2], vb, pa0, pa1, pa2, pa3); pv_one<3>(o[3], vb, pa0, pa1, pa2, pa3);
}
__device__ __forceinline__ void na_mask(f32x16& p0, f32x16& p1, const float* T, int tb, int kk, bool rowvalid) {
#pragma unroll
  for (int q = 0; q < 4; ++q) {
#pragma unroll
    for (int r = 4 * q; r < 4 * q + 4; ++r) { const int cr = (r & 3) + 8 * (r >> 2);
      const float b0 = T[tb + cr]; const bool v0 = rowvalid && (unsigned)(cr + kk) < 16u; p0[r] = v0 ? p0[r] + b0 : -INFINITY; }
    asm volatile("" ::: "memory");
#pragma unroll
    for (int r = 4 * q; r < 4 * q + 4; ++r) { const int cr = (r & 3) + 8 * (r >> 2);
      const float b1 = T[tb + 32 + cr]; const bool v1 = rowvalid && (unsigned)(cr + 32 + kk) < 16u; p1[r] = v1 ? p1[r] + b1 : -INFINITY; }
    asm volatile("" ::: "memory");
  }
}
__device__ __forceinline__ void partialSM_fx(f32x16& p0, f32x16& p1, float negMc) {
  (void)negMc;
  for (int r = 0; r < 16; ++r) p0[r] = __builtin_amdgcn_exp2f(p0[r]);
}
__device__ __forceinline__ void finishSM_fx(f32x16& p0, f32x16& p1, float& l_reg, bf16x8& pa0, bf16x8& pa1, bf16x8& pa2, bf16x8& pa3) {
  for (int r = 0; r < 16; ++r) p1[r] = __builtin_amdgcn_exp2f(p1[r]);
  float ps = 0; for (int r = 0; r < 16; ++r) ps += p0[r]; for (int r = 0; r < 16; ++r) ps += p1[r];
  l_reg += ps;
#define PK4(P, BASE, OUT) do { unsigned a0 = cvtpk(P[BASE + 0], P[BASE + 1]), a1 = cvtpk(P[BASE + 2], P[BASE + 3]);   \
    unsigned b0 = cvtpk(P[BASE + 4], P[BASE + 5]), b1 = cvtpk(P[BASE + 6], P[BASE + 7]);                              \
    auto r0 = __builtin_amdgcn_permlane32_swap(a0, b0, false, false); auto r1 = __builtin_amdgcn_permlane32_swap(a1, b1, false, false); \
    u32x4 w = {r0[0], r1[0], r0[1], r1[1]}; OUT = *reinterpret_cast<bf16x8*>(&w); } while (0)
  PK4(p0, 0, pa0); PK4(p0, 8, pa1); PK4(p1, 0, pa2); PK4(p1, 8, pa3);
#undef PK4
}
__device__ __forceinline__ void qkt_i(f32x16& p0, f32x16& p1, const bf16* Ks, const bf16x8* qr, int r32, int hi, float init) {
  for (int r = 0; r < 16; ++r) { p0[r] = init; p1[r] = init; }
  for (int d0 = 0; d0 < 8; ++d0) { int cb = (d0 * 16 + hi * 8) * 2;
    bf16x8 b0 = *reinterpret_cast<const bf16x8*>((const char*)Ks + KSWZ(r32, cb));
    bf16x8 b1 = *reinterpret_cast<const bf16x8*>((const char*)Ks + KSWZ(32 + r32, cb));
    p0 = __builtin_amdgcn_mfma_f32_32x32x16_bf16(b0, qr[d0], p0, 0, 0, 0);
    p1 = __builtin_amdgcn_mfma_f32_32x32x16_bf16(b1, qr[d0], p1, 0, 0, 0); }
}
template <int LDO>
__device__ __forceinline__ void store_o_tile(const f32x16* o, const float* rli, char* lds, int wid, int lane, bf16* Ow) {
  const int r32 = lane & 31, hi = lane >> 5;
  char* T = lds + wid * 8192;
#pragma unroll
  for (int r = 0; r < 16; ++r) { const int orow = crow(r, hi);
#pragma unroll
    for (int d0 = 0; d0 < 4; ++d0) *reinterpret_cast<bf16*>(T + orow * 256 + (d0 * 32 + r32) * 2) = __float2bfloat16(o[d0][r] * rli[r]); }
  asm volatile("s_waitcnt lgkmcnt(0)" ::: "memory");
#pragma unroll
  for (int i = 0; i < 8; ++i) { const int idx = lane + 64 * i, row = idx >> 4, ch = idx & 15;
    const u32x4 w = *reinterpret_cast<const u32x4*>(T + row * 256 + ch * 16);
    *reinterpret_cast<u32x4*>(Ow + (long)row * LDO + ch * 8) = w; }
  asm volatile("s_waitcnt lgkmcnt(0)" ::: "memory");
}
template <int LDQ, int LDK, int LDO, bool NA, int SD, int VOFF>
__device__ __forceinline__ void attn_unit(const bf16* Qb, const bf16* __restrict__ Kh, const bf16* __restrict__ Vh_, bf16* Ob, int NT, char* lds,
                                          const float* __restrict__ rpb  , const float* __restrict__ f1  , int qrow0, int krow0, int tid_in) {
  using St = Stage<bf16>;
  const bf16* __restrict__ Vh = VOFF ? Kh + VOFF : Vh_;
  int tid_ = tid_in; asm volatile("" : "+v"(tid_));
  const int tid = tid_, wid = __builtin_amdgcn_readfirstlane(tid >> 6), lane = tid & 63, r32 = lane & 31, hi = lane >> 5;
  bf16* V_lds = (bf16*)lds; bf16* K_lds = (bf16*)(lds + 2 * SHM_V);
  float* ws = (float*)(lds + 2 * SHM_V + 2 * SHM_K) + wid * 64; float* li_l = ws; float* al_l = ws + 32;
  float* T = (float*)(lds + SHM_ATTN);
  __syncthreads();
  int na_tb0 = 0, na_kk = 0, na_r = 0, na_rs = 0;
  if constexpr (NA) {
    for (int e = tid; e < 15 * 128; e += 512) { const int rr = e >> 7, x = e & 127; T[e] = (x >= 49 && x <= 79) ? rpb[rr * 31 + x - 49] * (1.0f / SCALE) : 0.f;
    }
    const int c = (wid & 1) * 32 + r32; int cs = c - 8; cs = cs < 0 ? 0 : (cs > 48 ? 48 : cs);
    na_tb0 = 64 - c + 4 * hi; na_kk = 4 * hi - cs;
    na_r = qrow0 + (wid >> 1); na_rs = na_r - 4; na_rs = na_rs < 0 ? 0 : (na_rs > 248 ? 248 : na_rs);
  }
  float negMc = 0.f;
  if constexpr (!NA) {
    float mq = fmaxf(fabsf(rpb[lane]), fabsf(rpb[lane + 64])), mk = fmaxf(fabsf(f1[lane]), fabsf(f1[lane + 64]));
#pragma unroll
    for (int o_ = 1; o_ < 64; o_ <<= 1) { mq = fmaxf(mq, __shfl_xor(mq, o_)); mk = fmaxf(mk, __shfl_xor(mk, o_)); }
    const float M = fminf(11.3137085f * 1.01f * mq * mk, 60.f);
    negMc = -M * 1.4426950408889634f;
  }
#define PSM(P0, P1, MN, AL) do { if constexpr (NA) partialSM(P0, P1, m_reg, MN, AL); else partialSM_fx(P0, P1, negMc); } while (0)
#define FSM(P0, P1, AL) do { if constexpr (NA) finishSM(P0, P1, AL, l_reg, pa0, pa1, pa2, pa3); else finishSM_fx(P0, P1, l_reg, pa0, pa1, pa2, pa3); } while (0)
#define NAMASK(P0, P1, ti) do { if constexpr (NA) { SBAR(); const int kr_ = krow0 + (ti); const bool rv_ = (unsigned)(kr_ - na_rs) < 8u; int rr_ = kr_ - na_r + 7; rr_ = rv_ ? rr_ : 0; \
    na_mask(P0, P1, T, na_tb0 + rr_ * 128, na_kk, rv_); SBAR(); } } while (0)
  float m_reg = -1e30f, l_reg = 0; f32x16 o[4] = {}; bf16x8 qr[8];
  const bf16* Qw = Qb + (long)(wid * QBLK + r32) * LDQ + hi * 8;
#pragma unroll
  for (int d0 = 0; d0 < 8; ++d0) qr[d0] = St::ld8(Qw + d0 * 16);
  const int sr = tid >> 4, sc = (tid & 15) * 8, vst0 = v_st(sr, sc), vst1 = v_st(32 + sr, sc);
  const int vb0 = (int)(uintptr_t)V_lds + v_rd_base(lane);
  struct { typename St::T vs0, vs1, ks0, ks1; } sr_[SD];
#define SLOAD(i, k0) do { sr_[i].vs0 = St::ld8(&Vh[(long)((k0) + sr) * LDK + sc]); sr_[i].vs1 = St::ld8(&Vh[(long)((k0) + 32 + sr) * LDK + sc]); \
    sr_[i].ks0 = St::ld8(&Kh[(long)((k0) + sr) * LDK + sc]); sr_[i].ks1 = St::ld8(&Kh[(long)((k0) + 32 + sr) * LDK + sc]); } while (0)
#define SWRITE(b, i) do { *(bf16x8*)((char*)V_lds + (b) * SHM_V + vst0) = St::tobf(sr_[i].vs0);          \
    *(bf16x8*)((char*)V_lds + (b) * SHM_V + vst1) = St::tobf(sr_[i].vs1); int kc = sc * 2;               \
    *(bf16x8*)((char*)K_lds + (b) * SHM_K + KSWZ(sr, kc)) = St::tobf(sr_[i].ks0);                       \
    *(bf16x8*)((char*)K_lds + (b) * SHM_K + KSWZ(32 + sr, kc)) = St::tobf(sr_[i].ks1); } while (0)
#define SWAIT() do { if constexpr (SD == 2) asm volatile("s_waitcnt vmcnt(4)" ::: "memory"); else asm volatile("s_waitcnt vmcnt(0)" ::: "memory"); } while (0)
#define RESC(a) do { if constexpr (NA) if (__any((a) < 1.f)) { if (hi == 0) al_l[r32] = (a); asm volatile("s_waitcnt lgkmcnt(0)" ::: "memory"); \
    for (int d = 0; d < 4; ++d) for (int r = 0; r < 16; ++r) o[d][r] *= al_l[crow(r, hi)]; } } while (0)
  f32x16 pA0, pA1, pB0, pB1; float mnA, mnB, alA, alB; bf16x8 pa0, pa1, pa2, pa3;
  constexpr int SE = 0, SO = SD - 1;
  SLOAD(SE, 0); asm volatile("s_waitcnt vmcnt(0)" ::: "memory"); SWRITE(0, SE); __syncthreads();
  qkt_i(pA0, pA1, K_lds, qr, r32, hi, negMc); NAMASK(pA0, pA1, 0); PSM(pA0, pA1, mnA, alA);
  SLOAD(SO, KVBLK); if constexpr (SD == 2) { if (2 < NT) SLOAD(SE, 2 * KVBLK); }
  SWAIT(); SWRITE(1, SO); __syncthreads();
  for (int j = 1; j + 1 < NT; j += 2) {
    SBAR(); qkt_i(pB0, pB1, (bf16*)((char*)K_lds + SHM_K), qr, r32, hi, negMc);
    FSM(pA0, pA1, alA); SBAR();
    SLOAD(SO, (j + SD) * KVBLK); SBAR();
    pv_d0(o, vb0, pa0, pa1, pa2, pa3); NAMASK(pB0, pB1, j); PSM(pB0, pB1, mnB, alB);
    __syncthreads(); SWAIT(); SWRITE(0, SE);
    RESC(alB); __syncthreads();
    SBAR(); qkt_i(pA0, pA1, K_lds, qr, r32, hi, negMc);
    FSM(pB0, pB1, alB); SBAR();
    if (SD == 1 || j + 3 < NT) SLOAD(SE, (j + 1 + SD) * KVBLK); SBAR();
    pv_d0(o, vb0 + (int)SHM_V, pa0, pa1, pa2, pa3); NAMASK(pA0, pA1, j + 1); PSM(pA0, pA1, mnA, alA);
    __syncthreads(); SWAIT(); SWRITE(1, SO);
    RESC(alA); __syncthreads();
  }
  SBAR(); qkt_i(pB0, pB1, (bf16*)((char*)K_lds + SHM_K), qr, r32, hi, negMc);
  FSM(pA0, pA1, alA); SBAR();
  pv_d0(o, vb0, pa0, pa1, pa2, pa3); NAMASK(pB0, pB1, NT - 1); PSM(pB0, pB1, mnB, alB);
  __syncthreads(); RESC(alB);
  FSM(pB0, pB1, alB); SBAR();
  pv_d0(o, vb0 + (int)SHM_V, pa0, pa1, pa2, pa3);
  if constexpr (!NA) { auto rr_ = __builtin_amdgcn_permlane32_swap(__float_as_uint(l_reg), __float_as_uint(l_reg), false, false); l_reg = __uint_as_float(rr_[0]) + __uint_as_float(rr_[1]); }
  if (hi == 0) li_l[r32] = l_reg; asm volatile("s_waitcnt lgkmcnt(0)" ::: "memory");
  float rli[16];
#pragma unroll
  for (int r = 0; r < 16; ++r) rli[r] = __builtin_amdgcn_rcpf(li_l[crow(r, hi)]);
  __syncthreads();
  store_o_tile<LDO>(o, rli, lds, wid, lane, Ob + (long)(wid * QBLK) * LDO);
#undef SLOAD
#undef SWRITE
#undef SWAIT
#undef RESC
#undef NAMASK
#undef PSM
#undef FSM
}

typedef int v8i_t __attribute__((ext_vector_type(8)));
#define KSWZ8(row, colB) ((row) * 128 + ((colB) ^ ((((row) >> 1) & 7) << 4)))
__device__ __forceinline__ void qkt8(f32x16& p0, f32x16& p1, const char* Ks, const v8i_t* q8, int r32, int hi, float init) {
  for (int r = 0; r < 16; ++r) { p0[r] = init; p1[r] = init; }
#pragma unroll
  for (int s = 0; s < 2; ++s) { const int cb = 64 * s + 32 * hi;
    const u32x4 a00 = *reinterpret_cast<const u32x4*>(Ks + KSWZ8(r32, cb)), a01 = *reinterpret_cast<const u32x4*>(Ks + KSWZ8(r32, cb + 16));
    const u32x4 a10 = *reinterpret_cast<const u32x4*>(Ks + KSWZ8(32 + r32, cb)), a11 = *reinterpret_cast<const u32x4*>(Ks + KSWZ8(32 + r32, cb + 16));
    const v8i_t A0 = {(int)a00.x, (int)a00.y, (int)a00.z, (int)a00.w, (int)a01.x, (int)a01.y, (int)a01.z, (int)a01.w};
    const v8i_t A1 = {(int)a10.x, (int)a10.y, (int)a10.z, (int)a10.w, (int)a11.x, (int)a11.y, (int)a11.z, (int)a11.w};
    p0 = __builtin_amdgcn_mfma_scale_f32_32x32x64_f8f6f4(A0, q8[s], p0, 0, 0, 0, 0, 0, 0);
    p1 = __builtin_amdgcn_mfma_scale_f32_32x32x64_f8f6f4(A1, q8[s], p1, 0, 0, 0, 0, 0, 0); }
}
#define VSWZ8(row, colB) ((row) * 64 + ((colB) ^ ((((row) >> 2) & 3) << 4)))
__device__ __forceinline__ void finishSM_fx8(f32x16& p0, f32x16& p1, float& l_reg, v8i_t& P8) {
  for (int r = 0; r < 16; ++r) p1[r] = __builtin_amdgcn_exp2f(p1[r]);
  float ps = 0; for (int r = 0; r < 16; ++r) ps += p0[r]; for (int r = 0; r < 16; ++r) ps += p1[r];
  l_reg += ps;
#pragma unroll
  for (int i = 0; i < 4; ++i) { int w = 0; w = __builtin_amdgcn_cvt_pk_bf8_f32(p0[4 * i], p0[4 * i + 1], w, false); w = __builtin_amdgcn_cvt_pk_bf8_f32(p0[4 * i + 2], p0[4 * i + 3], w, true); P8[i] = w; }
#pragma unroll
  for (int i = 0; i < 4; ++i) { int w = 0; w = __builtin_amdgcn_cvt_pk_bf8_f32(p1[4 * i], p1[4 * i + 1], w, false); w = __builtin_amdgcn_cvt_pk_bf8_f32(p1[4 * i + 2], p1[4 * i + 3], w, true); P8[4 + i] = w; }
}
__device__ __forceinline__ void pv8(f32x16* o, const char* Vs, const v8i_t P8, int r32, int hi) {
#pragma unroll
  for (int d0 = 0; d0 < 4; ++d0) { const int row = 32 * d0 + r32;
    const u32x4 b0 = *reinterpret_cast<const u32x4*>(Vs + VSWZ8(row, 32 * hi)), b1 = *reinterpret_cast<const u32x4*>(Vs + VSWZ8(row, 32 * hi + 16));
    const v8i_t B = {(int)b0.x, (int)b0.y, (int)b0.z, (int)b0.w, (int)b1.x, (int)b1.y, (int)b1.z, (int)b1.w};
    o[d0] = __builtin_amdgcn_mfma_scale_f32_32x32x64_f8f6f4(P8, B, o[d0], 1  , 0  , 0, 0, 0, 0); }
}
template <int LDQ8, int LDK8, int LDVT, int LDO>
__device__ __forceinline__ void attn_unit_g8(const unsigned char* Q8, const unsigned char* __restrict__ K8h, const unsigned char* __restrict__ V8Th, bf16* Ob, int NT, char* lds,
                                             const float* __restrict__ qnw, const float* __restrict__ knw, int tid_in) {
  int tid_ = tid_in; asm volatile("" : "+v"(tid_));
  const int tid = tid_, wid = __builtin_amdgcn_readfirstlane(tid >> 6), lane = tid & 63, r32 = lane & 31, hi = lane >> 5;
  char* V_lds = lds; char* K_lds = lds + 2 * SHM_V;
  float* ws = (float*)(lds + 2 * SHM_V + 2 * SHM_K) + wid * 64; float* li_l = ws;
  __syncthreads();
  float negMc;
  { float mq = fmaxf(fabsf(qnw[lane]), fabsf(qnw[lane + 64])), mk = fmaxf(fabsf(knw[lane]), fabsf(knw[lane + 64]));
#pragma unroll
    for (int o_ = 1; o_ < 64; o_ <<= 1) { mq = fmaxf(mq, __shfl_xor(mq, o_)); mk = fmaxf(mk, __shfl_xor(mk, o_)); }
    const float M = fminf(11.3137085f * 1.07f * mq * mk, 60.f);
    negMc = __uint_as_float(__builtin_amdgcn_readfirstlane(__float_as_uint(15.0f - M * 1.4426950408889634f))); }
  float l_reg = 0; f32x16 o[4] = {}; v8i_t q8[2];
  { const unsigned char* Qw = Q8 + (long)(wid * QBLK + r32) * LDQ8 + hi * 32;
#pragma unroll
    for (int s = 0; s < 2; ++s) { const u32x4 a = *reinterpret_cast<const u32x4*>(Qw + 64 * s), b = *reinterpret_cast<const u32x4*>(Qw + 64 * s + 16);
      q8[s] = (v8i_t){(int)a.x, (int)a.y, (int)a.z, (int)a.w, (int)b.x, (int)b.y, (int)b.z, (int)b.w}; } }
  const int kr = tid >> 3, kc = (tid & 7) * 16, kst = KSWZ8(kr, kc);
  const int vr = tid >> 2, vc = (tid & 3) * 16, vst = VSWZ8(vr, vc);
  u32x4 vs, ks;
  unsigned vo = (unsigned)(vr * LDVT + vc), ko = (unsigned)(kr * LDK8 + kc);
#define SLOAD(k0) do { vs = *reinterpret_cast<const u32x4*>(V8Th + vo); ks = *reinterpret_cast<const u32x4*>(K8h + ko); vo += KVBLK; ko += KVBLK * LDK8; asm volatile("" : "+v"(vo), "+v"(ko)); } while (0)
#define SWRITE(b) do { *(u32x4*)(V_lds + (b) * SHM_V + vst) = vs; *(u32x4*)(K_lds + (b) * SHM_K + kst) = ks; } while (0)
#define SWAIT() asm volatile("s_waitcnt vmcnt(0)" ::: "memory")
  f32x16 pA0, pA1, pB0, pB1; v8i_t P8;
#define SWRITE4(b) do { *(u32x4*)(V_lds + (b) * 8192 + vst) = vs; *(u32x4*)(K_lds + (b) * 8192 + kst) = ks; } while (0)
#define STEP(PN0, PN1, PO0, PO1, KB, VB, WB, JJ, LOADS) do { \
    SBAR(); qkt8(PN0, PN1, K_lds + (KB) * 8192, q8, r32, hi, negMc); \
    finishSM_fx8(PO0, PO1, l_reg, P8); SBAR(); \
    if (LOADS) SLOAD(((JJ) + 2) * KVBLK); SBAR(); \
    pv8(o, V_lds + (VB) * 8192, P8, r32, hi); partialSM_fx(PN0, PN1, negMc); \
    __syncthreads(); if (LOADS) { SWAIT(); SWRITE4(WB); } } while (0)
  SLOAD(0); SWAIT(); SWRITE4(0);
  SLOAD(KVBLK); SWAIT(); SWRITE4(1); __syncthreads();
  SLOAD(2 * KVBLK);
  qkt8(pA0, pA1, K_lds, q8, r32, hi, negMc); partialSM_fx(pA0, pA1, negMc);
  SWAIT(); SWRITE4(2);
  int j = 1;
  for (; j + 5 < NT; j += 4) {
    STEP(pB0, pB1, pA0, pA1, 1, 0, 3, j, true);
    STEP(pA0, pA1, pB0, pB1, 2, 1, 0, j + 1, true);
    STEP(pB0, pB1, pA0, pA1, 3, 2, 1, j + 2, true);
    STEP(pA0, pA1, pB0, pB1, 0, 3, 2, j + 3, true);
  }
  STEP(pB0, pB1, pA0, pA1, 1, 0, 3, j, true);
  STEP(pA0, pA1, pB0, pB1, 2, 1, 0, j + 1, false);
  SBAR(); qkt8(pB0, pB1, K_lds + 3 * 8192, q8, r32, hi, negMc);
  finishSM_fx8(pA0, pA1, l_reg, P8); SBAR();
  pv8(o, V_lds + 2 * 8192, P8, r32, hi); partialSM_fx(pB0, pB1, negMc);
  finishSM_fx8(pB0, pB1, l_reg, P8); SBAR();
  pv8(o, V_lds + 3 * 8192, P8, r32, hi);
#undef STEP
#undef SWRITE4
  { auto rr_ = __builtin_amdgcn_permlane32_swap(__float_as_uint(l_reg), __float_as_uint(l_reg), false, false); l_reg = __uint_as_float(rr_[0]) + __uint_as_float(rr_[1]); }
  if (hi == 0) li_l[r32] = l_reg; asm volatile("s_waitcnt lgkmcnt(0)" ::: "memory");
  float rli[16];
#pragma unroll
  for (int r = 0; r < 16; ++r) rli[r] = __builtin_amdgcn_rcpf(li_l[crow(r, hi)]);
  __syncthreads();
  store_o_tile<LDO>(o, rli, lds, wid, lane, Ob + (long)(wid * QBLK) * LDO);
#undef SLOAD
#undef SWRITE
#undef SWAIT
}
#undef SBAR
}
namespace cg = cooperative_groups;
#define LAS __attribute__((address_space(3)))
typedef unsigned short bf16_t;
typedef float f32x4 __attribute__((ext_vector_type(4)));
typedef unsigned v4u __attribute__((ext_vector_type(4)));
typedef unsigned v2u __attribute__((ext_vector_type(2)));
constexpr int SEQ = 16384, DM = 2048, DIN = 8704, DFF = 5632, NMOD = 6 * DM;
constexpr float NORM_EPS = 1e-6f;
constexpr size_t MiB = 1u << 20;
constexpr size_t WS_MOD = 0, CTL_ZERO_BYTES = 64 * 1024;
constexpr size_t WS_ROPE = 1 * MiB;
using pg8::PH; using pg8::PA; using pg8::PKV; using pg8::PNB;
constexpr size_t WS_WIN = 2 * MiB, WS_WO = 39 * MiB, WS_WOUT = 48 * MiB, WS_WGU = 57 * MiB, WS_WD = 104 * MiB;
constexpr size_t WS_H = 128 * MiB;
constexpr size_t WS_Q8 = WS_H, WS_K8 = WS_H + 16 * MiB, WS_V8T = WS_H + 20 * MiB;
constexpr size_t WS_QAB = 196 * MiB, WS_KVA = 264 * MiB, WS_KB = 284 * MiB, WS_VB = 320 * MiB, WS_GA = 356 * MiB, WS_GB = 424 * MiB, WS_END = 492 * MiB;
constexpr size_t WS_ACT = 196 * MiB;
static_assert(WS_WIN + (size_t)DIN * PH * 2 <= WS_WO && WS_WO + (size_t)DM * PH * 2 <= WS_WOUT && WS_WOUT + (size_t)DM * PH * 2 <= WS_WGU && WS_WGU + (size_t)2 * DFF * PH * 2 <= WS_WD && WS_WD + (size_t)DM * PA * 2 <= WS_H, "weight map");
static_assert(WS_H + (size_t)SEQ * PH * 2 <= WS_QAB && WS_QAB + (size_t)SEQ * PH * 2 <= WS_KVA && WS_KVA + (size_t)SEQ * PKV * 2 <= WS_KB && WS_KB + (size_t)SEQ * PNB * 2 <= WS_VB && WS_VB + (size_t)SEQ * PNB * 2 <= WS_GA &&
              WS_GA + (size_t)SEQ * PH * 2 <= WS_GB && WS_GB + (size_t)SEQ * PH * 2 <= WS_END && WS_ACT + (size_t)SEQ * PA * 2 <= WS_GB && WS_V8T + 4 * MiB <= WS_QAB, "activation map");
constexpr size_t WS_BAR = 49152;
constexpr int LDS_BYTES = 147456, LDS_MISC = 131072;
constexpr int NPHASE = 11;
#ifndef GEMM_SP2
#define GEMM_SP2 true
#endif
#ifndef GEMM_ALIGN
#define GEMM_ALIGN true
#endif
#ifndef GATT_SD
#define GATT_SD 1
#endif
#ifndef STAGGER_SLEEPS
#define STAGGER_SLEEPS 7
#endif

__device__ __forceinline__ unsigned f2bf(float f) { unsigned u = __builtin_bit_cast(unsigned, f); return (u + 0x7fffu + ((u >> 16) & 1u)) >> 16; }
__device__ __forceinline__ unsigned pk2(float lo, float hi) { return f2bf(lo) | (f2bf(hi) << 16); }
__device__ __forceinline__ float wave_sum(float v) {
#pragma unroll
    for (int o = 1; o < 64; o <<= 1) v += __shfl_xor(v, o);
    return v;
}
__device__ __forceinline__ void transpose_item(const float* __restrict__ W, int N, bf16_t* __restrict__ WT, int ldt, int koff, int mode, LAS float* scr, int item, int lane) {
    const int nblk = N / 32, kb = item / nblk, nb = item % nblk, k0 = 64 * kb, n0 = 32 * nb;
    const int drow0 = mode == 0 ? n0 : ((n0 >> 7) * 256 + (n0 & 127) + (mode == 2 ? 128 : 0));
#pragma unroll 8
    for (int i = 0; i < 32; ++i) { const int kk = 2 * i + (lane >> 5); scr[kk * 33 + (lane & 31)] = W[(size_t)(k0 + kk) * N + n0 + (lane & 31)]; }
    asm volatile("s_waitcnt lgkmcnt(0)" ::: "memory");
    const int c = lane & 7;
#pragma unroll
    for (int j = 0; j < 4; ++j) { const int n = (lane >> 3) + 8 * j; const LAS float* s = scr + (8 * c) * 33 + n;
        v4u o; o.x = pk2(s[0 * 33], s[1 * 33]); o.y = pk2(s[2 * 33], s[3 * 33]); o.z = pk2(s[4 * 33], s[5 * 33]); o.w = pk2(s[6 * 33], s[7 * 33]);
        *(v4u*)(WT + (size_t)(drow0 + n) * ldt + koff + k0 + 8 * c) = o; }
    asm volatile("s_waitcnt lgkmcnt(0)" ::: "memory");
}
__device__ __forceinline__ void gemv_item(const float* __restrict__ cvec, const float* __restrict__ w_ada, const float* __restrict__ b_ada, float* mod, int item, int lane) {
    const int kc = item / 48, jc = item % 48, col = jc * 256 + 4 * lane;
    f32x4 acc = {0.f, 0.f, 0.f, 0.f};
#pragma unroll 8
    for (int kk = 0; kk < 64; ++kk) { const int k = kc * 64 + kk; const float cv = cvec[k]; const float s = cv / (1.f + expf(-cv));
        const f32x4 w = *(const f32x4*)(w_ada + (size_t)k * NMOD + col); acc += w * s; }
    if (kc == 0) acc += *(const f32x4*)(b_ada + col);
#pragma unroll
    for (int e = 0; e < 4; ++e) __hip_atomic_fetch_add(mod + col + e, acc[e], __ATOMIC_RELAXED, __HIP_MEMORY_SCOPE_AGENT);
}
__device__ __forceinline__ void normmod_rows(const float* X, const float* __restrict__ nw, const float* __restrict__ sc, const float* __restrict__ sh, bf16_t* __restrict__ H, int gw, int NGW, int mend, int lane) {
    f32x4 a[8], b[8];
#pragma unroll
    for (int j = 0; j < 8; ++j) { const int col = 4 * lane + 256 * j; const f32x4 w = *(const f32x4*)(nw + col), s = *(const f32x4*)(sc + col); a[j] = w * (s + 1.0f); b[j] = *(const f32x4*)(sh + col); }
    for (int m = gw; m < mend; m += NGW) {
        const f32x4* xr = (const f32x4*)(X + (size_t)m * DM) + lane; f32x4 v[8]; float ss = 0.f;
#pragma unroll
        for (int j = 0; j < 8; ++j) { v[j] = xr[64 * j]; ss += (v[j].x * v[j].x + v[j].y * v[j].y) + (v[j].z * v[j].z + v[j].w * v[j].w); }
        const float rstd = rsqrtf(wave_sum(ss) * (1.0f / DM) + NORM_EPS);
        v2u* o8 = (v2u*)(H + (size_t)m * PH) + lane;
#pragma unroll
        for (int j = 0; j < 8; ++j) { const f32x4 y = v[j] * rstd * a[j] + b[j]; v2u w; w.x = pk2(y.x, y.y); w.y = pk2(y.z, y.w);
            o8[64 * j] = w; }
    }
}
__device__ __forceinline__ f32x4 bf4(v2u w) { f32x4 r; r.x = __uint_as_float(w.x << 16); r.y = __uint_as_float(w.x & 0xffff0000u); r.z = __uint_as_float(w.y << 16); r.w = __uint_as_float(w.y & 0xffff0000u); return r; }
__device__ __forceinline__ void normmod_rows_d(const float* __restrict__ X, const bf16_t* __restrict__ D1, const float* __restrict__ nw, const float* __restrict__ sc, const float* __restrict__ sh, bf16_t* __restrict__ H, int gw, int NGW, int mend, int lane) {
    f32x4 a[8], b[8];
#pragma unroll
    for (int j = 0; j < 8; ++j) { const int col = 4 * lane + 256 * j; const f32x4 w = *(const f32x4*)(nw + col), s = *(const f32x4*)(sc + col); a[j] = w * (s + 1.0f); b[j] = *(const f32x4*)(sh + col); }
    for (int m = gw; m < mend; m += NGW) {
        const f32x4* xr = (const f32x4*)(X + (size_t)m * DM) + lane; const v2u* dr = (const v2u*)(D1 + (size_t)m * PH) + lane; f32x4 v[8]; float ss = 0.f;
#pragma unroll
        for (int j = 0; j < 8; ++j) { v[j] = xr[64 * j] + bf4(dr[64 * j]); ss += (v[j].x * v[j].x + v[j].y * v[j].y) + (v[j].z * v[j].z + v[j].w * v[j].w); }
        const float rstd = rsqrtf(wave_sum(ss) * (1.0f / DM) + NORM_EPS);
        v2u* o8 = (v2u*)(H + (size_t)m * PH) + lane;
#pragma unroll
        for (int j = 0; j < 8; ++j) { const f32x4 y = v[j] * rstd * a[j] + b[j]; v2u w; w.x = pk2(y.x, y.y); w.y = pk2(y.z, y.w); o8[64 * j] = w; }
    }
}
__device__ __forceinline__ void final_rows_d(const float* __restrict__ X, const bf16_t* __restrict__ D1, const bf16_t* __restrict__ D2, float* __restrict__ OUT, const float* __restrict__ fw, int gw, int NGW, int mend, int lane) {
    f32x4 a[8];
#pragma unroll
    for (int j = 0; j < 8; ++j) a[j] = *(const f32x4*)(fw + 4 * lane + 256 * j);
    for (int m = gw; m < mend; m += NGW) {
        const f32x4* xr = (const f32x4*)(X + (size_t)m * DM) + lane; const v2u* d1 = (const v2u*)(D1 + (size_t)m * PH) + lane; const v2u* d2 = (const v2u*)(D2 + (size_t)m * PH) + lane; f32x4 v[8]; float ss = 0.f;
#pragma unroll
        for (int j = 0; j < 8; ++j) { v[j] = (xr[64 * j] + bf4(d1[64 * j])) + bf4(d2[64 * j]); ss += (v[j].x * v[j].x + v[j].y * v[j].y) + (v[j].z * v[j].z + v[j].w * v[j].w); }
        const float rstd = rsqrtf(wave_sum(ss) * (1.0f / DM) + NORM_EPS);
        f32x4* orow = (f32x4*)(OUT + (size_t)m * DM) + lane;
#pragma unroll
        for (int j = 0; j < 8; ++j) orow[64 * j] = v[j] * rstd * a[j];
    }
}
__device__ __forceinline__ void final_rows(float* X, const float* __restrict__ fw, int gw, int NGW, int lane) {
    f32x4 a[8];
#pragma unroll
    for (int j = 0; j < 8; ++j) a[j] = *(const f32x4*)(fw + 4 * lane + 256 * j);
    for (int m = gw; m < SEQ; m += NGW) {
        f32x4* xr = (f32x4*)(X + (size_t)m * DM) + lane; f32x4 v[8]; float ss = 0.f;
#pragma unroll
        for (int j = 0; j < 8; ++j) { v[j] = xr[64 * j]; ss += (v[j].x * v[j].x + v[j].y * v[j].y) + (v[j].z * v[j].z + v[j].w * v[j].w); }
        const float rstd = rsqrtf(wave_sum(ss) * (1.0f / DM) + NORM_EPS);
#pragma unroll
        for (int j = 0; j < 8; ++j) xr[64 * j] = v[j] * rstd * a[j];
    }
}
__device__ __forceinline__ void qknorm_rope(bf16_t* QAB, bf16_t* KVA, unsigned char* __restrict__ Q8, unsigned char* __restrict__ K8, const float* __restrict__ qn, const float* __restrict__ kn, const float* __restrict__ tab, int it0, int its, int ite, int lane) {
    const int li = lane & 15;
    for (int it = it0 + (lane >> 4); it < ite; it += its) {
        const int t = it / 10, hs = it - t * 10;
        bf16_t* p = (hs < 8 ? QAB + (size_t)t * PH + hs * 128 : KVA + (size_t)t * PKV + (hs - 8) * 128) + 8 * li;
        const float* wn = (hs < 8 ? qn : kn) + 8 * li;
        const v4u raw = *(const v4u*)p; float x[8];
#pragma unroll
        for (int e = 0; e < 4; ++e) { x[2 * e] = __uint_as_float(raw[e] << 16); x[2 * e + 1] = __uint_as_float(raw[e] & 0xffff0000u); }
        float ss = 0.f;
#pragma unroll
        for (int e = 0; e < 8; ++e) ss += x[e] * x[e];
        ss += __shfl_xor(ss, 1); ss += __shfl_xor(ss, 2); ss += __shfl_xor(ss, 4); ss += __shfl_xor(ss, 8);
        const float rstd = rsqrtf(ss * (1.0f / 128.0f) + NORM_EPS) * (hs < 8 ? 0.088388347648318440f * 1.4426950408889634f : 1.0f);
        const f32x4 w0 = *(const f32x4*)wn, w1 = *(const f32x4*)(wn + 4);
        const float wv[8] = {w0.x, w0.y, w0.z, w0.w, w1.x, w1.y, w1.z, w1.w};
        const int row = t >> 6, col = t & 63;
        const float* cs = tab + 2 * (li < 8 ? (row * 32 + 4 * li) : ((256 + col) * 32 + 4 * (li - 8)));
        const f32x4 c0 = *(const f32x4*)cs, c1 = *(const f32x4*)(cs + 4);
        const float cv[4] = {c0.x, c0.z, c1.x, c1.z}, sv[4] = {c0.y, c0.w, c1.y, c1.w};
        float r8[8];
#pragma unroll
        for (int e = 0; e < 4; ++e) { const float y0 = x[2 * e] * rstd * wv[2 * e], y1 = x[2 * e + 1] * rstd * wv[2 * e + 1];
            r8[2 * e] = y0 * cv[e] - y1 * sv[e]; r8[2 * e + 1] = y0 * sv[e] + y1 * cv[e]; }
        int pw0 = 0, pw1 = 0;
        pw0 = __builtin_amdgcn_cvt_pk_fp8_f32(r8[0], r8[1], pw0, false); pw0 = __builtin_amdgcn_cvt_pk_fp8_f32(r8[2], r8[3], pw0, true);
        pw1 = __builtin_amdgcn_cvt_pk_fp8_f32(r8[4], r8[5], pw1, false); pw1 = __builtin_amdgcn_cvt_pk_fp8_f32(r8[6], r8[7], pw1, true);
        unsigned char* d8 = (hs < 8 ? Q8 + (size_t)t * 1024 + hs * 128 : K8 + (size_t)t * 256 + (hs - 8) * 128) + 8 * li;
        v2u o8; o8.x = (unsigned)pw0; o8.y = (unsigned)pw1; *(v2u*)d8 = o8;
    }
}

#define XB_TMO      128
#define XB_XCNT(j)  (256  + 64 * (j))
#define XB_XSUB(j)  (1280 + 64 * (j))
#define XB_XGEN(j)  (2304 + 64 * (j))
#define XB_TOP      3328
#define XB_TOPGEN   3392
#define XCD_BAR_WORDS 3456
#define XB_SPIN_CAP (1u << 18)

__device__ __forceinline__ unsigned xb_ld(unsigned* p)              { return __hip_atomic_load(p, __ATOMIC_RELAXED, __HIP_MEMORY_SCOPE_AGENT); }
__device__ __forceinline__ unsigned xb_add(unsigned* p, unsigned v) { return __hip_atomic_fetch_add(p, v, __ATOMIC_RELAXED, __HIP_MEMORY_SCOPE_AGENT); }
__device__ __forceinline__ unsigned xb_xcc_id() { return (unsigned)__builtin_amdgcn_s_getreg((3 << 11) | 20) & 0xFu; }
#define XB_SPIN(cond, bar) do { unsigned _sp = 0; while (cond) { __builtin_amdgcn_s_sleep(1); \
    if ((++_sp & 255u) == 0u) { if (xb_ld(&(bar)[XB_TMO])) break; if (_sp > XB_SPIN_CAP) { atomicAdd(&(bar)[XB_TMO], 1u); break; } } } } while (0)

struct XcdBarrier {
    unsigned* bar; unsigned x;
    volatile LAS unsigned* st;
};

__device__ __forceinline__ XcdBarrier xcd_barrier_post(unsigned* bar, volatile LAS unsigned* st) {
    XcdBarrier b; b.bar = bar; b.x = xb_xcc_id(); b.st = st;
    if (threadIdx.x == 0) st[2] = xb_add(&bar[XB_XCNT(b.x)], 1u);
    return b;
}
__device__ __forceinline__ void xcd_barrier_complete(unsigned* bar, unsigned x, unsigned& nloc, unsigned& nx) {
    const unsigned G = gridDim.x * gridDim.y * gridDim.z;
    unsigned sum, cnt, mine, sp = 0u;
    for (;;) {
        sum = 0u; cnt = 0u; mine = 0u;
#pragma unroll
        for (unsigned j = 0; j < 16; ++j) { const unsigned c = xb_ld(&bar[XB_XCNT(j)]); sum += c; cnt += (c > 0u) ? 1u : 0u; mine = (j == x) ? c : mine; }
        if (sum == G) break;
        __builtin_amdgcn_s_sleep(1);
        if ((++sp & 255u) == 0u) { if (xb_ld(&bar[XB_TMO])) break; if (sp > XB_SPIN_CAP) { atomicAdd(&bar[XB_TMO], 1u); break; } }
    }
    nloc = mine > 0u ? mine : 1u; nx = cnt > 0u ? cnt : 1u;
}

__device__ __forceinline__ void xcd_barrier(const XcdBarrier& b, int tid_) {
    asm volatile("s_waitcnt vmcnt(0)" ::: "memory");
    __syncthreads();
    if (tid_ == 0) {
        unsigned* bar = b.bar;
        __builtin_amdgcn_s_waitcnt(0);
        unsigned nloc = b.st[0], nx = b.st[1];
        if (nloc == 0u) { xcd_barrier_complete(bar, b.x, nloc, nx); b.st[0] = nloc; b.st[1] = nx; }
        const unsigned old = xb_add(&bar[XB_XSUB(b.x)], 1u);
        const unsigned gen = old / nloc;
        if (old + 1u == (gen + 1u) * nloc) {
            __builtin_amdgcn_fence(__ATOMIC_RELEASE, "agent");
            asm volatile("s_waitcnt vmcnt(0)" ::: "memory");
            const unsigned og = xb_add(&bar[XB_TOP], 1u);
            const unsigned tg = og / nx;
            if (og + 1u == (tg + 1u) * nx) xb_add(&bar[XB_TOPGEN], 1u);
            else XB_SPIN(xb_ld(&bar[XB_TOPGEN]) == tg, bar);
            __builtin_amdgcn_fence(__ATOMIC_ACQUIRE, "agent");
            xb_add(&bar[XB_XGEN(b.x)], 1u);
            asm volatile("s_waitcnt vmcnt(0)" ::: "memory");
        } else {
            XB_SPIN(xb_ld(&bar[XB_XGEN(b.x)]) == gen, bar);
            __builtin_amdgcn_fence(__ATOMIC_ACQUIRE, "agent");
            asm volatile("s_waitcnt vmcnt(0)" ::: "memory");
        }
    }
    __syncthreads();
}
#define XB_LSUB(j) (3456 + 16 * (j))
#define XB_LGEN(j) (3712 + 16 * (j))
__device__ __forceinline__ void xcd_barrier_local(const XcdBarrier& b, int tid_) {
    asm volatile("s_waitcnt vmcnt(0)" ::: "memory");
    __syncthreads();
    if (tid_ == 0) {
        unsigned* bar = b.bar;
        __builtin_amdgcn_s_waitcnt(0);
        const unsigned nloc = b.st[0];
        const unsigned old = xb_add(&bar[XB_LSUB(b.x)], 1u);
        const unsigned gen = old / nloc;
        if (old + 1u == (gen + 1u) * nloc) xb_add(&bar[XB_LGEN(b.x)], 1u);
        else XB_SPIN(xb_ld(&bar[XB_LGEN(b.x)]) == gen, bar);
        __builtin_amdgcn_fence(__ATOMIC_ACQUIRE, "agent");
        asm volatile("s_waitcnt vmcnt(0)" ::: "memory");
    }
    __syncthreads();
}
__device__ __forceinline__ void v8t_item(const bf16_t* __restrict__ KVA, unsigned char* __restrict__ V8T, int item, LAS unsigned char* scr, int lane) {
    const int kvh = item >> 8, T = item & 255;
    const bf16_t* src = KVA + (size_t)(64 * T) * PKV + 256 + kvh * 128;
#pragma unroll 4
    for (int i = 0; i < 16; ++i) { const int key = 4 * i + (lane >> 4), c0 = 8 * (lane & 15);
        const v4u raw = *(const v4u*)(src + (size_t)key * PKV + c0);
        int w0 = 0, w1 = 0;
        w0 = __builtin_amdgcn_cvt_pk_fp8_f32(__uint_as_float(raw.x << 16), __uint_as_float(raw.x & 0xffff0000u), w0, false); w0 = __builtin_amdgcn_cvt_pk_fp8_f32(__uint_as_float(raw.y << 16), __uint_as_float(raw.y & 0xffff0000u), w0, true);
        w1 = __builtin_amdgcn_cvt_pk_fp8_f32(__uint_as_float(raw.z << 16), __uint_as_float(raw.z & 0xffff0000u), w1, false); w1 = __builtin_amdgcn_cvt_pk_fp8_f32(__uint_as_float(raw.w << 16), __uint_as_float(raw.w & 0xffff0000u), w1, true);
        const int kq = key & 31, pos = 32 * ((kq >> 2) & 1) + 16 * (key >> 5) + (kq & 3) + 4 * (kq >> 3);
        LAS unsigned char* d = scr + c0 * 68 + pos;
        d[0 * 68] = (unsigned char)(w0); d[1 * 68] = (unsigned char)(w0 >> 8); d[2 * 68] = (unsigned char)(w0 >> 16); d[3 * 68] = (unsigned char)(w0 >> 24);
        d[4 * 68] = (unsigned char)(w1); d[5 * 68] = (unsigned char)(w1 >> 8); d[6 * 68] = (unsigned char)(w1 >> 16); d[7 * 68] = (unsigned char)(w1 >> 24); }
    asm volatile("s_waitcnt lgkmcnt(0)" ::: "memory");
#pragma unroll
    for (int i = 0; i < 8; ++i) { const int idx = lane + 64 * i, col = idx >> 2, ch = idx & 3; const LAS unsigned* s4 = (const LAS unsigned*)(scr + col * 68 + ch * 16);
        v4u w; w.x = s4[0]; w.y = s4[1]; w.z = s4[2]; w.w = s4[3];
        *(v4u*)(V8T + (size_t)(kvh * 128 + col) * 16384 + 64 * T + ch * 16) = w; }
    asm volatile("s_waitcnt lgkmcnt(0)" ::: "memory");
}
struct Args { const float* in[17]; float* out; unsigned char* ws; int ph_lo, ph_hi; };
__global__ void __launch_bounds__(512) fwd(Args args) {
    extern __shared__ __attribute__((aligned(16))) unsigned char lds[];
    cg::grid_group grid = cg::this_grid();
    const int tid0 = threadIdx.x;
    const int G0 = gridDim.x, bx0 = blockIdx.x;
    const int lo = args.ph_lo, hi = args.ph_hi;
    const int wave0 = __builtin_amdgcn_readfirstlane(tid0 >> 6);
    if (hi > 1000) grid.sync();
    volatile LAS unsigned* bst = (volatile LAS unsigned*)((LAS unsigned char*)lds + LDS_MISC);
    if (tid0 < 4) bst[tid0] = tid0 == 3 ? 0xFFFFFFFFu : 0u;
    __syncthreads();
    const XcdBarrier bar = xcd_barrier_post((unsigned*)(args.ws + WS_BAR), bst);
#ifndef PHASE_MASK
#define PHASE_MASK 0x7ff
#endif
#define IN(k) (((PHASE_MASK >> (k)) & 1) && lo <= (k) && (k) < hi)
#define SEAM(k) do { if (IN(k) && IN((k) + 1)) { const int t_ = wave0 * 64 + (int)__builtin_amdgcn_mbcnt_hi(~0u, __builtin_amdgcn_mbcnt_lo(~0u, 0u)); xcd_barrier(bar, t_); } } while (0)
#define SEAML(k) do { if (IN(k) && IN((k) + 1)) { const int t_ = wave0 * 64 + (int)__builtin_amdgcn_mbcnt_hi(~0u, __builtin_amdgcn_mbcnt_lo(~0u, 0u)); if (bst[3] != 0xFFFFFFFFu) xcd_barrier_local(bar, t_); else xcd_barrier(bar, t_); } } while (0)
    typedef const __attribute__((address_space(4))) Args* ArgP;
#define ARGP() ({ ArgP p_ = (ArgP)__builtin_amdgcn_kernarg_segment_ptr(); asm volatile("" : "+s"(p_)); p_; })
#define WSP(off, T) ((T*)(A->ws + (off)))
#define OPQ() int G = G0, bx = bx0; asm volatile("" : "+s"(G), "+s"(bx)); int tid = wave0 * 64 + (int)__builtin_amdgcn_mbcnt_hi(~0u, __builtin_amdgcn_mbcnt_lo(~0u, 0u)); asm volatile("" : "+v"(tid)); const int lane = tid & 63, wave = __builtin_amdgcn_readfirstlane(tid >> 6), gw = bx * 8 + wave, NGW = G * 8; (void)gw; (void)NGW; (void)lane; const unsigned vm_ = bst[3]; const bool g8_ = (G & 7) == 0; const int vbx = (vm_ != 0xFFFFFFFFu) ? (int)__builtin_amdgcn_readfirstlane(vm_) : bx; const int cls = vbx & 7, rnk = vbx >> 3; (void)cls; (void)rnk; const int rw0 = g8_ ? cls * (SEQ / 8) + rnk * 8 + wave : gw, rws = g8_ ? G : NGW, rwe = g8_ ? (cls + 1) * (SEQ / 8) : SEQ; (void)rw0; (void)rws; (void)rwe

    if (IN(0)) { ArgP A = ARGP(); OPQ();
        const float* cvec = A->in[1]; const float* w_ada = A->in[2]; const float* b_ada = A->in[3]; const float* w_in = A->in[5]; const float* w_oa = A->in[9]; const float* w_ob = A->in[10];
        const float* w_out = A->in[11]; const float* w_g = A->in[13]; const float* w_u = A->in[14]; const float* w_d = A->in[15]; float* mod = WSP(WS_MOD, float); float* tab = WSP(WS_ROPE, float);
        bf16_t* WinT = WSP(WS_WIN, bf16_t); bf16_t* WoT = WSP(WS_WO, bf16_t); bf16_t* WoutT = WSP(WS_WOUT, bf16_t); bf16_t* WguT = WSP(WS_WGU, bf16_t); bf16_t* WdT = WSP(WS_WD, bf16_t);
        LAS float* scr = (LAS float*)((LAS unsigned char*)lds + wave * 16384);
        constexpr int I_GEMV = 32 * 48, I_IN = (DM / 64) * (DIN / 32), I_OA = (1024 / 64) * (DM / 32), I_OUT = (DM / 64) * (DM / 32), I_G = (DM / 64) * (DFF / 32), I_D = (DFF / 64) * (DM / 32);
        constexpr int NITEMS = I_GEMV + I_IN + 2 * I_OA + I_OUT + I_D;
        for (int it = gw; it < NITEMS; it += NGW) {
            int r = it;
            if (r < I_GEMV) { gemv_item(cvec, w_ada, b_ada, mod, r, lane); continue; } r -= I_GEMV;
            if (r < I_IN) { transpose_item(w_in, DIN, WinT, PH, 0, 0, scr, r, lane); continue; } r -= I_IN;
            if (r < I_OA) { transpose_item(w_oa, DM, WoT, PH, 0, 0, scr, r, lane); continue; } r -= I_OA;
            if (r < I_OA) { transpose_item(w_ob, DM, WoT, PH, 1024, 0, scr, r, lane); continue; } r -= I_OA;
            if (r < I_OUT) { transpose_item(w_out, DM, WoutT, PH, 0, 0, scr, r, lane); continue; } r -= I_OUT;
            transpose_item(w_d, DM, WdT, PA, 0, 0, scr, r, lane);
        }
        for (int e = bx * 512 + tid; e < 320 * 32; e += G * 512) { const int pos = e >> 5, j = e & 31; const float p = (float)(pos < 256 ? pos : pos - 256);
            const float inv = powf(10000.0f, -(float)(2 * j) / 64.0f); const float ang = p * inv; tab[2 * e] = cosf(ang); tab[2 * e + 1] = sinf(ang);
        }
    }
    SEAM(0);
    if (IN(0) && IN(1)) {
        const int t_ = wave0 * 64 + (int)__builtin_amdgcn_mbcnt_hi(~0u, __builtin_amdgcn_mbcnt_lo(~0u, 0u));
        if (t_ == 0) { unsigned nx_ = 0u, below_ = 0u, ok_ = ((G0 & 7) == 0) ? 1u : 0u; const unsigned per_ = (unsigned)G0 >> 3;
#pragma unroll
            for (unsigned j_ = 0; j_ < 16; ++j_) { const unsigned c_ = xb_ld(&bar.bar[XB_XCNT(j_)]); if (c_) { ++nx_; if (c_ != per_) ok_ = 0u; if (j_ < bar.x) ++below_; } }
            const unsigned rk_ = bst[2];
            bst[3] = (ok_ && nx_ == 8u && rk_ < per_) ? (rk_ * 8u + below_) : 0xFFFFFFFFu; }
        __syncthreads();
    }
    if (IN(1)) { ArgP A = ARGP(); OPQ(); float* mod = WSP(WS_MOD, float); normmod_rows(A->in[0], A->in[4], mod + 2048, mod + 0, WSP(WS_H, bf16_t), rw0, rws, rwe, lane); }
    SEAML(1);
    if (IN(2)) { ArgP A = ARGP(); OPQ();
        pg8::Gemm g{WSP(WS_H, bf16_t), WSP(WS_WIN, bf16_t), SEQ, DIN, DM, PH}; pg8::StaticOrder S; S.init(SEQ, DIN, G, vbx);
        pg8::EpiProj E{WSP(WS_QAB, bf16_t), WSP(WS_KVA, bf16_t), WSP(WS_KB, bf16_t), WSP(WS_VB, bf16_t), WSP(WS_GA, bf16_t), WSP(WS_GB, bf16_t)};
        pg8::gemm_phase<pg8::EpiProj, pg8::StaticOrder, GEMM_ALIGN, GEMM_SP2, false>((LAS unsigned char*)lds, g, S, E, tid);
        {
            const int first = S.nwg % G;
            if (vbx >= first) {
                constexpr int I_G2 = (DM / 64) * (DFF / 32);
                LAS float* scr = (LAS float*)((LAS unsigned char*)lds + wave * 16384);
                const float* w_g = A->in[13]; const float* w_u = A->in[14]; bf16_t* WguT = WSP(WS_WGU, bf16_t);
                for (int it = (vbx - first) * 8 + wave; it < 2 * I_G2; it += (G - first) * 8) {
                    if (it < I_G2) transpose_item(w_g, DFF, WguT, PH, 0, 1, scr, it, lane); else transpose_item(w_u, DFF, WguT, PH, 0, 2, scr, it - I_G2, lane);
                }
            }
        }
    }
    SEAM(2);
    if (IN(3)) { ArgP A = ARGP(); OPQ();
        if ((wave & 3) == 0) { LAS unsigned char* scr = (LAS unsigned char*)lds + wave * 16384; if (g8_) { for (int tt = rnk; tt < 32; tt += (G >> 3)) v8t_item(WSP(WS_KVA, bf16_t), WSP(WS_V8T, unsigned char), (wave >> 2) * 256 + cls * 32 + tt, scr, lane); }
            else for (int it = bx * 2 + (wave >> 2); it < 512; it += G * 2) v8t_item(WSP(WS_KVA, bf16_t), WSP(WS_V8T, unsigned char), it, scr, lane); }
        qknorm_rope(WSP(WS_QAB, bf16_t), WSP(WS_KVA, bf16_t), WSP(WS_Q8, unsigned char), WSP(WS_K8, unsigned char), A->in[6], A->in[7], WSP(WS_ROPE, float), g8_ ? cls * (SEQ / 8) * 10 + (rnk * 8 + wave) * 4 : gw * 4, g8_ ? G * 4 : NGW * 4, g8_ ? (cls + 1) * (SEQ / 8) * 10 : SEQ * 10, lane); }
    SEAM(3);
    if (IN(4)) { ArgP A = ARGP(); OPQ();
        using abf = att::bf16; bf16_t* QAB = WSP(WS_QAB, bf16_t); bf16_t* KVA = WSP(WS_KVA, bf16_t); bf16_t* KB = WSP(WS_KB, bf16_t); bf16_t* VB = WSP(WS_VB, bf16_t); const float* rpb = A->in[8];
        for (int u = bx; u < 512; u += G) { const int h = u >> 6, qb = u & 63, kvh = h >> 2;
            att::attn_unit_g8<1024, 256, 16384, PH>(WSP(WS_Q8, unsigned char) + (size_t)qb * 256 * 1024 + h * 128, WSP(WS_K8, unsigned char) + kvh * 128, WSP(WS_V8T, unsigned char) + (size_t)kvh * 128 * 16384,
                                                    (abf*)QAB + (size_t)qb * 256 * PH + h * 128, SEQ / 64, (char*)lds, A->in[6], A->in[7], tid);
        }
        for (int v = bx; v < 512; v += G) { const int h = v >> 6, qb = v & 63; int r_lo = 4 * qb - 4; r_lo = r_lo < 0 ? 0 : (r_lo > 244 ? 244 : r_lo);
            att::attn_unit<PH, PNB, PH, true, 1, 0>((const abf*)QAB + (size_t)qb * 256 * PH + 1024 + h * 128, (const abf*)KB + (size_t)r_lo * 64 * PNB + h * 128, (const abf*)VB + (size_t)r_lo * 64 * PNB + h * 128,
                                                   (abf*)QAB + (size_t)qb * 256 * PH + 1024 + h * 128, 12, (char*)lds, rpb + h * 15 * 31, nullptr, 4 * qb, r_lo, tid);
        }
        __syncthreads();
    }
    SEAM(4);
    if (IN(5)) { ArgP A = ARGP(); OPQ();
        pg8::Gemm g{WSP(WS_QAB, bf16_t), WSP(WS_WO, bf16_t), SEQ, DM, DM, PH}; pg8::StaticOrder S; S.init(SEQ, DM, G, vbx);
        pg8::EpiMerged E{WSP(WS_GA, bf16_t), WSP(WS_GB, bf16_t), WSP(WS_H, bf16_t)};
        pg8::gemm_phase<pg8::EpiMerged, pg8::StaticOrder, GEMM_ALIGN, GEMM_SP2, true>((LAS unsigned char*)lds, g, S, E, tid);
    }
    SEAML(5);
    if (IN(6)) { ArgP A = ARGP(); OPQ();
        pg8::Gemm g{WSP(WS_H, bf16_t), WSP(WS_WOUT, bf16_t), SEQ, DM, DM, PH}; pg8::StaticOrder S; S.init(SEQ, DM, G, vbx);
        pg8::EpiDelta E{WSP(WS_GB, bf16_t), WSP(WS_MOD, float) + 4096};
        pg8::gemm_phase<pg8::EpiDelta, pg8::StaticOrder, GEMM_ALIGN, GEMM_SP2, false>((LAS unsigned char*)lds, g, S, E, tid);
    }
    SEAML(6);
    if (IN(7)) { ArgP A = ARGP(); OPQ(); float* mod = WSP(WS_MOD, float); normmod_rows_d(A->in[0], WSP(WS_GB, bf16_t), A->in[12], mod + 8192, mod + 6144, WSP(WS_H, bf16_t), rw0, rws, rwe, lane); }
    SEAM(7);
    if (IN(8)) { ArgP A = ARGP(); OPQ();
        pg8::Gemm g{WSP(WS_H, bf16_t), WSP(WS_WGU, bf16_t), SEQ, 2 * DFF, DM, PH}; pg8::StaticOrder S; S.init(SEQ, 2 * DFF, G, vbx);
        pg8::EpiSwiglu E{WSP(WS_ACT, bf16_t)};
        pg8::gemm_phase<pg8::EpiSwiglu, pg8::StaticOrder, GEMM_ALIGN, GEMM_SP2, false>((LAS unsigned char*)lds, g, S, E, tid);
    }
    SEAML(8);
    if (IN(9)) { ArgP A = ARGP(); OPQ();
        pg8::Gemm g{WSP(WS_ACT, bf16_t), WSP(WS_WD, bf16_t), SEQ, DM, DFF, PA}; pg8::StaticOrder S; S.init(SEQ, DM, G, vbx);
        pg8::EpiDelta E{WSP(WS_H, bf16_t), WSP(WS_MOD, float) + 10240};
        pg8::gemm_phase<pg8::EpiDelta, pg8::StaticOrder, GEMM_ALIGN, GEMM_SP2, false>((LAS unsigned char*)lds, g, S, E, tid);
    }
    SEAML(9);
    if (IN(10)) { ArgP A = ARGP(); OPQ(); final_rows_d(A->in[0], WSP(WS_GB, bf16_t), WSP(WS_H, bf16_t), A->out, A->in[16], rw0, rws, rwe, lane); }
#undef IN
#undef SEAM
}

#ifndef N_LAUNCHES
#define N_LAUNCHES 1
#endif
extern "C" void kernel_launch(void* const* d_in, const int* in_sizes, int n_in, void* d_out, int out_size, void* d_ws, size_t ws_size, hipStream_t stream) {
    static int grid = 0;
    if (grid == 0) {
        if (n_in != 17 || in_sizes[0] != SEQ * DM || out_size != SEQ * DM || ws_size < WS_END) { fprintf(stderr, "kernel_launch: unexpected shapes: n_in %d in0 %d out %d ws %zu (need %zu)\n", n_in, n_in > 0 ? in_sizes[0] : -1, out_size, ws_size, (size_t)WS_END); grid = -1; return; }
        int dev = 0, cus = 0, per_cu = 0;
        if (hipGetDevice(&dev) != hipSuccess || hipDeviceGetAttribute(&cus, hipDeviceAttributeMultiprocessorCount, dev) != hipSuccess) { fprintf(stderr, "kernel_launch: device query failed\n"); grid = -1; return; }
        if (hipFuncSetAttribute((const void*)fwd, hipFuncAttributeMaxDynamicSharedMemorySize, LDS_BYTES) != hipSuccess) { fprintf(stderr, "kernel_launch: hipFuncSetAttribute failed\n"); grid = -1; return; }
        if (hipOccupancyMaxActiveBlocksPerMultiprocessor(&per_cu, (const void*)fwd, 512, LDS_BYTES) != hipSuccess || per_cu < 1) { fprintf(stderr, "kernel_launch: occupancy query says %d\n", per_cu); per_cu = 1; }
        (void)hipGetLastError();
        grid = cus * per_cu;
        fprintf(stderr, "kernel_launch: grid %d (cus %d x %d)\n", grid, cus, per_cu);
    }
    if (grid < 0) return;
    if (hipMemsetAsync((char*)d_ws + WS_MOD, 0, CTL_ZERO_BYTES, stream) != hipSuccess) { fprintf(stderr, "kernel_launch: memset failed\n"); return; }
    Args a{};
    for (int i = 0; i < 17; ++i) a.in[i] = (const float*)d_in[i];
    a.out = (float*)d_out; a.ws = (unsigned char*)d_ws;
    if (N_LAUNCHES == 1) {
        a.ph_lo = 0; a.ph_hi = NPHASE;
        void* kargs[] = {&a};
        const hipError_t e = hipLaunchCooperativeKernel((const void*)fwd, dim3(grid), dim3(512), kargs, LDS_BYTES, stream);
        if (e != hipSuccess) fprintf(stderr, "kernel_launch: cooperative launch failed: %s (grid %d)\n", hipGetErrorString(e), grid);
    } else {
        for (int p = 0; p < NPHASE; ++p) { a.ph_lo = p; a.ph_hi = p + 1;
            hipLaunchKernelGGL(fwd, dim3(grid), dim3(512), LDS_BYTES, stream, a);
            const hipError_t le = hipPeekAtLastError();
            if (le != hipSuccess) { fprintf(stderr, "kernel_launch: launch %d failed: %s\n", p, hipGetErrorName(le)); break; } }
    }
}
```

```cpp
#include <hip/hip_runtime.h>
#include <hip/hip_bf16.h>
#include <hip/hip_cooperative_groups.h>
#include <cstdio>
#include <cstdint>
#include <cmath>
#define N_LAUNCHES 1
namespace pg8 {
#define PG8_LAS __attribute__((address_space(3)))
typedef unsigned short bf16_t;
typedef short bf16x8 __attribute__((ext_vector_type(8)));
typedef float f32x4 __attribute__((ext_vector_type(4)));
typedef unsigned u32x4 __attribute__((ext_vector_type(4)));
constexpr int BM = 256, BK = 64, HALF = 128, HTB = HALF * BK * 2  , STAGE_BYTES = 8 * HTB, NXCD = 8, WGM = 4;

__host__ __device__ __forceinline__ int lds_byte(int r, int c) { const int st = (r >> 4) * 2 + (c >> 5), rr = r & 15, cc = c & 31, ob = rr * 64 + cc * 2; return st * 1024 + (ob ^ (((ob >> 9) & 1) << 5)); }
__host__ __device__ __forceinline__ void stage_rc(int b, int& R, int& C) { const int st = b / 1024, sb = b % 1024, swz = sb ^ (((sb >> 9) & 1) << 5); R = (st >> 1) * 16 + swz / 64; C = (st & 1) * 32 + (swz % 64) / 2; }
__host__ __device__ __forceinline__ int perm32(int rho) { const int n = rho >> 4, i = rho & 15; return 8 * (i >> 2) + 4 * n + (i & 3); }

struct Unit { int pm, pn; };
struct Gemm { const bf16_t* A; const bf16_t* Bt; int M, N, K, ld; };

struct StaticOrder {
    int nM, nN, nwg, G, c;
    __host__ __device__ void init(int M, int N, int G_, int c_) { nM = M / BM; nN = N / BM; nwg = nM * nN; G = G_; c = c_; }
    __host__ __device__ bool next(int i, Unit& u) const {
        const long L = (long)i * G + c; if (L >= nwg) return false;
        int wgid = (int)L; { const int q = nwg / NXCD, r = nwg % NXCD, xcd = wgid % NXCD, off = wgid / NXCD; wgid = (xcd < r ? xcd * (q + 1) : r * (q + 1) + (xcd - r) * q) + off; }
        const int nig = WGM * nN, gid = wgid / nig, fm = gid * WGM, gsz = (nM - fm) < WGM ? (nM - fm) : WGM;
        u.pm = fm + ((wgid % nig) % gsz); u.pn = (wgid % nig) / gsz; return true;
    }
    __device__ __forceinline__ void a_ready(const Unit&) const {}
    __device__ __forceinline__ void done(const Unit&) const {}
};

__device__ __forceinline__ unsigned cvt_pk_bf16(float lo, float hi) { unsigned r; asm volatile("v_cvt_pk_bf16_f32 %0, %1, %2" : "=v"(r) : "v"(lo), "v"(hi)); return r; }
constexpr int PH = 2176  , PA = 5760  , PKV = 640  , PNB = 1152  ;
__device__ __forceinline__ float bflo(unsigned w) { return __uint_as_float(w << 16); }
__device__ __forceinline__ float bfhi(unsigned w) { return __uint_as_float(w & 0xffff0000u); }
struct EpiProj {
    static constexpr bool PERM = true, AFTER_DRAIN = false;
    bf16_t *QAB, *KVA, *KB, *VB, *GA, *GB;
    __device__ __forceinline__ void operator()(const f32x4 (&acc)[2][2][4][2], const Unit& u, int wr, int wc, int fr, int fq) const {
        const int pn = u.pn; bf16_t* base; int ldc, colt;
        if (pn < 4) { base = QAB; ldc = PH; colt = pn * 256; }
        else if (pn < 6) { base = KVA; ldc = PKV; colt = (pn - 4) * 256; }
        else if (pn < 10) { base = QAB; ldc = PH; colt = 1024 + (pn - 6) * 256; }
        else if (pn < 14) { base = KB; ldc = PNB; colt = (pn - 10) * 256; }
        else if (pn < 18) { base = VB; ldc = PNB; colt = (pn - 14) * 256; }
        else if (pn < 26) { base = GA; ldc = PH; colt = (pn - 18) * 256; }
        else { base = GB; ldc = PH; colt = (pn - 26) * 256; }
        const int row0 = u.pm * BM + wr * 64 + fr, col0 = colt + wc * 32 + 8 * fq;
#pragma unroll
        for (int ai = 0; ai < 2; ++ai)
#pragma unroll
            for (int m = 0; m < 4; ++m) { bf16_t* rowp = base + (size_t)(row0 + ai * HALF + m * 16) * ldc + col0;
#pragma unroll
                for (int bj = 0; bj < 2; ++bj) { const f32x4 v0 = acc[ai][bj][m][0], v1 = acc[ai][bj][m][1];
                    u32x4 w; w.x = cvt_pk_bf16(v0[0], v0[1]); w.y = cvt_pk_bf16(v0[2], v0[3]); w.z = cvt_pk_bf16(v1[0], v1[1]); w.w = cvt_pk_bf16(v1[2], v1[3]);
                    *(u32x4*)(rowp + bj * HALF) = w; } }
    }
};
struct EpiMerged {
    static constexpr bool PERM = true, AFTER_DRAIN = false;
    const bf16_t *GA, *GB; bf16_t* O;
    __device__ __forceinline__ void mid(f32x4 (&acc)[2][2][4][2], const Unit& u, int wr, int wc, int fr, int fq) const {
        int row0 = u.pm * BM + wr * 64 + fr; const int col0 = u.pn * BM + wc * 32 + 8 * fq;
        asm volatile("" : "+v"(row0));
#pragma unroll
        for (int ai = 0; ai < 2; ++ai)
#pragma unroll
            for (int m = 0; m < 4; ++m)
#pragma unroll
                for (int bj = 0; bj < 2; ++bj) { const size_t off = (size_t)(row0 + ai * HALF + m * 16) * PH + col0 + bj * HALF;
                    const u32x4 a = *(const u32x4*)(GA + off), b = *(const u32x4*)(GB + off);
#pragma unroll
                    for (int e = 0; e < 4; ++e) { const float ga0 = bflo(a[e]), ga1 = bfhi(a[e]), gb0 = bflo(b[e]), gb1 = bfhi(b[e]);
                        const float r0 = (1.f + __expf(-gb0)) * __builtin_amdgcn_rcpf(1.f + __expf(-ga0)), r1 = (1.f + __expf(-gb1)) * __builtin_amdgcn_rcpf(1.f + __expf(-ga1));
                        acc[ai][bj][m][e >> 1][(e & 1) * 2] *= r0; acc[ai][bj][m][e >> 1][(e & 1) * 2 + 1] *= r1; }
                    if (bj == 1 && (m & 1)) asm volatile("" ::: "memory"); }
    }
    __device__ __forceinline__ void operator()(const f32x4 (&acc)[2][2][4][2], const Unit& u, int wr, int wc, int fr, int fq) const {
        const int row0 = u.pm * BM + wr * 64 + fr, col0 = u.pn * BM + wc * 32 + 8 * fq;
#pragma unroll
        for (int ai = 0; ai < 2; ++ai)
#pragma unroll
            for (int m = 0; m < 4; ++m)
#pragma unroll
                for (int bj = 0; bj < 2; ++bj) { const size_t off = (size_t)(row0 + ai * HALF + m * 16) * PH + col0 + bj * HALF;
                    const u32x4 b = *(const u32x4*)(GB + off); float o[8];
#pragma unroll
                    for (int e = 0; e < 4; ++e) { const float gb0 = bflo(b[e]), gb1 = bfhi(b[e]);
                        o[2 * e] = acc[ai][bj][m][e >> 1][(e & 1) * 2] * __builtin_amdgcn_rcpf(1.f + __expf(-gb0)); o[2 * e + 1] = acc[ai][bj][m][e >> 1][(e & 1) * 2 + 1] * __builtin_amdgcn_rcpf(1.f + __expf(-gb1)); }
                    u32x4 w; w.x = cvt_pk_bf16(o[0], o[1]); w.y = cvt_pk_bf16(o[2], o[3]); w.z = cvt_pk_bf16(o[4], o[5]); w.w = cvt_pk_bf16(o[6], o[7]);
                    *(u32x4*)(O + off) = w; }
    }
};
struct EpiResid {
    static constexpr bool PERM = false, AFTER_DRAIN = false;
    const float* base; float* out; const float* g;
    __device__ __forceinline__ void operator()(const f32x4 (&acc)[2][2][4][2], const Unit& u, int wr, int wc, int fr, int fq) const {
        const int row0 = u.pm * BM + wr * 64 + fr, col0 = u.pn * BM + wc * 32 + 4 * fq;
        f32x4 gv[2][2];
#pragma unroll
        for (int bj = 0; bj < 2; ++bj)
#pragma unroll
            for (int n = 0; n < 2; ++n) gv[bj][n] = *(const f32x4*)(g + col0 + bj * HALF + n * 16);
#pragma unroll
        for (int ai = 0; ai < 2; ++ai)
#pragma unroll
            for (int m = 0; m < 4; ++m) { const size_t off = (size_t)(row0 + ai * HALF + m * 16) * 2048 + col0;
#pragma unroll
                for (int bj = 0; bj < 2; ++bj)
#pragma unroll
                    for (int n = 0; n < 2; ++n) { const f32x4 bs = *(const f32x4*)(base + off + bj * HALF + n * 16);
                        *(f32x4*)(out + off + bj * HALF + n * 16) = bs + gv[bj][n] * acc[ai][bj][m][n]; } }
    }
};
struct EpiSwiglu {
    static constexpr bool PERM = true, AFTER_DRAIN = false;
    bf16_t* O;
    __device__ __forceinline__ void operator()(const f32x4 (&acc)[2][2][4][2], const Unit& u, int wr, int wc, int fr, int fq) const {
        const int row0 = u.pm * BM + wr * 64 + fr, col0 = u.pn * HALF + wc * 32 + 8 * fq;
#pragma unroll
        for (int ai = 0; ai < 2; ++ai)
#pragma unroll
            for (int m = 0; m < 4; ++m) { float o[8];
#pragma unroll
                for (int n = 0; n < 2; ++n)
#pragma unroll
                    for (int e = 0; e < 4; ++e) { const float gt = acc[ai][0][m][n][e], up = acc[ai][1][m][n][e]; o[4 * n + e] = gt * up * __builtin_amdgcn_rcpf(1.f + __expf(-gt)); }
                u32x4 w; w.x = cvt_pk_bf16(o[0], o[1]); w.y = cvt_pk_bf16(o[2], o[3]); w.z = cvt_pk_bf16(o[4], o[5]); w.w = cvt_pk_bf16(o[6], o[7]);
                *(u32x4*)(O + (size_t)(row0 + ai * HALF + m * 16) * PA + col0) = w; }
    }
};

struct EpiNull {
    static constexpr bool PERM = false, AFTER_DRAIN = false;
    float* out;
    __device__ __forceinline__ void operator()(const f32x4 (&acc)[2][2][4][2], const Unit& u, int wr, int wc, int fr, int fq) const {
        f32x4 s = {0.f, 0.f, 0.f, 0.f};
#pragma unroll
        for (int ai = 0; ai < 2; ++ai)
#pragma unroll
            for (int bj = 0; bj < 2; ++bj)
#pragma unroll
                for (int m = 0; m < 4; ++m)
#pragma unroll
                    for (int n = 0; n < 2; ++n) s += acc[ai][bj][m][n];
        if (s[0] + s[1] + s[2] + s[3] == 123456.789f) out[u.pm] = 1.f;
    }
};

struct EpiDelta {
    static constexpr bool PERM = true, AFTER_DRAIN = false;
    bf16_t* O; const float* g;
    __device__ __forceinline__ void operator()(const f32x4 (&acc)[2][2][4][2], const Unit& u, int wr, int wc, int fr, int fq) const {
        const int row0 = u.pm * BM + wr * 64 + fr, col0 = u.pn * BM + wc * 32 + 8 * fq;
        f32x4 gv[2][2];
#pragma unroll
        for (int bj = 0; bj < 2; ++bj)
#pragma unroll
            for (int n = 0; n < 2; ++n) gv[bj][n] = *(const f32x4*)(g + col0 + bj * HALF + 4 * n);
#pragma unroll
        for (int ai = 0; ai < 2; ++ai)
#pragma unroll
            for (int m = 0; m < 4; ++m) { bf16_t* rowp = O + (size_t)(row0 + ai * HALF + m * 16) * PH + col0;
#pragma unroll
                for (int bj = 0; bj < 2; ++bj) { const f32x4 v0 = acc[ai][bj][m][0] * gv[bj][0], v1 = acc[ai][bj][m][1] * gv[bj][1];
                    u32x4 w; w.x = cvt_pk_bf16(v0[0], v0[1]); w.y = cvt_pk_bf16(v0[2], v0[3]); w.z = cvt_pk_bf16(v1[0], v1[1]); w.w = cvt_pk_bf16(v1[2], v1[3]);
                    *(u32x4*)(rowp + bj * HALF) = w; } }
    }
};
template <class Epi, class Sched, bool ALIGN_EPI = false, bool SP2 = false, bool MID = false>
__device__ __forceinline__ void gemm_phase(PG8_LAS unsigned char* lds, const Gemm g, const Sched& S, const Epi& E, int tid_in) {
    int tid_ = tid_in; asm volatile("" : "+v"(tid_));
    const int tid = tid_, wid = __builtin_amdgcn_readfirstlane(tid >> 6), lane = tid & 63, wr = wid >> 2, wc = wid & 3, fr = lane & 15, fq = lane >> 4;
    const int K = g.K, nt = K / BK, LD = g.ld;
    unsigned voffA[2], voffB[2];
#pragma unroll
    for (int i = 0; i < 2; ++i) { int R, C; stage_rc(tid * 16 + i * 8192, R, C); const int Rb = Epi::PERM ? ((R & ~31) + perm32(R & 31)) : R;
        voffA[i] = (unsigned)(R * LD + C) * 2u; voffB[i] = (unsigned)(Rb * LD + C) * 2u; }
    const size_t kstep = (size_t)(BK * 2);
    const size_t hstep = (size_t)HALF * LD * 2;
    const size_t tstep = 2 * hstep;
    const unsigned ldsw = (unsigned)wid * 1024u;
    const int aoff = lds_byte(wr * 64 + fr, fq * 8), boff = lds_byte(wc * 32 + fr, fq * 8);
#define PG8_SA(b, h) (((b) * 2 + (h)) * HTB)
#define PG8_SB(b, h) ((4 + (b) * 2 + (h)) * HTB)
#define PG8_STAGE(bufoff, gbase, voff) do { _Pragma("unroll") for (int _i = 0; _i < 2; ++_i) \
        __builtin_amdgcn_global_load_lds((const unsigned*)((const char*)(gbase) + (voff)[_i]), (PG8_LAS unsigned*)(lds + (bufoff) + ldsw + _i * 8192), 16, 0, 0); } while (0)
#define PG8_LDA(dst, b, h) do { _Pragma("unroll") for (int m = 0; m < 4; ++m) _Pragma("unroll") for (int k = 0; k < 2; ++k) dst[m][k] = *(const PG8_LAS bf16x8*)(lds + PG8_SA(b, h) + aoff + m * 2048 + k * 1024); } while (0)
#define PG8_LDB(dst, b, h) do { _Pragma("unroll") for (int n = 0; n < 2; ++n) _Pragma("unroll") for (int k = 0; k < 2; ++k) dst[n][k] = *(const PG8_LAS bf16x8*)(lds + PG8_SB(b, h) + boff + n * 2048 + k * 1024); } while (0)
#define PG8_MMA(ai, bj, At, Bt) do { __builtin_amdgcn_s_setprio(1); _Pragma("unroll") for (int m = 0; m < 4; ++m) _Pragma("unroll") for (int n = 0; n < 2; ++n) _Pragma("unroll") for (int k = 0; k < 2; ++k) \
        acc[ai][bj][m][n] = __builtin_amdgcn_mfma_f32_16x16x32_bf16(Bt[n][k], At[m][k], acc[ai][bj][m][n], 0, 0, 0); __builtin_amdgcn_s_setprio(0); } while (0)
#define PG8_WAIT_V(n) asm volatile("s_waitcnt vmcnt(" #n ")" ::: "memory")
#define PG8_WAIT_L(n) asm volatile("s_waitcnt lgkmcnt(" #n ")" ::: "memory")
#define PG8_BAR __builtin_amdgcn_s_barrier()
#define PG8_SCHED __builtin_amdgcn_sched_barrier(0)
    Unit cur, nxt; int ui = 0;
    if (!S.next(0, cur)) return;
    f32x4 acc[2][2][4][2];
#pragma unroll
    for (int a = 0; a < 2; ++a)
#pragma unroll
        for (int b = 0; b < 2; ++b)
#pragma unroll
            for (int m = 0; m < 4; ++m)
#pragma unroll
                for (int n = 0; n < 2; ++n) acc[a][b][m][n] = (f32x4){0.f, 0.f, 0.f, 0.f};
    bf16x8 At[4][2], B0[2][2], B1[2][2];
    const char* cA = (const char*)g.A + (size_t)cur.pm * tstep; const char* cB = (const char*)g.Bt + (size_t)cur.pn * tstep;
    S.a_ready(cur);
    if constexpr (SP2) {
        PG8_STAGE(PG8_SB(0, 0), cB, voffB); PG8_STAGE(PG8_SB(0, 1), cB + hstep, voffB); PG8_STAGE(PG8_SA(0, 0), cA, voffA); PG8_STAGE(PG8_SA(0, 1), cA + hstep, voffA);
        if (wr == 1) PG8_BAR;
        PG8_WAIT_V(2); PG8_BAR;
        PG8_STAGE(PG8_SB(1, 0), cB + kstep, voffB); PG8_STAGE(PG8_SA(1, 0), cA + kstep, voffA); PG8_STAGE(PG8_SB(1, 1), cB + hstep + kstep, voffB);
        PG8_WAIT_V(6); PG8_BAR;
    } else {
        PG8_STAGE(PG8_SB(0, 0), cB, voffB); PG8_STAGE(PG8_SA(0, 0), cA, voffA); PG8_STAGE(PG8_SB(0, 1), cB + hstep, voffB); PG8_STAGE(PG8_SA(0, 1), cA + hstep, voffA);
        if (wr == 1) PG8_BAR;
        PG8_WAIT_V(4); PG8_BAR;
        PG8_STAGE(PG8_SB(1, 0), cB + kstep, voffB); PG8_STAGE(PG8_SA(1, 0), cA + kstep, voffA); PG8_STAGE(PG8_SB(1, 1), cB + hstep + kstep, voffB);
        PG8_WAIT_V(6); PG8_BAR;
    }
    for (;;) {
        const bool has_next = S.next(ui + 1, nxt);
        const char* nA = has_next ? (const char*)g.A + (size_t)nxt.pm * tstep : cA; const char* nB = has_next ? (const char*)g.Bt + (size_t)nxt.pn * tstep : cB;
        for (int t = 0; t < nt; t += 2) {
            if constexpr (MID) { if (t == (nt >> 1)) E.mid(acc, cur, wr, wc, fr, fq); }
            const bool last = (t == nt - 2);
            const char* a1 = cA + (size_t)(t + 1) * kstep;
            const char* a2 = last ? nA : cA + (size_t)(t + 2) * kstep; const char* b2 = last ? nB : cB + (size_t)(t + 2) * kstep;
            const char* a3 = a2 + kstep; const char* b3 = b2 + kstep;
            if (last && has_next) S.a_ready(nxt);
            if constexpr (SP2) {
            PG8_LDB(B0, 0, 0); PG8_LDB(B1, 0, 1); PG8_SCHED; PG8_LDA(At, 0, 0); PG8_STAGE(PG8_SA(1, 1), a1 + hstep, voffA);
            PG8_WAIT_V(8); PG8_WAIT_L(0); PG8_BAR; PG8_MMA(0, 0, At, B0); PG8_MMA(0, 1, At, B1); PG8_BAR; PG8_SCHED;
            PG8_LDA(At, 0, 1); PG8_STAGE(PG8_SB(0, 0), b2, voffB); PG8_STAGE(PG8_SB(0, 1), b2 + hstep, voffB); PG8_STAGE(PG8_SA(0, 0), a2, voffA);
            PG8_WAIT_V(8); PG8_WAIT_L(0); PG8_BAR; PG8_MMA(1, 0, At, B0); PG8_MMA(1, 1, At, B1); PG8_BAR; PG8_SCHED;
            PG8_LDB(B0, 1, 0); PG8_LDB(B1, 1, 1); PG8_SCHED; PG8_LDA(At, 1, 0); PG8_STAGE(PG8_SA(0, 1), a2 + hstep, voffA);
            PG8_WAIT_V(8); PG8_WAIT_L(0); PG8_BAR; PG8_MMA(0, 0, At, B0); PG8_MMA(0, 1, At, B1); PG8_BAR; PG8_SCHED;
            PG8_LDA(At, 1, 1); PG8_STAGE(PG8_SB(1, 0), b3, voffB); PG8_STAGE(PG8_SB(1, 1), b3 + hstep, voffB); PG8_STAGE(PG8_SA(1, 0), a3, voffA);
            PG8_WAIT_V(8); PG8_WAIT_L(0); PG8_BAR; PG8_MMA(1, 0, At, B0); PG8_MMA(1, 1, At, B1); PG8_BAR; PG8_SCHED;
            } else {
            PG8_LDB(B0, 0, 0); PG8_SCHED; PG8_LDA(At, 0, 0); PG8_STAGE(PG8_SA(1, 1), a1 + hstep, voffA);
            PG8_WAIT_L(8); PG8_BAR; PG8_WAIT_L(0); PG8_MMA(0, 0, At, B0); PG8_BAR; PG8_SCHED;
            PG8_LDB(B1, 0, 1); PG8_STAGE(PG8_SB(0, 0), b2, voffB);
            PG8_BAR; PG8_WAIT_L(0); PG8_MMA(0, 1, At, B1); PG8_BAR;
            PG8_LDA(At, 0, 1); PG8_STAGE(PG8_SA(0, 0), a2, voffA);
            PG8_BAR; PG8_WAIT_L(0); PG8_MMA(1, 0, At, B0); PG8_BAR; PG8_SCHED;
            PG8_STAGE(PG8_SB(0, 1), b2 + hstep, voffB);
            PG8_WAIT_V(6); PG8_BAR; PG8_MMA(1, 1, At, B1); PG8_BAR;
            PG8_LDB(B0, 1, 0); PG8_SCHED; PG8_LDA(At, 1, 0); PG8_STAGE(PG8_SA(0, 1), a2 + hstep, voffA);
            PG8_WAIT_L(8); PG8_BAR; PG8_WAIT_L(0); PG8_MMA(0, 0, At, B0); PG8_BAR; PG8_SCHED;
            PG8_LDB(B1, 1, 1); PG8_STAGE(PG8_SB(1, 0), b3, voffB);
            PG8_BAR; PG8_WAIT_L(0); PG8_MMA(0, 1, At, B1); PG8_BAR;
            PG8_LDA(At, 1, 1); PG8_STAGE(PG8_SA(1, 0), a3, voffA);
            PG8_BAR; PG8_WAIT_L(0); PG8_MMA(1, 0, At, B0); PG8_BAR; PG8_SCHED;
            PG8_STAGE(PG8_SB(1, 1), b3 + hstep, voffB);
            PG8_WAIT_V(6); PG8_BAR; PG8_MMA(1, 1, At, B1); PG8_BAR;
            }
        }
        if constexpr (ALIGN_EPI) { if (wr == 0) PG8_BAR; }
        if constexpr (!Epi::AFTER_DRAIN) { E(acc, cur, wr, wc, fr, fq); S.done(cur); }
        if (!has_next) break;
#pragma unroll
        for (int a = 0; a < 2; ++a)
#pragma unroll
            for (int b = 0; b < 2; ++b)
#pragma unroll
                for (int m = 0; m < 4; ++m)
#pragma unroll
                    for (int n = 0; n < 2; ++n) acc[a][b][m][n] = (f32x4){0.f, 0.f, 0.f, 0.f};
        cur = nxt; cA = nA; cB = nB; ++ui;
        if constexpr (ALIGN_EPI) { if (wr == 1) PG8_BAR; }
    }
    PG8_WAIT_V(0);
    if constexpr (!ALIGN_EPI) { if (wr == 0) PG8_BAR; }
    PG8_BAR;
    if constexpr (Epi::AFTER_DRAIN) { E.fused(acc, cur, wr, wc, fr, fq, lds, wid, lane); S.done(cur); }
#undef PG8_SA
#undef PG8_SB
#undef PG8_STAGE
#undef PG8_LDA
#undef PG8_LDB
#undef PG8_MMA
#undef PG8_WAIT_V
#undef PG8_WAIT_L
#undef PG8_BAR
#undef PG8_SCHED
}
}
namespace att {
using bf16 = __hip_bfloat16;
constexpr int D = 128, NW = 8, QBLK = 32, KVBLK = 64;
constexpr float SCALE = 0.088388347648318440f;
constexpr float THR = 8.f;
constexpr int SDEPTH = 2;
constexpr size_t SHM_V = KVBLK * D * 2, SHM_K = KVBLK * D * 2, SHM_ATTN = 2 * SHM_V + 2 * SHM_K + NW * 64 * 4;
using bf16x8 = __attribute__((ext_vector_type(8))) short;
using s16x4  = __attribute__((ext_vector_type(4))) short;
using f32x16 = __attribute__((ext_vector_type(16))) float;
using f32x8  = __attribute__((ext_vector_type(8))) float;
using u32x4  = __attribute__((ext_vector_type(4))) unsigned;
#define KSWZ(row, colB) ((row) * 256 + ((colB) ^ (((row) & 7) << 4)))
#define SBAR() __builtin_amdgcn_sched_barrier(0)
__device__ __forceinline__ int crow(int r, int hi) { return (r & 3) + 8 * (r >> 2) + 4 * hi; }
__device__ __forceinline__ unsigned cvtpk(float lo, float hi) {
  unsigned r; asm volatile("v_cvt_pk_bf16_f32 %0, %1, %2" : "=v"(r) : "v"(lo), "v"(hi)); return r;
}
template <typename TIn> struct Stage;
template <> struct Stage<bf16>  { using T = bf16x8;
  __device__ static __forceinline__ T ld8(const bf16* p) { return *reinterpret_cast<const bf16x8*>(p); }
  __device__ static __forceinline__ bf16x8 tobf(T x) { return x; } };
template <> struct Stage<float> { using T = f32x8;
  __device__ static __forceinline__ T ld8(const float* p) { return *reinterpret_cast<const f32x8*>(p); }
  __device__ static __forceinline__ bf16x8 tobf(T x) {
    u32x4 w = {cvtpk(x[0], x[1]), cvtpk(x[2], x[3]), cvtpk(x[4], x[5]), cvtpk(x[6], x[7])}; return *reinterpret_cast<bf16x8*>(&w); } };

__device__ __forceinline__ void partialSM(f32x16& p0, f32x16& p1, float& m_reg, float& mn, float& alpha) {
  constexpr float C = SCALE * 1.4426950408889634f;
  float pmax = p0[0]; for (int r = 1; r < 16; ++r) pmax = fmaxf(pmax, p0[r]); for (int r = 0; r < 16; ++r) pmax = fmaxf(pmax, p1[r]);
  { auto rr = __builtin_amdgcn_permlane32_swap(__float_as_uint(pmax), __float_as_uint(pmax), false, false);
    pmax = fmaxf(__uint_as_float(rr[0]), __uint_as_float(rr[1])); }
  if (__builtin_expect(__all(pmax - m_reg <= THR / SCALE), 1)) { mn = m_reg; alpha = 1.f; }
  else { mn = fmaxf(m_reg, pmax); alpha = __builtin_amdgcn_exp2f((m_reg - mn) * C); m_reg = mn; }
  float mnC = -mn * C;
  for (int r = 0; r < 16; ++r) p0[r] = fmaf(p0[r], C, mnC); for (int r = 0; r < 16; ++r) p1[r] = fmaf(p1[r], C, mnC);
  for (int r = 0; r < 16; ++r) p0[r] = __builtin_amdgcn_exp2f(p0[r]);
}
__device__ __forceinline__ void finishSM(f32x16& p0, f32x16& p1, float alpha, float& l_reg, bf16x8& pa0, bf16x8& pa1, bf16x8& pa2, bf16x8& pa3) {
  for (int r = 0; r < 16; ++r) p1[r] = __builtin_amdgcn_exp2f(p1[r]);
  float ps = 0; for (int r = 0; r < 16; ++r) ps += p0[r]; for (int r = 0; r < 16; ++r) ps += p1[r];
  { auto rr = __builtin_amdgcn_permlane32_swap(__float_as_uint(ps), __float_as_uint(ps), false, false);
    ps = __uint_as_float(rr[0]) + __uint_as_float(rr[1]); }
  l_reg = l_reg * alpha + ps;
#define PK4(P, BASE, OUT) do { unsigned a0 = cvtpk(P[BASE + 0], P[BASE + 1]), a1 = cvtpk(P[BASE + 2], P[BASE + 3]);   \
    unsigned b0 = cvtpk(P[BASE + 4], P[BASE + 5]), b1 = cvtpk(P[BASE + 6], P[BASE + 7]);                              \
    auto r0 = __builtin_amdgcn_permlane32_swap(a0, b0, false, false); auto r1 = __builtin_amdgcn_permlane32_swap(a1, b1, false, false); \
    u32x4 w = {r0[0], r1[0], r0[1], r1[1]}; OUT = *reinterpret_cast<bf16x8*>(&w); } while (0)
  PK4(p0, 0, pa0); PK4(p0, 8, pa1); PK4(p1, 0, pa2); PK4(p1, 8, pa3);
#undef PK4
}
__device__ __forceinline__ void qkt(f32x16& p0, f32x16& p1, const bf16* Ks, const bf16x8* qr, int r32, int hi) {
  p0 = f32x16{}; p1 = f32x16{};
  for (int d0 = 0; d0 < 8; ++d0) { int cb = (d0 * 16 + hi * 8) * 2;
    bf16x8 b0 = *reinterpret_cast<const bf16x8*>((const char*)Ks + KSWZ(r32, cb));
    bf16x8 b1 = *reinterpret_cast<const bf16x8*>((const char*)Ks + KSWZ(32 + r32, cb));
    p0 = __builtin_amdgcn_mfma_f32_32x32x16_bf16(b0, qr[d0], p0, 0, 0, 0);
    p1 = __builtin_amdgcn_mfma_f32_32x32x16_bf16(b1, qr[d0], p1, 0, 0, 0); }
}
__device__ __forceinline__ int v_st(int k, int c) { const int kk = (k & ~0xC) | ((k & 4) << 1) | ((k & 8) >> 1); return ((kk >> 3) * 4 + (c >> 5)) * 512 + ((kk & 7) * 32 + (c & 31)) * 2; }
__device__ __forceinline__ int v_rd_base(int lane) { return ((lane & 3) << 3) | (((lane >> 2) & 3) << 6) | (((lane >> 4) & 1) << 5) | (((lane >> 5) & 1) << 8); }
constexpr int v_rd_off(int d0, int ks, int half) { return d0 * 512 + ks * 4096 + half * 2048; }
template <int OFF> __device__ __forceinline__ s16x4 tr_read(int vb) {
  s16x4 r; asm volatile("ds_read_b64_tr_b16 %0, %1 offset:%2" : "=&v"(r) : "v"(vb), "i"(OFF) : "memory"); return r;
}
template <int D0> __device__ __forceinline__ void pv_one(f32x16& od, int vb, bf16x8 pa0, bf16x8 pa1, bf16x8 pa2, bf16x8 pa3) {
  const s16x4 l0 = tr_read<v_rd_off(D0, 0, 0)>(vb), h0 = tr_read<v_rd_off(D0, 0, 1)>(vb), l1 = tr_read<v_rd_off(D0, 1, 0)>(vb), h1 = tr_read<v_rd_off(D0, 1, 1)>(vb);
  const s16x4 l2 = tr_read<v_rd_off(D0, 2, 0)>(vb), h2 = tr_read<v_rd_off(D0, 2, 1)>(vb), l3 = tr_read<v_rd_off(D0, 3, 0)>(vb), h3 = tr_read<v_rd_off(D0, 3, 1)>(vb);
  asm volatile("s_waitcnt lgkmcnt(0)" ::: "memory"); SBAR();
#define PK(L, H) (bf16x8){L[0], L[1], L[2], L[3], H[0], H[1], H[2], H[3]}
  od = __builtin_amdgcn_mfma_f32_32x32x16_bf16(pa0, PK(l0, h0), od, 0, 0, 0);
  od = __builtin_amdgcn_mfma_f32_32x32x16_bf16(pa1, PK(l1, h1), od, 0, 0, 0);
  od = __builtin_amdgcn_mfma_f32_32x32x16_bf16(pa2, PK(l2, h2), od, 0, 0, 0);
  od = __builtin_amdgcn_mfma_f32_32x32x16_bf16(pa3, PK(l3, h3), od, 0, 0, 0);
#undef PK
}
__device__ __forceinline__ void pv_d0(f32x16* o, int vb, bf16x8 pa0, bf16x8 pa1, bf16x8 pa2, bf16x8 pa3) {
  pv_one<0>(o[0], vb, pa0, pa1, pa2, pa3); pv_one<1>(o[1], vb, pa0, pa1, pa2, pa3); pv_one<2>(o[2], vb, pa0, pa1, pa2, pa3); pv_one<3>(o[3], vb, pa0, pa1, pa2, pa3);
}
__device__ __forceinline__ void na_mask(f32x16& p0, f32x16& p1, const float* T, int tb, int kk, bool rowvalid) {
#pragma unroll
  for (int q = 0; q < 4; ++q) {
#pragma unroll
    for (int r = 4 * q; r < 4 * q + 4; ++r) { const int cr = (r & 3) + 8 * (r >> 2);
      const float b0 = T[tb + cr]; const bool v0 = rowvalid && (unsigned)(cr + kk) < 16u; p0[r] = v0 ? p0[r] + b0 : -INFINITY; }
    asm volatile("" ::: "memory");
#pragma unroll
    for (int r = 4 * q; r < 4 * q + 4; ++r) { const int cr = (r & 3) + 8 * (r >> 2);
      const float b1 = T[tb + 32 + cr]; const bool v1 = rowvalid && (unsigned)(cr + 32 + kk) < 16u; p1[r] = v1 ? p1[r] + b1 : -INFINITY; }
    asm volatile("" ::: "memory");
  }
}
__device__ __forceinline__ void partialSM_fx(f32x16& p0, f32x16& p1, float negMc) {
  (void)negMc;
  for (int r = 0; r < 16; ++r) p0[r] = __builtin_amdgcn_exp2f(p0[r]);
}
__device__ __forceinline__ void finishSM_fx(f32x16& p0, f32x16& p1, float& l_reg, bf16x8& pa0, bf16x8& pa1, bf16x8& pa2, bf16x8& pa3) {
  for (int r = 0; r < 16; ++r) p1[r] = __builtin_amdgcn_exp2f(p1[r]);
  float ps = 0; for (int r = 0; r < 16; ++r) ps += p0[r]; for (int r = 0; r < 16; ++r) ps += p1[r];
  l_reg += ps;
#define PK4(P, BASE, OUT) do { unsigned a0 = cvtpk(P[BASE + 0], P[BASE + 1]), a1 = cvtpk(P[BASE + 2], P[BASE + 3]);   \
    unsigned b0 = cvtpk(P[BASE + 4], P[BASE + 5]), b1 = cvtpk(P[BASE + 6], P[BASE + 7]);                              \
    auto r0 = __builtin_amdgcn_permlane32_swap(a0, b0, false, false); auto r1 = __builtin_amdgcn_permlane32_swap(a1, b1, false, false); \
    u32x4 w = {r0[0], r1[0], r0[1], r1[1]}; OUT = *reinterpret_cast<bf16x8*>(&w); } while (0)
  PK4(p0, 0, pa0); PK4(p0, 8, pa1); PK4(p1, 0, pa2); PK4(p1, 8, pa3);
#undef PK4
}
__device__ __forceinline__ void qkt_i(f32x16& p0, f32x16& p1, const bf16* Ks, const bf16x8* qr, int r32, int hi, float init) {
  for (int r = 0; r < 16; ++r) { p0[r] = init; p1[r] = init; }
  for (int d0 = 0; d0 < 8; ++d0) { int cb = (d0 * 16 + hi * 8) * 2;
    bf16x8 b0 = *reinterpret_cast<const bf16x8*>((const char*)Ks + KSWZ(r32, cb));
    bf16x8 b1 = *reinterpret_cast<const bf16x8*>((const char*)Ks + KSWZ(32 + r32, cb));
    p0 = __builtin_amdgcn_mfma_f32_32x32x16_bf16(b0, qr[d0], p0, 0, 0, 0);
    p1 = __builtin_amdgcn_mfma_f32_32x32x16_bf16(b1, qr[d0], p1, 0, 0, 0); }
}
template <int LDO>
__device__ __forceinline__ void store_o_tile(const f32x16* o, const float* rli, char* lds, int wid, int lane, bf16* Ow) {
  const int r32 = lane & 31, hi = lane >> 5;
  char* T = lds + wid * 8192;
#pragma unroll
  for (int r = 0; r < 16; ++r) { const int orow = crow(r, hi);
#pragma unroll
    for (int d0 = 0; d0 < 4; ++d0) *reinterpret_cast<bf16*>(T + orow * 256 + (d0 * 32 + r32) * 2) = __float2bfloat16(o[d0][r] * rli[r]); }
  asm volatile("s_waitcnt lgkmcnt(0)" ::: "memory");
#pragma unroll
  for (int i = 0; i < 8; ++i) { const int idx = lane + 64 * i, row = idx >> 4, ch = idx & 15;
    const u32x4 w = *reinterpret_cast<const u32x4*>(T + row * 256 + ch * 16);
    *reinterpret_cast<u32x4*>(Ow + (long)row * LDO + ch * 8) = w; }
  asm volatile("s_waitcnt lgkmcnt(0)" ::: "memory");
}
template <int LDQ, int LDK, int LDO, bool NA, int SD, int VOFF>
__device__ __forceinline__ void attn_unit(const bf16* Qb, const bf16* __restrict__ Kh, const bf16* __restrict__ Vh_, bf16* Ob, int NT, char* lds,
                                          const float* __restrict__ rpb  , const float* __restrict__ f1  , int qrow0, int krow0, int tid_in) {
  using St = Stage<bf16>;
  const bf16* __restrict__ Vh = VOFF ? Kh + VOFF : Vh_;
  int tid_ = tid_in; asm volatile("" : "+v"(tid_));
  const int tid = tid_, wid = __builtin_amdgcn_readfirstlane(tid >> 6), lane = tid & 63, r32 = lane & 31, hi = lane >> 5;
  bf16* V_lds = (bf16*)lds; bf16* K_lds = (bf16*)(lds + 2 * SHM_V);
  float* ws = (float*)(lds + 2 * SHM_V + 2 * SHM_K) + wid * 64; float* li_l = ws; float* al_l = ws + 32;
  float* T = (float*)(lds + SHM_ATTN);
  __syncthreads();
  int na_tb0 = 0, na_kk = 0, na_r = 0, na_rs = 0;
  if constexpr (NA) {
    for (int e = tid; e < 15 * 128; e += 512) { const int rr = e >> 7, x = e & 127; T[e] = (x >= 49 && x <= 79) ? rpb[rr * 31 + x - 49] * (1.0f / SCALE) : 0.f;
    }
    const int c = (wid & 1) * 32 + r32; int cs = c - 8; cs = cs < 0 ? 0 : (cs > 48 ? 48 : cs);
    na_tb0 = 64 - c + 4 * hi; na_kk = 4 * hi - cs;
    na_r = qrow0 + (wid >> 1); na_rs = na_r - 4; na_rs = na_rs < 0 ? 0 : (na_rs > 248 ? 248 : na_rs);
  }
  float negMc = 0.f;
  if constexpr (!NA) {
    float mq = fmaxf(fabsf(rpb[lane]), fabsf(rpb[lane + 64])), mk = fmaxf(fabsf(f1[lane]), fabsf(f1[lane + 64]));
#pragma unroll
    for (int o_ = 1; o_ < 64; o_ <<= 1) { mq = fmaxf(mq, __shfl_xor(mq, o_)); mk = fmaxf(mk, __shfl_xor(mk, o_)); }
    const float M = fminf(11.3137085f * 1.01f * mq * mk, 60.f);
    negMc = -M * 1.4426950408889634f;
  }
#define PSM(P0, P1, MN, AL) do { if constexpr (NA) partialSM(P0, P1, m_reg, MN, AL); else partialSM_fx(P0, P1, negMc); } while (0)
#define FSM(P0, P1, AL) do { if constexpr (NA) finishSM(P0, P1, AL, l_reg, pa0, pa1, pa2, pa3); else finishSM_fx(P0, P1, l_reg, pa0, pa1, pa2, pa3); } while (0)
#define NAMASK(P0, P1, ti) do { if constexpr (NA) { SBAR(); const int kr_ = krow0 + (ti); const bool rv_ = (unsigned)(kr_ - na_rs) < 8u; int rr_ = kr_ - na_r + 7; rr_ = rv_ ? rr_ : 0; \
    na_mask(P0, P1, T, na_tb0 + rr_ * 128, na_kk, rv_); SBAR(); } } while (0)
  float m_reg = -1e30f, l_reg = 0; f32x16 o[4] = {}; bf16x8 qr[8];
  const bf16* Qw = Qb + (long)(wid * QBLK + r32) * LDQ + hi * 8;
#pragma unroll
  for (int d0 = 0; d0 < 8; ++d0) qr[d0] = St::ld8(Qw + d0 * 16);
  const int sr = tid >> 4, sc = (tid & 15) * 8, vst0 = v_st(sr, sc), vst1 = v_st(32 + sr, sc);
  const int vb0 = (int)(uintptr_t)V_lds + v_rd_base(lane);
  struct { typename St::T vs0, vs1, ks0, ks1; } sr_[SD];
#define SLOAD(i, k0) do { sr_[i].vs0 = St::ld8(&Vh[(long)((k0) + sr) * LDK + sc]); sr_[i].vs1 = St::ld8(&Vh[(long)((k0) + 32 + sr) * LDK + sc]); \
    sr_[i].ks0 = St::ld8(&Kh[(long)((k0) + sr) * LDK + sc]); sr_[i].ks1 = St::ld8(&Kh[(long)((k0) + 32 + sr) * LDK + sc]); } while (0)
#define SWRITE(b, i) do { *(bf16x8*)((char*)V_lds + (b) * SHM_V + vst0) = St::tobf(sr_[i].vs0);          \
    *(bf16x8*)((char*)V_lds + (b) * SHM_V + vst1) = St::tobf(sr_[i].vs1); int kc = sc * 2;               \
    *(bf16x8*)((char*)K_lds + (b) * SHM_K + KSWZ(sr, kc)) = St::tobf(sr_[i].ks0);                       \
    *(bf16x8*)((char*)K_lds + (b) * SHM_K + KSWZ(32 + sr, kc)) = St::tobf(sr_[i].ks1); } while (0)
#define SWAIT() do { if constexpr (SD == 2) asm volatile("s_waitcnt vmcnt(4)" ::: "memory"); else asm volatile("s_waitcnt vmcnt(0)" ::: "memory"); } while (0)
#define RESC(a) do { if constexpr (NA) if (__any((a) < 1.f)) { if (hi == 0) al_l[r32] = (a); asm volatile("s_waitcnt lgkmcnt(0)" ::: "memory"); \
    for (int d = 0; d < 4; ++d) for (int r = 0; r < 16; ++r) o[d][r] *= al_l[crow(r, hi)]; } } while (0)
  f32x16 pA0, pA1, pB0, pB1; float mnA, mnB, alA, alB; bf16x8 pa0, pa1, pa2, pa3;
  constexpr int SE = 0, SO = SD - 1;
  SLOAD(SE, 0); asm volatile("s_waitcnt vmcnt(0)" ::: "memory"); SWRITE(0, SE); __syncthreads();
  qkt_i(pA0, pA1, K_lds, qr, r32, hi, negMc); NAMASK(pA0, pA1, 0); PSM(pA0, pA1, mnA, alA);
  SLOAD(SO, KVBLK); if constexpr (SD == 2) { if (2 < NT) SLOAD(SE, 2 * KVBLK); }
  SWAIT(); SWRITE(1, SO); __syncthreads();
  for (int j = 1; j + 1 < NT; j += 2) {
    SBAR(); qkt_i(pB0, pB1, (bf16*)((char*)K_lds + SHM_K), qr, r32, hi, negMc);
    FSM(pA0, pA1, alA); SBAR();
    SLOAD(SO, (j + SD) * KVBLK); SBAR();
    pv_d0(o, vb0, pa0, pa1, pa2, pa3); NAMASK(pB0, pB1, j); PSM(pB0, pB1, mnB, alB);
    __syncthreads(); SWAIT(); SWRITE(0, SE);
    RESC(alB); __syncthreads();
    SBAR(); qkt_i(pA0, pA1, K_lds, qr, r32, hi, negMc);
    FSM(pB0, pB1, alB); SBAR();
    if (SD == 1 || j + 3 < NT) SLOAD(SE, (j + 1 + SD) * KVBLK); SBAR();
    pv_d0(o, vb0 + (int)SHM_V, pa0, pa1, pa2, pa3); NAMASK(pA0, pA1, j + 1); PSM(pA0, pA1, mnA, alA);
    __syncthreads(); SWAIT(); SWRITE(1, SO);
    RESC(alA); __syncthreads();
  }
  SBAR(); qkt_i(pB0, pB1, (bf16*)((char*)K_lds + SHM_K), qr, r32, hi, negMc);
  FSM(pA0, pA1, alA); SBAR();
  pv_d0(o, vb0, pa0, pa1, pa2, pa3); NAMASK(pB0, pB1, NT - 1); PSM(pB0, pB1, mnB, alB);
  __syncthreads(); RESC(alB);
  FSM(pB0, pB1, alB); SBAR();
  pv_d0(o, vb0 + (int)SHM_V, pa0, pa1, pa2, pa3);
  if constexpr (!NA) { auto rr_ = __builtin_amdgcn_permlane32_swap(__float_as_uint(l_reg), __float_as_uint(l_reg), false, false); l_reg = __uint_as_float(rr_[0]) + __uint_as_float(rr_[1]); }
  if (hi == 0) li_l[r32] = l_reg; asm volatile("s_waitcnt lgkmcnt(0)" ::: "memory");
  float rli[16];
#pragma unroll
  for (int r = 0; r < 16; ++r) rli[r] = __builtin_amdgcn_rcpf(li_l[crow(r, hi)]);
  __syncthreads();
  store_o_tile<LDO>(o, rli, lds, wid, lane, Ob + (long)(wid * QBLK) * LDO);
#undef SLOAD
#undef SWRITE
#undef SWAIT
#undef RESC
#undef NAMASK
#undef PSM
#undef FSM
}

typedef int v8i_t __attribute__((ext_vector_type(8)));
#define KSWZ8(row, colB) ((row) * 128 + ((colB) ^ ((((row) >> 1) & 7) << 4)))
__device__ __forceinline__ void qkt8(f32x16& p0, f32x16& p1, const char* Ks, const v8i_t* q8, int r32, int hi, float init) {
  for (int r = 0; r < 16; ++r) { p0[r] = init; p1[r] = init; }
#pragma unroll
  for (int s = 0; s < 2; ++s) { const int cb = 64 * s + 32 * hi;
    const u32x4 a00 = *reinterpret_cast<const u32x4*>(Ks + KSWZ8(r32, cb)), a01 = *reinterpret_cast<const u32x4*>(Ks + KSWZ8(r32, cb + 16));
    const u32x4 a10 = *reinterpret_cast<const u32x4*>(Ks + KSWZ8(32 + r32, cb)), a11 = *reinterpret_cast<const u32x4*>(Ks + KSWZ8(32 + r32, cb + 16));
    const v8i_t A0 = {(int)a00.x, (int)a00.y, (int)a00.z, (int)a00.w, (int)a01.x, (int)a01.y, (int)a01.z, (int)a01.w};
    const v8i_t A1 = {(int)a10.x, (int)a10.y, (int)a10.z, (int)a10.w, (int)a11.x, (int)a11.y, (int)a11.z, (int)a11.w};
    p0 = __builtin_amdgcn_mfma_scale_f32_32x32x64_f8f6f4(A0, q8[s], p0, 0, 0, 0, 0, 0, 0);
    p1 = __builtin_amdgcn_mfma_scale_f32_32x32x64_f8f6f4(A1, q8[s], p1, 0, 0, 0, 0, 0, 0); }
}
#define VSWZ8(row, colB) ((row) * 64 + ((colB) ^ ((((row) >> 2) & 3) << 4)))
__device__ __forceinline__ void finishSM_fx8(f32x16& p0, f32x16& p1, float& l_reg, v8i_t& P8) {
  for (int r = 0; r < 16; ++r) p1[r] = __builtin_amdgcn_exp2f(p1[r]);
  float ps = 0; for (int r = 0; r < 16; ++r) ps += p0[r]; for (int r = 0; r < 16; ++r) ps += p1[r];
  l_reg += ps;
#pragma unroll
  for (int i = 0; i < 4; ++i) { int w = 0; w = __builtin_amdgcn_cvt_pk_bf8_f32(p0[4 * i], p0[4 * i + 1], w, false); w = __builtin_amdgcn_cvt_pk_bf8_f32(p0[4 * i + 2], p0[4 * i + 3], w, true); P8[i] = w; }
#pragma unroll
  for (int i = 0; i < 4; ++i) { int w = 0; w = __builtin_amdgcn_cvt_pk_bf8_f32(p1[4 * i], p1[4 * i + 1], w, false); w = __builtin_amdgcn_cvt_pk_bf8_f32(p1[4 * i + 2], p1[4 * i + 3], w, true); P8[4 + i] = w; }
}
__device__ __forceinline__ void pv8(f32x16* o, const char* Vs, const v8i_t P8, int r32, int hi) {
#pragma unroll
  for (int d0 = 0; d0 < 4; ++d0) { const int row = 32 * d0 + r32;
    const u32x4 b0 = *reinterpret_cast<const u32x4*>(Vs + VSWZ8(row, 32 * hi)), b1 = *reinterpret_cast<const u32x4*>(Vs + VSWZ8(row, 32 * hi + 16));
    const v8i_t B = {(int)b0.x, (int)b0.y, (int)b0.z, (int)b0.w, (int)b1.x, (int)b1.y, (int)b1.z, (int)b1.w};
    o[d0] = __builtin_amdgcn_mfma_scale_f32_32x32x64_f8f6f4(P8, B, o[d0], 1  , 0  , 0, 0, 0, 0); }
}
template <int LDQ8, int LDK8, int LDVT, int LDO>
__device__ __forceinline__ void attn_unit_g8(const unsigned char* Q8, const unsigned char* __restrict__ K8h, const unsigned char* __restrict__ V8Th, bf16* Ob, int NT, char* lds,
                                             const float* __restrict__ qnw, const float* __restrict__ knw, int tid_in) {
  int tid_ = tid_in; asm volatile("" : "+v"(tid_));
  const int tid = tid_, wid = __builtin_amdgcn_readfirstlane(tid >> 6), lane = tid & 63, r32 = lane & 31, hi = lane >> 5;
  char* V_lds = lds; char* K_lds = lds + 2 * SHM_V;
  float* ws = (float*)(lds + 2 * SHM_V + 2 * SHM_K) + wid * 64; float* li_l = ws;
  __syncthreads();
  float negMc;
  { float mq = fmaxf(fabsf(qnw[lane]), fabsf(qnw[lane + 64])), mk = fmaxf(fabsf(knw[lane]), fabsf(knw[lane + 64]));
#pragma unroll
    for (int o_ = 1; o_ < 64; o_ <<= 1) { mq = fmaxf(mq, __shfl_xor(mq, o_)); mk = fmaxf(mk, __shfl_xor(mk, o_)); }
    const float M = fminf(11.3137085f * 1.07f * mq * mk, 60.f);
    negMc = __uint_as_float(__builtin_amdgcn_readfirstlane(__float_as_uint(15.0f - M * 1.4426950408889634f))); }
  float l_reg = 0; f32x16 o[4] = {}; v8i_t q8[2];
  { const unsigned char* Qw = Q8 + (long)(wid * QBLK + r32) * LDQ8 + hi * 32;
#pragma unroll
    for (int s = 0; s < 2; ++s) { const u32x4 a = *reinterpret_cast<const u32x4*>(Qw + 64 * s), b = *reinterpret_cast<const u32x4*>(Qw + 64 * s + 16);
      q8[s] = (v8i_t){(int)a.x, (int)a.y, (int)a.z, (int)a.w, (int)b.x, (int)b.y, (int)b.z, (int)b.w}; } }
  const int kr = tid >> 3, kc = (tid & 7) * 16, kst = KSWZ8(kr, kc);
  const int vr = tid >> 2, vc = (tid & 3) * 16, vst = VSWZ8(vr, vc);
  u32x4 vs, ks;
  unsigned vo = (unsigned)(vr * LDVT + vc), ko = (unsigned)(kr * LDK8 + kc);
#define SLOAD(k0) do { vs = *reinterpret_cast<const u32x4*>(V8Th + vo); ks = *reinterpret_cast<const u32x4*>(K8h + ko); vo += KVBLK; ko += KVBLK * LDK8; asm volatile("" : "+v"(vo), "+v"(ko)); } while (0)
#define SWRITE(b) do { *(u32x4*)(V_lds + (b) * SHM_V + vst) = vs; *(u32x4*)(K_lds + (b) * SHM_K + kst) = ks; } while (0)
#define SWAIT() asm volatile("s_waitcnt vmcnt(0)" ::: "memory")
  f32x16 pA0, pA1, pB0, pB1; v8i_t P8;
#define SWRITE4(b) do { *(u32x4*)(V_lds + (b) * 8192 + vst) = vs; *(u32x4*)(K_lds + (b) * 8192 + kst) = ks; } while (0)
#define STEP(PN0, PN1, PO0, PO1, KB, VB, WB, JJ, LOADS) do { \
    SBAR(); qkt8(PN0, PN1, K_lds + (KB) * 8192, q8, r32, hi, negMc); \
    finishSM_fx8(PO0, PO1, l_reg, P8); SBAR(); \
    if (LOADS) SLOAD(((JJ) + 2) * KVBLK); SBAR(); \
    pv8(o, V_lds + (VB) * 8192, P8, r32, hi); partialSM_fx(PN0, PN1, negMc); \
    __syncthreads(); if (LOADS) { SWAIT(); SWRITE4(WB); } } while (0)
  SLOAD(0); SWAIT(); SWRITE4(0);
  SLOAD(KVBLK); SWAIT(); SWRITE4(1); __syncthreads();
  SLOAD(2 * KVBLK);
  qkt8(pA0, pA1, K_lds, q8, r32, hi, negMc); partialSM_fx(pA0, pA1, negMc);
  SWAIT(); SWRITE4(2);
  int j = 1;
  for (; j + 5 < NT; j += 4) {
    STEP(pB0, pB1, pA0, pA1, 1, 0, 3, j, true);
    STEP(pA0, pA1, pB0, pB1, 2, 1, 0, j + 1, true);
    STEP(pB0, pB1, pA0, pA1, 3, 2, 1, j + 2, true);
    STEP(pA0, pA1, pB0, pB1, 0, 3, 2, j + 3, true);
  }
  STEP(pB0, pB1, pA0, pA1, 1, 0, 3, j, true);
  STEP(pA0, pA1, pB0, pB1, 2, 1, 0, j + 1, false);
  SBAR(); qkt8(pB0, pB1, K_lds + 3 * 8192, q8, r32, hi, negMc);
  finishSM_fx8(pA0, pA1, l_reg, P8); SBAR();
  pv8(o, V_lds + 2 * 8192, P8, r32, hi); partialSM_fx(pB0, pB1, negMc);
  finishSM_fx8(pB0, pB1, l_reg, P8); SBAR();
  pv8(o, V_lds + 3 * 8192, P8, r32, hi);
#undef STEP
#undef SWRITE4
  { auto rr_ = __builtin_amdgcn_permlane32_swap(__float_as_uint(l_reg), __float_as_uint(l_reg), false, false); l_reg = __uint_as_float(rr_[0]) + __uint_as_float(rr_[1]); }
  if (hi == 0) li_l[r32] = l_reg; asm volatile("s_waitcnt lgkmcnt(0)" ::: "memory");
  float rli[16];
#pragma unroll
  for (int r = 0; r < 16; ++r) rli[r] = __builtin_amdgcn_rcpf(li_l[crow(r, hi)]);
  __syncthreads();
  store_o_tile<LDO>(o, rli, lds, wid, lane, Ob + (long)(wid * QBLK) * LDO);
#undef SLOAD
#undef SWRITE
#undef SWAIT
}
#undef SBAR
}
namespace cg = cooperative_groups;
#define LAS __attribute__((address_space(3)))
typedef unsigned short bf16_t;
typedef float f32x4 __attribute__((ext_vector_type(4)));
typedef unsigned v4u __attribute__((ext_vector_type(4)));
typedef unsigned v2u __attribute__((ext_vector_type(2)));
constexpr int SEQ = 16384, DM = 2048, DIN = 8704, DFF = 5632, NMOD = 6 * DM;
constexpr float NORM_EPS = 1e-6f;
constexpr size_t MiB = 1u << 20;
constexpr size_t WS_MOD = 0, CTL_ZERO_BYTES = 64 * 1024;
constexpr size_t WS_ROPE = 1 * MiB;
using pg8::PH; using pg8::PA; using pg8::PKV; using pg8::PNB;
constexpr size_t WS_WIN = 2 * MiB, WS_WO = 39 * MiB, WS_WOUT = 48 * MiB, WS_WGU = 57 * MiB, WS_WD = 104 * MiB;
constexpr size_t WS_H = 128 * MiB;
constexpr size_t WS_Q8 = WS_H, WS_K8 = WS_H + 16 * MiB, WS_V8T = WS_H + 20 * MiB;
constexpr size_t WS_QAB = 196 * MiB, WS_KVA = 264 * MiB, WS_KB = 284 * MiB, WS_VB = 320 * MiB, WS_GA = 356 * MiB, WS_GB = 424 * MiB, WS_END = 492 * MiB;
constexpr size_t WS_ACT = 196 * MiB;
static_assert(WS_WIN + (size_t)DIN * PH * 2 <= WS_WO && WS_WO + (size_t)DM * PH * 2 <= WS_WOUT && WS_WOUT + (size_t)DM * PH * 2 <= WS_WGU && WS_WGU + (size_t)2 * DFF * PH * 2 <= WS_WD && WS_WD + (size_t)DM * PA * 2 <= WS_H, "weight map");
static_assert(WS_H + (size_t)SEQ * PH * 2 <= WS_QAB && WS_QAB + (size_t)SEQ * PH * 2 <= WS_KVA && WS_KVA + (size_t)SEQ * PKV * 2 <= WS_KB && WS_KB + (size_t)SEQ * PNB * 2 <= WS_VB && WS_VB + (size_t)SEQ * PNB * 2 <= WS_GA &&
              WS_GA + (size_t)SEQ * PH * 2 <= WS_GB && WS_GB + (size_t)SEQ * PH * 2 <= WS_END && WS_ACT + (size_t)SEQ * PA * 2 <= WS_GB && WS_V8T + 4 * MiB <= WS_QAB, "activation map");
constexpr size_t WS_BAR = 49152;
constexpr int LDS_BYTES = 147456, LDS_MISC = 131072;
constexpr int NPHASE = 11;
#ifndef GEMM_SP2
#define GEMM_SP2 true
#endif
#ifndef GEMM_ALIGN
#define GEMM_ALIGN true
#endif
#ifndef GATT_SD
#define GATT_SD 1
#endif
#ifndef STAGGER_SLEEPS
#define STAGGER_SLEEPS 7
#endif

__device__ __forceinline__ unsigned f2bf(float f) { unsigned u = __builtin_bit_cast(unsigned, f); return (u + 0x7fffu + ((u >> 16) & 1u)) >> 16; }
__device__ __forceinline__ unsigned pk2(float lo, float hi) { return f2bf(lo) | (f2bf(hi) << 16); }
__device__ __forceinline__ float wave_sum(float v) {
#pragma unroll
    for (int o = 1; o < 64; o <<= 1) v += __shfl_xor(v, o);
    return v;
}
__device__ __forceinline__ void transpose_item(const float* __restrict__ W, int N, bf16_t* __restrict__ WT, int ldt, int koff, int mode, LAS float* scr, int item, int lane) {
    const int nblk = N / 32, kb = item / nblk, nb = item % nblk, k0 = 64 * kb, n0 = 32 * nb;
    const int drow0 = mode == 0 ? n0 : ((n0 >> 7) * 256 + (n0 & 127) + (mode == 2 ? 128 : 0));
#pragma unroll 8
    for (int i = 0; i < 32; ++i) { const int kk = 2 * i + (lane >> 5); scr[kk * 33 + (lane & 31)] = W[(size_t)(k0 + kk) * N + n0 + (lane & 31)]; }
    asm volatile("s_waitcnt lgkmcnt(0)" ::: "memory");
    const int c = lane & 7;
#pragma unroll
    for (int j = 0; j < 4; ++j) { const int n = (lane >> 3) + 8 * j; const LAS float* s = scr + (8 * c) * 33 + n;
        v4u o; o.x = pk2(s[0 * 33], s[1 * 33]); o.y = pk2(s[2 * 33], s[3 * 33]); o.z = pk2(s[4 * 33], s[5 * 33]); o.w = pk2(s[6 * 33], s[7 * 33]);
        *(v4u*)(WT + (size_t)(drow0 + n) * ldt + koff + k0 + 8 * c) = o; }
    asm volatile("s_waitcnt lgkmcnt(0)" ::: "memory");
}
__device__ __forceinline__ void gemv_item(const float* __restrict__ cvec, const float* __restrict__ w_ada, const float* __restrict__ b_ada, float* mod, int item, int lane) {
    const int kc = item / 48, jc = item % 48, col = jc * 256 + 4 * lane;
    f32x4 acc = {0.f, 0.f, 0.f, 0.f};
#pragma unroll 8
    for (int kk = 0; kk < 64; ++kk) { const int k = kc * 64 + kk; const float cv = cvec[k]; const float s = cv / (1.f + expf(-cv));
        const f32x4 w = *(const f32x4*)(w_ada + (size_t)k * NMOD + col); acc += w * s; }
    if (kc == 0) acc += *(const f32x4*)(b_ada + col);
#pragma unroll
    for (int e = 0; e < 4; ++e) __hip_atomic_fetch_add(mod + col + e, acc[e], __ATOMIC_RELAXED, __HIP_MEMORY_SCOPE_AGENT);
}
__device__ __forceinline__ void normmod_rows(const float* X, const float* __restrict__ nw, const float* __restrict__ sc, const float* __restrict__ sh, bf16_t* __restrict__ H, int gw, int NGW, int mend, int lane) {
    f32x4 a[8], b[8];
#pragma unroll
    for (int j = 0; j < 8; ++j) { const int col = 4 * lane + 256 * j; const f32x4 w = *(const f32x4*)(nw + col), s = *(const f32x4*)(sc + col); a[j] = w * (s + 1.0f); b[j] = *(const f32x4*)(sh + col); }
    for (int m = gw; m < mend; m += NGW) {
        const f32x4* xr = (const f32x4*)(X + (size_t)m * DM) + lane; f32x4 v[8]; float ss = 0.f;
#pragma unroll
        for (int j = 0; j < 8; ++j) { v[j] = xr[64 * j]; ss += (v[j].x * v[j].x + v[j].y * v[j].y) + (v[j].z * v[j].z + v[j].w * v[j].w); }
        const float rstd = rsqrtf(wave_sum(ss) * (1.0f / DM) + NORM_EPS);
        v2u* o8 = (v2u*)(H + (size_t)m * PH) + lane;
#pragma unroll
        for (int j = 0; j < 8; ++j) { const f32x4 y = v[j] * rstd * a[j] + b[j]; v2u w; w.x = pk2(y.x, y.y); w.y = pk2(y.z, y.w);
            o8[64 * j] = w; }
    }
}
__device__ __forceinline__ f32x4 bf4(v2u w) { f32x4 r; r.x = __uint_as_float(w.x << 16); r.y = __uint_as_float(w.x & 0xffff0000u); r.z = __uint_as_float(w.y << 16); r.w = __uint_as_float(w.y & 0xffff0000u); return r; }
__device__ __forceinline__ void normmod_rows_d(const float* __restrict__ X, const bf16_t* __restrict__ D1, const float* __restrict__ nw, const float* __restrict__ sc, const float* __restrict__ sh, bf16_t* __restrict__ H, int gw, int NGW, int mend, int lane) {
    f32x4 a[8], b[8];
#pragma unroll
    for (int j = 0; j < 8; ++j) { const int col = 4 * lane + 256 * j; const f32x4 w = *(const f32x4*)(nw + col), s = *(const f32x4*)(sc + col); a[j] = w * (s + 1.0f); b[j] = *(const f32x4*)(sh + col); }
    for (int m = gw; m < mend; m += NGW) {
        const f32x4* xr = (const f32x4*)(X + (size_t)m * DM) + lane; const v2u* dr = (const v2u*)(D1 + (size_t)m * PH) + lane; f32x4 v[8]; float ss = 0.f;
#pragma unroll
        for (int j = 0; j < 8; ++j) { v[j] = xr[64 * j] + bf4(dr[64 * j]); ss += (v[j].x * v[j].x + v[j].y * v[j].y) + (v[j].z * v[j].z + v[j].w * v[j].w); }
        const float rstd = rsqrtf(wave_sum(ss) * (1.0f / DM) + NORM_EPS);
        v2u* o8 = (v2u*)(H + (size_t)m * PH) + lane;
#pragma unroll
        for (int j = 0; j < 8; ++j) { const f32x4 y = v[j] * rstd * a[j] + b[j]; v2u w; w.x = pk2(y.x, y.y); w.y = pk2(y.z, y.w); o8[64 * j] = w; }
    }
}
__device__ __forceinline__ void final_rows_d(const float* __restrict__ X, const bf16_t* __restrict__ D1, const bf16_t* __restrict__ D2, float* __restrict__ OUT, const float* __restrict__ fw, int gw, int NGW, int mend, int lane) {
    f32x4 a[8];
#pragma unroll
    for (int j = 0; j < 8; ++j) a[j] = *(const f32x4*)(fw + 4 * lane + 256 * j);
    for (int m = gw; m < mend; m += NGW) {
        const f32x4* xr = (const f32x4*)(X + (size_t)m * DM) + lane; const v2u* d1 = (const v2u*)(D1 + (size_t)m * PH) + lane; const v2u* d2 = (const v2u*)(D2 + (size_t)m * PH) + lane; f32x4 v[8]; float ss = 0.f;
#pragma unroll
        for (int j = 0; j < 8; ++j) { v[j] = (xr[64 * j] + bf4(d1[64 * j])) + bf4(d2[64 * j]); ss += (v[j].x * v[j].x + v[j].y * v[j].y) + (v[j].z * v[j].z + v[j].w * v[j].w); }
        const float rstd = rsqrtf(wave_sum(ss) * (1.0f / DM) + NORM_EPS);
        f32x4* orow = (f32x4*)(OUT + (size_t)m * DM) + lane;
#pragma unroll
        for (int j = 0; j < 8; ++j) orow[64 * j] = v[j] * rstd * a[j];
    }
}
__device__ __forceinline__ void final_rows(float* X, const float* __restrict__ fw, int gw, int NGW, int lane) {
    f32x4 a[8];
#pragma unroll
    for (int j = 0; j < 8; ++j) a[j] = *(const f32x4*)(fw + 4 * lane + 256 * j);
    for (int m = gw; m < SEQ; m += NGW) {
        f32x4* xr = (f32x4*)(X + (size_t)m * DM) + lane; f32x4 v[8]; float ss = 0.f;
#pragma unroll
        for (int j = 0; j < 8; ++j) { v[j] = xr[64 * j]; ss += (v[j].x * v[j].x + v[j].y * v[j].y) + (v[j].z * v[j].z + v[j].w * v[j].w); }
        const float rstd = rsqrtf(wave_sum(ss) * (1.0f / DM) + NORM_EPS);
#pragma unroll
        for (int j = 0; j < 8; ++j) xr[64 * j] = v[j] * rstd * a[j];
    }
}
__device__ __forceinline__ void qknorm_rope(bf16_t* QAB, bf16_t* KVA, unsigned char* __restrict__ Q8, unsigned char* __restrict__ K8, const float* __restrict__ qn, const float* __restrict__ kn, const float* __restrict__ tab, int it0, int its, int ite, int lane) {
    const int li = lane & 15;
    for (int it = it0 + (lane >> 4); it < ite; it += its) {
        const int t = it / 10, hs = it - t * 10;
        bf16_t* p = (hs < 8 ? QAB + (size_t)t * PH + hs * 128 : KVA + (size_t)t * PKV + (hs - 8) * 128) + 8 * li;
        const float* wn = (hs < 8 ? qn : kn) + 8 * li;
        const v4u raw = *(const v4u*)p; float x[8];
#pragma unroll
        for (int e = 0; e < 4; ++e) { x[2 * e] = __uint_as_float(raw[e] << 16); x[2 * e + 1] = __uint_as_float(raw[e] & 0xffff0000u); }
        float ss = 0.f;
#pragma unroll
        for (int e = 0; e < 8; ++e) ss += x[e] * x[e];
        ss += __shfl_xor(ss, 1); ss += __shfl_xor(ss, 2); ss += __shfl_xor(ss, 4); ss += __shfl_xor(ss, 8);
        const float rstd = rsqrtf(ss * (1.0f / 128.0f) + NORM_EPS) * (hs < 8 ? 0.088388347648318440f * 1.4426950408889634f : 1.0f);
        const f32x4 w0 = *(const f32x4*)wn, w1 = *(const f32x4*)(wn + 4);
        const float wv[8] = {w0.x, w0.y, w0.z, w0.w, w1.x, w1.y, w1.z, w1.w};
        const int row = t >> 6, col = t & 63;
        const float* cs = tab + 2 * (li < 8 ? (row * 32 + 4 * li) : ((256 + col) * 32 + 4 * (li - 8)));
        const f32x4 c0 = *(const f32x4*)cs, c1 = *(const f32x4*)(cs + 4);
        const float cv[4] = {c0.x, c0.z, c1.x, c1.z}, sv[4] = {c0.y, c0.w, c1.y, c1.w};
        float r8[8];
#pragma unroll
        for (int e = 0; e < 4; ++e) { const float y0 = x[2 * e] * rstd * wv[2 * e], y1 = x[2 * e + 1] * rstd * wv[2 * e + 1];
            r8[2 * e] = y0 * cv[e] - y1 * sv[e]; r8[2 * e + 1] = y0 * sv[e] + y1 * cv[e]; }
        int pw0 = 0, pw1 = 0;
        pw0 = __builtin_amdgcn_cvt_pk_fp8_f32(r8[0], r8[1], pw0, false); pw0 = __builtin_amdgcn_cvt_pk_fp8_f32(r8[2], r8[3], pw0, true);
        pw1 = __builtin_amdgcn_cvt_pk_fp8_f32(r8[4], r8[5], pw1, false); pw1 = __builtin_amdgcn_cvt_pk_fp8_f32(r8[6], r8[7], pw1, true);
        unsigned char* d8 = (hs < 8 ? Q8 + (size_t)t * 1024 + hs * 128 : K8 + (size_t)t * 256 + (hs - 8) * 128) + 8 * li;
        v2u o8; o8.x = (unsigned)pw0; o8.y = (unsigned)pw1; *(v2u*)d8 = o8;
    }
}

#define XB_TMO      128
#define XB_XCNT(j)  (256  + 64 * (j))
#define XB_XSUB(j)  (1280 + 64 * (j))
#define XB_XGEN(j)  (2304 + 64 * (j))
#define XB_TOP      3328
#define XB_TOPGEN   3392
#define XCD_BAR_WORDS 3456
#define XB_SPIN_CAP (1u << 18)

__device__ __forceinline__ unsigned xb_ld(unsigned* p)              { return __hip_atomic_load(p, __ATOMIC_RELAXED, __HIP_MEMORY_SCOPE_AGENT); }
__device__ __forceinline__ unsigned xb_add(unsigned* p, unsigned v) { return __hip_atomic_fetch_add(p, v, __ATOMIC_RELAXED, __HIP_MEMORY_SCOPE_AGENT); }
__device__ __forceinline__ unsigned xb_xcc_id() { return (unsigned)__builtin_amdgcn_s_getreg((3 << 11) | 20) & 0xFu; }
#define XB_SPIN(cond, bar) do { unsigned _sp = 0; while (cond) { __builtin_amdgcn_s_sleep(1); \
    if ((++_sp & 255u) == 0u) { if (xb_ld(&(bar)[XB_TMO])) break; if (_sp > XB_SPIN_CAP) { atomicAdd(&(bar)[XB_TMO], 1u); break; } } } } while (0)

struct XcdBarrier {
    unsigned* bar; unsigned x;
    volatile LAS unsigned* st;
};

__device__ __forceinline__ XcdBarrier xcd_barrier_post(unsigned* bar, volatile LAS unsigned* st) {
    XcdBarrier b; b.bar = bar; b.x = xb_xcc_id(); b.st = st;
    if (threadIdx.x == 0) st[2] = xb_add(&bar[XB_XCNT(b.x)], 1u);
    return b;
}
__device__ __forceinline__ void xcd_barrier_complete(unsigned* bar, unsigned x, unsigned& nloc, unsigned& nx) {
    const unsigned G = gridDim.x * gridDim.y * gridDim.z;
    unsigned sum, cnt, mine, sp = 0u;
    for (;;) {
        sum = 0u; cnt = 0u; mine = 0u;
#pragma unroll
        for (unsigned j = 0; j < 16; ++j) { const unsigned c = xb_ld(&bar[XB_XCNT(j)]); sum += c; cnt += (c > 0u) ? 1u : 0u; mine = (j == x) ? c : mine; }
        if (sum == G) break;
        __builtin_amdgcn_s_sleep(1);
        if ((++sp & 255u) == 0u) { if (xb_ld(&bar[XB_TMO])) break; if (sp > XB_SPIN_CAP) { atomicAdd(&bar[XB_TMO], 1u); break; } }
    }
    nloc = mine > 0u ? mine : 1u; nx = cnt > 0u ? cnt : 1u;
}

__device__ __forceinline__ void xcd_barrier(const XcdBarrier& b, int tid_) {
    asm volatile("s_waitcnt vmcnt(0)" ::: "memory");
    __syncthreads();
    if (tid_ == 0) {
        unsigned* bar = b.bar;
        __builtin_amdgcn_s_waitcnt(0);
        unsigned nloc = b.st[0], nx = b.st[1];
        if (nloc == 0u) { xcd_barrier_complete(bar, b.x, nloc, nx); b.st[0] = nloc; b.st[1] = nx; }
        const unsigned old = xb_add(&bar[XB_XSUB(b.x)], 1u);
        const unsigned gen = old / nloc;
        if (old + 1u == (gen + 1u) * nloc) {
            __builtin_amdgcn_fence(__ATOMIC_RELEASE, "agent");
            asm volatile("s_waitcnt vmcnt(0)" ::: "memory");
            const unsigned og = xb_add(&bar[XB_TOP], 1u);
            const unsigned tg = og / nx;
            if (og + 1u == (tg + 1u) * nx) xb_add(&bar[XB_TOPGEN], 1u);
            else XB_SPIN(xb_ld(&bar[XB_TOPGEN]) == tg, bar);
            __builtin_amdgcn_fence(__ATOMIC_ACQUIRE, "agent");
            xb_add(&bar[XB_XGEN(b.x)], 1u);
            asm volatile("s_waitcnt vmcnt(0)" ::: "memory");
        } else {
            XB_SPIN(xb_ld(&bar[XB_XGEN(b.x)]) == gen, bar);
            __builtin_amdgcn_fence(__ATOMIC_ACQUIRE, "agent");
            asm volatile("s_waitcnt vmcnt(0)" ::: "memory");
        }
    }
    __syncthreads();
}
#define XB_LSUB(j) (3456 + 16 * (j))
#define XB_LGEN(j) (3712 + 16 * (j))
__device__ __forceinline__ void xcd_barrier_local(const XcdBarrier& b, int tid_) {
    asm volatile("s_waitcnt vmcnt(0)" ::: "memory");
    __syncthreads();
    if (tid_ == 0) {
        unsigned* bar = b.bar;
        __builtin_amdgcn_s_waitcnt(0);
        const unsigned nloc = b.st[0];
        const unsigned old = xb_add(&bar[XB_LSUB(b.x)], 1u);
        const unsigned gen = old / nloc;
        if (old + 1u == (gen + 1u) * nloc) xb_add(&bar[XB_LGEN(b.x)], 1u);
        else XB_SPIN(xb_ld(&bar[XB_LGEN(b.x)]) == gen, bar);
        __builtin_amdgcn_fence(__ATOMIC_ACQUIRE, "agent");
        asm volatile("s_waitcnt vmcnt(0)" ::: "memory");
    }
    __syncthreads();
}
__device__ __forceinline__ void v8t_item(const bf16_t* __restrict__ KVA, unsigned char* __restrict__ V8T, int item, LAS unsigned char* scr, int lane) {
    const int kvh = item >> 8, T = item & 255;
    const bf16_t* src = KVA + (size_t)(64 * T) * PKV + 256 + kvh * 128;
#pragma unroll 4
    for (int i = 0; i < 16; ++i) { const int key = 4 * i + (lane >> 4), c0 = 8 * (lane & 15);
        const v4u raw = *(const v4u*)(src + (size_t)key * PKV + c0);
        int w0 = 0, w1 = 0;
        w0 = __builtin_amdgcn_cvt_pk_fp8_f32(__uint_as_float(raw.x << 16), __uint_as_float(raw.x & 0xffff0000u), w0, false); w0 = __builtin_amdgcn_cvt_pk_fp8_f32(__uint_as_float(raw.y << 16), __uint_as_float(raw.y & 0xffff0000u), w0, true);
        w1 = __builtin_amdgcn_cvt_pk_fp8_f32(__uint_as_float(raw.z << 16), __uint_as_float(raw.z & 0xffff0000u), w1, false); w1 = __builtin_amdgcn_cvt_pk_fp8_f32(__uint_as_float(raw.w << 16), __uint_as_float(raw.w & 0xffff0000u), w1, true);
        const int kq = key & 31, pos = 32 * ((kq >> 2) & 1) + 16 * (key >> 5) + (kq & 3) + 4 * (kq >> 3);
        LAS unsigned char* d = scr + c0 * 68 + pos;
        d[0 * 68] = (unsigned char)(w0); d[1 * 68] = (unsigned char)(w0 >> 8); d[2 * 68] = (unsigned char)(w0 >> 16); d[3 * 68] = (unsigned char)(w0 >> 24);
        d[4 * 68] = (unsigned char)(w1); d[5 * 68] = (unsigned char)(w1 >> 8); d[6 * 68] = (unsigned char)(w1 >> 16); d[7 * 68] = (unsigned char)(w1 >> 24); }
    asm volatile("s_waitcnt lgkmcnt(0)" ::: "memory");
#pragma unroll
    for (int i = 0; i < 8; ++i) { const int idx = lane + 64 * i, col = idx >> 2, ch = idx & 3; const LAS unsigned* s4 = (const LAS unsigned*)(scr + col * 68 + ch * 16);
        v4u w; w.x = s4[0]; w.y = s4[1]; w.z = s4[2]; w.w = s4[3];
        *(v4u*)(V8T + (size_t)(kvh * 128 + col) * 16384 + 64 * T + ch * 16) = w; }
    asm volatile("s_waitcnt lgkmcnt(0)" ::: "memory");
}
struct Args { const float* in[17]; float* out; unsigned char* ws; int ph_lo, ph_hi; };
__global__ void __launch_bounds__(512) fwd(Args args) {
    extern __shared__ __attribute__((aligned(16))) unsigned char lds[];
    cg::grid_group grid = cg::this_grid();
    const int tid0 = threadIdx.x;
    const int G0 = gridDim.x, bx0 = blockIdx.x;
    const int lo = args.ph_lo, hi = args.ph_hi;
    const int wave0 = __builtin_amdgcn_readfirstlane(tid0 >> 6);
    if (hi > 1000) grid.sync();
    volatile LAS unsigned* bst = (volatile LAS unsigned*)((LAS unsigned char*)lds + LDS_MISC);
    if (tid0 < 4) bst[tid0] = tid0 == 3 ? 0xFFFFFFFFu : 0u;
    __syncthreads();
    const XcdBarrier bar = xcd_barrier_post((unsigned*)(args.ws + WS_BAR), bst);
#ifndef PHASE_MASK
#define PHASE_MASK 0x7ff
#endif
#define IN(k) (((PHASE_MASK >> (k)) & 1) && lo <= (k) && (k) < hi)
#define SEAM(k) do { if (IN(k) && IN((k) + 1)) { const int t_ = wave0 * 64 + (int)__builtin_amdgcn_mbcnt_hi(~0u, __builtin_amdgcn_mbcnt_lo(~0u, 0u)); xcd_barrier(bar, t_); } } while (0)
#define SEAML(k) do { if (IN(k) && IN((k) + 1)) { const int t_ = wave0 * 64 + (int)__builtin_amdgcn_mbcnt_hi(~0u, __builtin_amdgcn_mbcnt_lo(~0u, 0u)); if (bst[3] != 0xFFFFFFFFu) xcd_barrier_local(bar, t_); else xcd_barrier(bar, t_); } } while (0)
    typedef const __attribute__((address_space(4))) Args* ArgP;
#define ARGP() ({ ArgP p_ = (ArgP)__builtin_amdgcn_kernarg_segment_ptr(); asm volatile("" : "+s"(p_)); p_; })
#define WSP(off, T) ((T*)(A->ws + (off)))
#define OPQ() int G = G0, bx = bx0; asm volatile("" : "+s"(G), "+s"(bx)); int tid = wave0 * 64 + (int)__builtin_amdgcn_mbcnt_hi(~0u, __builtin_amdgcn_mbcnt_lo(~0u, 0u)); asm volatile("" : "+v"(tid)); const int lane = tid & 63, wave = __builtin_amdgcn_readfirstlane(tid >> 6), gw = bx * 8 + wave, NGW = G * 8; (void)gw; (void)NGW; (void)lane; const unsigned vm_ = bst[3]; const bool g8_ = (G & 7) == 0; const int vbx = (vm_ != 0xFFFFFFFFu) ? (int)__builtin_amdgcn_readfirstlane(vm_) : bx; const int cls = vbx & 7, rnk = vbx >> 3; (void)cls; (void)rnk; const int rw0 = g8_ ? cls * (SEQ / 8) + rnk * 8 + wave : gw, rws = g8_ ? G : NGW, rwe = g8_ ? (cls + 1) * (SEQ / 8) : SEQ; (void)rw0; (void)rws; (void)rwe

    if (IN(0)) { ArgP A = ARGP(); OPQ();
        const float* cvec = A->in[1]; const float* w_ada = A->in[2]; const float* b_ada = A->in[3]; const float* w_in = A->in[5]; const float* w_oa = A->in[9]; const float* w_ob = A->in[10];
        const float* w_out = A->in[11]; const float* w_g = A->in[13]; const float* w_u = A->in[14]; const float* w_d = A->in[15]; float* mod = WSP(WS_MOD, float); float* tab = WSP(WS_ROPE, float);
        bf16_t* WinT = WSP(WS_WIN, bf16_t); bf16_t* WoT = WSP(WS_WO, bf16_t); bf16_t* WoutT = WSP(WS_WOUT, bf16_t); bf16_t* WguT = WSP(WS_WGU, bf16_t); bf16_t* WdT = WSP(WS_WD, bf16_t);
        LAS float* scr = (LAS float*)((LAS unsigned char*)lds + wave * 16384);
        constexpr int I_GEMV = 32 * 48, I_IN = (DM / 64) * (DIN / 32), I_OA = (1024 / 64) * (DM / 32), I_OUT = (DM / 64) * (DM / 32), I_G = (DM / 64) * (DFF / 32), I_D = (DFF / 64) * (DM / 32);
        constexpr int NITEMS = I_GEMV + I_IN + 2 * I_OA + I_OUT + I_D;
        for (int it = gw; it < NITEMS; it += NGW) {
            int r = it;
            if (r < I_GEMV) { gemv_item(cvec, w_ada, b_ada, mod, r, lane); continue; } r -= I_GEMV;
            if (r < I_IN) { transpose_item(w_in, DIN, WinT, PH, 0, 0, scr, r, lane); continue; } r -= I_IN;
            if (r < I_OA) { transpose_item(w_oa, DM, WoT, PH, 0, 0, scr, r, lane); continue; } r -= I_OA;
            if (r < I_OA) { transpose_item(w_ob, DM, WoT, PH, 1024, 0, scr, r, lane); continue; } r -= I_OA;
            if (r < I_OUT) { transpose_item(w_out, DM, WoutT, PH, 0, 0, scr, r, lane); continue; } r -= I_OUT;
            transpose_item(w_d, DM, WdT, PA, 0, 0, scr, r, lane);
        }
        for (int e = bx * 512 + tid; e < 320 * 32; e += G * 512) { const int pos = e >> 5, j = e & 31; const float p = (float)(pos < 256 ? pos : pos - 256);
            const float inv = powf(10000.0f, -(float)(2 * j) / 64.0f); const float ang = p * inv; tab[2 * e] = cosf(ang); tab[2 * e + 1] = sinf(ang);
        }
    }
    SEAM(0);
    if (IN(0) && IN(1)) {
        const int t_ = wave0 * 64 + (int)__builtin_amdgcn_mbcnt_hi(~0u, __builtin_amdgcn_mbcnt_lo(~0u, 0u));
        if (t_ == 0) { unsigned nx_ = 0u, below_ = 0u, ok_ = ((G0 & 7) == 0) ? 1u : 0u; const unsigned per_ = (unsigned)G0 >> 3;
#pragma unroll
            for (unsigned j_ = 0; j_ < 16; ++j_) { const unsigned c_ = xb_ld(&bar.bar[XB_XCNT(j_)]); if (c_) { ++nx_; if (c_ != per_) ok_ = 0u; if (j_ < bar.x) ++below_; } }
            const unsigned rk_ = bst[2];
            bst[3] = (ok_ && nx_ == 8u && rk_ < per_) ? (rk_ * 8u + below_) : 0xFFFFFFFFu; }
        __syncthreads();
    }
    if (IN(1)) { ArgP A = ARGP(); OPQ(); float* mod = WSP(WS_MOD, float); normmod_rows(A->in[0], A->in[4], mod + 2048, mod + 0, WSP(WS_H, bf16_t), rw0, rws, rwe, lane); }
    SEAML(1);
    if (IN(2)) { ArgP A = ARGP(); OPQ();
        pg8::Gemm g{WSP(WS_H, bf16_t), WSP(WS_WIN, bf16_t), SEQ, DIN, DM, PH}; pg8::StaticOrder S; S.init(SEQ, DIN, G, vbx);
        pg8::EpiProj E{WSP(WS_QAB, bf16_t), WSP(WS_KVA, bf16_t), WSP(WS_KB, bf16_t), WSP(WS_VB, bf16_t), WSP(WS_GA, bf16_t), WSP(WS_GB, bf16_t)};
        pg8::gemm_phase<pg8::EpiProj, pg8::StaticOrder, GEMM_ALIGN, GEMM_SP2, false>((LAS unsigned char*)lds, g, S, E, tid);
        {
            const int first = S.nwg % G;
            if (vbx >= first) {
                constexpr int I_G2 = (DM / 64) * (DFF / 32);
                LAS float* scr = (LAS float*)((LAS unsigned char*)lds + wave * 16384);
                const float* w_g = A->in[13]; const float* w_u = A->in[14]; bf16_t* WguT = WSP(WS_WGU, bf16_t);
                for (int it = (vbx - first) * 8 + wave; it < 2 * I_G2; it += (G - first) * 8) {
                    if (it < I_G2) transpose_item(w_g, DFF, WguT, PH, 0, 1, scr, it, lane); else transpose_item(w_u, DFF, WguT, PH, 0, 2, scr, it - I_G2, lane);
                }
            }
        }
    }
    SEAM(2);
    if (IN(3)) { ArgP A = ARGP(); OPQ();
        if ((wave & 3) == 0) { LAS unsigned char* scr = (LAS unsigned char*)lds + wave * 16384; if (g8_) { for (int tt = rnk; tt < 32; tt += (G >> 3)) v8t_item(WSP(WS_KVA, bf16_t), WSP(WS_V8T, unsigned char), (wave >> 2) * 256 + cls * 32 + tt, scr, lane); }
            else for (int it = bx * 2 + (wave >> 2); it < 512; it += G * 2) v8t_item(WSP(WS_KVA, bf16_t), WSP(WS_V8T, unsigned char), it, scr, lane); }
        qknorm_rope(WSP(WS_QAB, bf16_t), WSP(WS_KVA, bf16_t), WSP(WS_Q8, unsigned char), WSP(WS_K8, unsigned char), A->in[6], A->in[7], WSP(WS_ROPE, float), g8_ ? cls * (SEQ / 8) * 10 + (rnk * 8 + wave) * 4 : gw * 4, g8_ ? G * 4 : NGW * 4, g8_ ? (cls + 1) * (SEQ / 8) * 10 : SEQ * 10, lane); }
    SEAM(3);
    if (IN(4)) { ArgP A = ARGP(); OPQ();
        using abf = att::bf16; bf16_t* QAB = WSP(WS_QAB, bf16_t); bf16_t* KVA = WSP(WS_KVA, bf16_t); bf16_t* KB = WSP(WS_KB, bf16_t); bf16_t* VB = WSP(WS_VB, bf16_t); const float* rpb = A->in[8];
        for (int u = bx; u < 512; u += G) { const int h = u >> 6, qb = u & 63, kvh = h >> 2;
            att::attn_unit_g8<1024, 256, 16384, PH>(WSP(WS_Q8, unsigned char) + (size_t)qb * 256 * 1024 + h * 128, WSP(WS_K8, unsigned char) + kvh * 128, WSP(WS_V8T, unsigned char) + (size_t)kvh * 128 * 16384,
                                                    (abf*)QAB + (size_t)qb * 256 * PH + h * 128, SEQ / 64, (char*)lds, A->in[6], A->in[7], tid);
        }
        for (int v = bx; v < 512; v += G) { const int h = v >> 6, qb = v & 63; int r_lo = 4 * qb - 4; r_lo = r_lo < 0 ? 0 : (r_lo > 244 ? 244 : r_lo);
            att::attn_unit<PH, PNB, PH, true, 1, 0>((const abf*)QAB + (size_t)qb * 256 * PH + 1024 + h * 128, (const abf*)KB + (size_t)r_lo * 64 * PNB + h * 128, (const abf*)VB + (size_t)r_lo * 64 * PNB + h * 128,
                                                   (abf*)QAB + (size_t)qb * 256 * PH + 1024 + h * 128, 12, (char*)lds, rpb + h * 15 * 31, nullptr, 4 * qb, r_lo, tid);
        }
        __syncthreads();
    }
    SEAM(4);
    if (IN(5)) { ArgP A = ARGP(); OPQ();
        pg8::Gemm g{WSP(WS_QAB, bf16_t), WSP(WS_WO, bf16_t), SEQ, DM, DM, PH}; pg8::StaticOrder S; S.init(SEQ, DM, G, vbx);
        pg8::EpiMerged E{WSP(WS_GA, bf16_t), WSP(WS_GB, bf16_t), WSP(WS_H, bf16_t)};
        pg8::gemm_phase<pg8::EpiMerged, pg8::StaticOrder, GEMM_ALIGN, GEMM_SP2, true>((LAS unsigned char*)lds, g, S, E, tid);
    }
    SEAML(5);
    if (IN(6)) { ArgP A = ARGP(); OPQ();
        pg8::Gemm g{WSP(WS_H, bf16_t), WSP(WS_WOUT, bf16_t), SEQ, DM, DM, PH}; pg8::StaticOrder S; S.init(SEQ, DM, G, vbx);
        pg8::EpiDelta E{WSP(WS_GB, bf16_t), WSP(WS_MOD, float) + 4096};
        pg8::gemm_phase<pg8::EpiDelta, pg8::StaticOrder, GEMM_ALIGN, GEMM_SP2, false>((LAS unsigned char*)lds, g, S, E, tid);
    }
    SEAML(6);
    if (IN(7)) { ArgP A = ARGP(); OPQ(); float* mod = WSP(WS_MOD, float); normmod_rows_d(A->in[0], WSP(WS_GB, bf16_t), A->in[12], mod + 8192, mod + 6144, WSP(WS_H, bf16_t), rw0, rws, rwe, lane); }
    SEAM(7);
    if (IN(8)) { ArgP A = ARGP(); OPQ();
        pg8::Gemm g{WSP(WS_H, bf16_t), WSP(WS_WGU, bf16_t), SEQ, 2 * DFF, DM, PH}; pg8::StaticOrder S; S.init(SEQ, 2 * DFF, G, vbx);
        pg8::EpiSwiglu E{WSP(WS_ACT, bf16_t)};
        pg8::gemm_phase<pg8::EpiSwiglu, pg8::StaticOrder, GEMM_ALIGN, GEMM_SP2, false>((LAS unsigned char*)lds, g, S, E, tid);
    }
    SEAML(8);
    if (IN(9)) { ArgP A = ARGP(); OPQ();
        pg8::Gemm g{WSP(WS_ACT, bf16_t), WSP(WS_WD, bf16_t), SEQ, DM, DFF, PA}; pg8::StaticOrder S; S.init(SEQ, DM, G, vbx);
        pg8::EpiDelta E{WSP(WS_H, bf16_t), WSP(WS_MOD, float) + 10240};
        pg8::gemm_phase<pg8::EpiDelta, pg8::StaticOrder, GEMM_ALIGN, GEMM_SP2, false>((LAS unsigned char*)lds, g, S, E, tid);
    }
    SEAML(9);
    if (IN(10)) { ArgP A = ARGP(); OPQ(); final_rows_d(A->in[0], WSP(WS_GB, bf16_t), WSP(WS_H, bf16_t), A->out, A->in[16], rw0, rws, rwe, lane); }
#undef IN
#undef SEAM
}

#ifndef N_LAUNCHES
#define N_LAUNCHES 1
#endif
extern "C" void kernel_launch(void* const* d_in, const int* in_sizes, int n_in, void* d_out, int out_size, void* d_ws, size_t ws_size, hipStream_t stream) {
    static int grid = 0;
    if (grid == 0) {
        if (n_in != 17 || in_sizes[0] != SEQ * DM || out_size != SEQ * DM || ws_size < WS_END) { fprintf(stderr, "kernel_launch: unexpected shapes: n_in %d in0 %d out %d ws %zu (need %zu)\n", n_in, n_in > 0 ? in_sizes[0] : -1, out_size, ws_size, (size_t)WS_END); grid = -1; return; }
        int dev = 0, cus = 0, per_cu = 0;
        if (hipGetDevice(&dev) != hipSuccess || hipDeviceGetAttribute(&cus, hipDeviceAttributeMultiprocessorCount, dev) != hipSuccess) { fprintf(stderr, "kernel_launch: device query failed\n"); grid = -1; return; }
        if (hipFuncSetAttribute((const void*)fwd, hipFuncAttributeMaxDynamicSharedMemorySize, LDS_BYTES) != hipSuccess) { fprintf(stderr, "kernel_launch: hipFuncSetAttribute failed\n"); grid = -1; return; }
        if (hipOccupancyMaxActiveBlocksPerMultiprocessor(&per_cu, (const void*)fwd, 512, LDS_BYTES) != hipSuccess || per_cu < 1) { fprintf(stderr, "kernel_launch: occupancy query says %d\n", per_cu); per_cu = 1; }
        (void)hipGetLastError();
        grid = cus * per_cu;
        fprintf(stderr, "kernel_launch: grid %d (cus %d x %d)\n", grid, cus, per_cu);
    }
    if (grid < 0) return;
    if (hipMemsetAsync((char*)d_ws + WS_MOD, 0, CTL_ZERO_BYTES, stream) != hipSuccess) { fprintf(stderr, "kernel_launch: memset failed\n"); return; }
    Args a{};
    for (int i = 0; i < 17; ++i) a.in[i] = (const float*)d_in[i];
    a.out = (float*)d_out; a.ws = (unsigned char*)d_ws;
    if (N_LAUNCHES == 1) {
        a.ph_lo = 0; a.ph_hi = NPHASE;
        void* kargs[] = {&a};
        const hipError_t e = hipLaunchCooperativeKernel((const void*)fwd, dim3(grid), dim3(512), kargs, LDS_BYTES, stream);
        if (e != hipSuccess) fprintf(stderr, "kernel_launch: cooperative launch failed: %s (grid %d)\n", hipGetErrorString(e), grid);
    } else {
        for (int p = 0; p < NPHASE; ++p) { a.ph_lo = p; a.ph_hi = p + 1;
            hipLaunchKernelGGL(fwd, dim3(grid), dim3(512), LDS_BYTES, stream, a);
            const hipError_t le = hipPeekAtLastError();
            if (le != hipSuccess) { fprintf(stderr, "kernel_launch: launch %d failed: %s\n", p, hipGetErrorName(le)); break; } }
    }
}
```

```cpp
#include <hip/hip_runtime.h>
#include <hip/hip_bf16.h>
#include <hip/hip_cooperative_groups.h>
#include <cstdio>
#include <cstdint>
#include <cmath>
#define N_LAUNCHES 1
namespace pg8 {
#define PG8_LAS __attribute__((address_space(3)))
typedef unsigned short bf16_t;
typedef short bf16x8 __attribute__((ext_vector_type(8)));
typedef float f32x4 __attribute__((ext_vector_type(4)));
typedef unsigned u32x4 __attribute__((ext_vector_type(4)));
constexpr int BM = 256, BK = 64, HALF = 128, HTB = HALF * BK * 2  , STAGE_BYTES = 8 * HTB, NXCD = 8, WGM = 4;

__host__ __device__ __forceinline__ int lds_byte(int r, int c) { const int st = (r >> 4) * 2 + (c >> 5), rr = r & 15, cc = c & 31, ob = rr * 64 + cc * 2; return st * 1024 + (ob ^ (((ob >> 9) & 1) << 5)); }
__host__ __device__ __forceinline__ void stage_rc(int b, int& R, int& C) { const int st = b / 1024, sb = b % 1024, swz = sb ^ (((sb >> 9) & 1) << 5); R = (st >> 1) * 16 + swz / 64; C = (st & 1) * 32 + (swz % 64) / 2; }
__host__ __device__ __forceinline__ int perm32(int rho) { const int n = rho >> 4, i = rho & 15; return 8 * (i >> 2) + 4 * n + (i & 3); }

struct Unit { int pm, pn; };
struct Gemm { const bf16_t* A; const bf16_t* Bt; int M, N, K, ld; };

struct StaticOrder {
    int nM, nN, nwg, G, c;
    __host__ __device__ void init(int M, int N, int G_, int c_) { nM = M / BM; nN = N / BM; nwg = nM * nN; G = G_; c = c_; }
    __host__ __device__ bool next(int i, Unit& u) const {
        const long L = (long)i * G + c; if (L >= nwg) return false;
        int wgid = (int)L; { const int q = nwg / NXCD, r = nwg % NXCD, xcd = wgid % NXCD, off = wgid / NXCD; wgid = (xcd < r ? xcd * (q + 1) : r * (q + 1) + (xcd - r) * q) + off; }
        const int nig = WGM * nN, gid = wgid / nig, fm = gid * WGM, gsz = (nM - fm) < WGM ? (nM - fm) : WGM;
        u.pm = fm + ((wgid % nig) % gsz); u.pn = ((wgid % nig) / gsz + (c & 7) * (nN >> 3)) % nN; return true;
    }
    __device__ __forceinline__ void a_ready(const Unit&) const {}
    __device__ __forceinline__ void done(const Unit&) const {}
};

__device__ __forceinline__ unsigned cvt_pk_bf16(float lo, float hi) { unsigned r; asm volatile("v_cvt_pk_bf16_f32 %0, %1, %2" : "=v"(r) : "v"(lo), "v"(hi)); return r; }
constexpr int PH = 2176  , PA = 5760  , PKV = 640  , PNB = 1152  ;
__device__ __forceinline__ float bflo(unsigned w) { return __uint_as_float(w << 16); }
__device__ __forceinline__ float bfhi(unsigned w) { return __uint_as_float(w & 0xffff0000u); }
struct EpiProj {
    static constexpr bool PERM = true, AFTER_DRAIN = false;
    bf16_t *QAB, *KVA, *KB, *VB, *GA, *GB;
    __device__ __forceinline__ void operator()(const f32x4 (&acc)[2][2][4][2], const Unit& u, int wr, int wc, int fr, int fq) const {
        const int pn = u.pn; bf16_t* base; int ldc, colt;
        if (pn < 4) { base = QAB; ldc = PH; colt = pn * 256; }
        else if (pn < 6) { base = KVA; ldc = PKV; colt = (pn - 4) * 256; }
        else if (pn < 10) { base = QAB; ldc = PH; colt = 1024 + (pn - 6) * 256; }
        else if (pn < 14) { base = KB; ldc = PNB; colt = (pn - 10) * 256; }
        else if (pn < 18) { base = VB; ldc = PNB; colt = (pn - 14) * 256; }
        else if (pn < 26) { base = GA; ldc = PH; colt = (pn - 18) * 256; }
        else { base = GB; ldc = PH; colt = (pn - 26) * 256; }
        const int row0 = u.pm * BM + wr * 64 + fr, col0 = colt + wc * 32 + 8 * fq;
#pragma unroll
        for (int ai = 0; ai < 2; ++ai)
#pragma unroll
            for (int m = 0; m < 4; ++m) { bf16_t* rowp = base + (size_t)(row0 + ai * HALF + m * 16) * ldc + col0;
#pragma unroll
                for (int bj = 0; bj < 2; ++bj) { const f32x4 v0 = acc[ai][bj][m][0], v1 = acc[ai][bj][m][1];
                    u32x4 w; w.x = cvt_pk_bf16(v0[0], v0[1]); w.y = cvt_pk_bf16(v0[2], v0[3]); w.z = cvt_pk_bf16(v1[0], v1[1]); w.w = cvt_pk_bf16(v1[2], v1[3]);
                    *(u32x4*)(rowp + bj * HALF) = w; } }
    }
};
struct EpiMerged {
    static constexpr bool PERM = true, AFTER_DRAIN = false;
    const bf16_t *GA, *GB; bf16_t* O;
    __device__ __forceinline__ void mid(f32x4 (&acc)[2][2][4][2], const Unit& u, int wr, int wc, int fr, int fq) const {
        int row0 = u.pm * BM + wr * 64 + fr; const int col0 = u.pn * BM + wc * 32 + 8 * fq;
        asm volatile("" : "+v"(row0));
#pragma unroll
        for (int ai = 0; ai < 2; ++ai)
#pragma unroll
            for (int m = 0; m < 4; ++m)
#pragma unroll
                for (int bj = 0; bj < 2; ++bj) { const size_t off = (size_t)(row0 + ai * HALF + m * 16) * PH + col0 + bj * HALF;
                    const u32x4 a = *(const u32x4*)(GA + off), b = *(const u32x4*)(GB + off);
#pragma unroll
                    for (int e = 0; e < 4; ++e) { const float ga0 = bflo(a[e]), ga1 = bfhi(a[e]), gb0 = bflo(b[e]), gb1 = bfhi(b[e]);
                        const float r0 = (1.f + __expf(-gb0)) * __builtin_amdgcn_rcpf(1.f + __expf(-ga0)), r1 = (1.f + __expf(-gb1)) * __builtin_amdgcn_rcpf(1.f + __expf(-ga1));
                        acc[ai][bj][m][e >> 1][(e & 1) * 2] *= r0; acc[ai][bj][m][e >> 1][(e & 1) * 2 + 1] *= r1; }
                    if (bj == 1 && (m & 1)) asm volatile("" ::: "memory"); }
    }
    __device__ __forceinline__ void operator()(const f32x4 (&acc)[2][2][4][2], const Unit& u, int wr, int wc, int fr, int fq) const {
        const int row0 = u.pm * BM + wr * 64 + fr, col0 = u.pn * BM + wc * 32 + 8 * fq;
#pragma unroll
        for (int ai = 0; ai < 2; ++ai)
#pragma unroll
            for (int m = 0; m < 4; ++m)
#pragma unroll
                for (int bj = 0; bj < 2; ++bj) { const size_t off = (size_t)(row0 + ai * HALF + m * 16) * PH + col0 + bj * HALF;
                    const u32x4 b = *(const u32x4*)(GB + off); float o[8];
#pragma unroll
                    for (int e = 0; e < 4; ++e) { const float gb0 = bflo(b[e]), gb1 = bfhi(b[e]);
                        o[2 * e] = acc[ai][bj][m][e >> 1][(e & 1) * 2] * __builtin_amdgcn_rcpf(1.f + __expf(-gb0)); o[2 * e + 1] = acc[ai][bj][m][e >> 1][(e & 1) * 2 + 1] * __builtin_amdgcn_rcpf(1.f + __expf(-gb1)); }
                    u32x4 w; w.x = cvt_pk_bf16(o[0], o[1]); w.y = cvt_pk_bf16(o[2], o[3]); w.z = cvt_pk_bf16(o[4], o[5]); w.w = cvt_pk_bf16(o[6], o[7]);
                    *(u32x4*)(O + off) = w; }
    }
};
struct EpiResid {
    static constexpr bool PERM = false, AFTER_DRAIN = false;
    const float* base; float* out; const float* g;
    __device__ __forceinline__ void operator()(const f32x4 (&acc)[2][2][4][2], const Unit& u, int wr, int wc, int fr, int fq) const {
        const int row0 = u.pm * BM + wr * 64 + fr, col0 = u.pn * BM + wc * 32 + 4 * fq;
        f32x4 gv[2][2];
#pragma unroll
        for (int bj = 0; bj < 2; ++bj)
#pragma unroll
            for (int n = 0; n < 2; ++n) gv[bj][n] = *(const f32x4*)(g + col0 + bj * HALF + n * 16);
#pragma unroll
        for (int ai = 0; ai < 2; ++ai)
#pragma unroll
            for (int m = 0; m < 4; ++m) { const size_t off = (size_t)(row0 + ai * HALF + m * 16) * 2048 + col0;
#pragma unroll
                for (int bj = 0; bj < 2; ++bj)
#pragma unroll
                    for (int n = 0; n < 2; ++n) { const f32x4 bs = *(const f32x4*)(base + off + bj * HALF + n * 16);
                        *(f32x4*)(out + off + bj * HALF + n * 16) = bs + gv[bj][n] * acc[ai][bj][m][n]; } }
    }
};
struct EpiSwiglu {
    static constexpr bool PERM = true, AFTER_DRAIN = false;
    bf16_t* O;
    __device__ __forceinline__ void operator()(const f32x4 (&acc)[2][2][4][2], const Unit& u, int wr, int wc, int fr, int fq) const {
        const int row0 = u.pm * BM + wr * 64 + fr, col0 = u.pn * HALF + wc * 32 + 8 * fq;
#pragma unroll
        for (int ai = 0; ai < 2; ++ai)
#pragma unroll
            for (int m = 0; m < 4; ++m) { float o[8];
#pragma unroll
                for (int n = 0; n < 2; ++n)
#pragma unroll
                    for (int e = 0; e < 4; ++e) { const float gt = acc[ai][0][m][n][e], up = acc[ai][1][m][n][e]; o[4 * n + e] = gt * up * __builtin_amdgcn_rcpf(1.f + __expf(-gt)); }
                u32x4 w; w.x = cvt_pk_bf16(o[0], o[1]); w.y = cvt_pk_bf16(o[2], o[3]); w.z = cvt_pk_bf16(o[4], o[5]); w.w = cvt_pk_bf16(o[6], o[7]);
                *(u32x4*)(O + (size_t)(row0 + ai * HALF + m * 16) * PA + col0) = w; }
    }
};

struct EpiNull {
    static constexpr bool PERM = false, AFTER_DRAIN = false;
    float* out;
    __device__ __forceinline__ void operator()(const f32x4 (&acc)[2][2][4][2], const Unit& u, int wr, int wc, int fr, int fq) const {
        f32x4 s = {0.f, 0.f, 0.f, 0.f};
#pragma unroll
        for (int ai = 0; ai < 2; ++ai)
#pragma unroll
            for (int bj = 0; bj < 2; ++bj)
#pragma unroll
                for (int m = 0; m < 4; ++m)
#pragma unroll
                    for (int n = 0; n < 2; ++n) s += acc[ai][bj][m][n];
        if (s[0] + s[1] + s[2] + s[3] == 123456.789f) out[u.pm] = 1.f;
    }
};

struct EpiDelta {
    static constexpr bool PERM = true, AFTER_DRAIN = false;
    bf16_t* O; const float* g;
    __device__ __forceinline__ void operator()(const f32x4 (&acc)[2][2][4][2], const Unit& u, int wr, int wc, int fr, int fq) const {
        const int row0 = u.pm * BM + wr * 64 + fr, col0 = u.pn * BM + wc * 32 + 8 * fq;
        f32x4 gv[2][2];
#pragma unroll
        for (int bj = 0; bj < 2; ++bj)
#pragma unroll
            for (int n = 0; n < 2; ++n) gv[bj][n] = *(const f32x4*)(g + col0 + bj * HALF + 4 * n);
#pragma unroll
        for (int ai = 0; ai < 2; ++ai)
#pragma unroll
            for (int m = 0; m < 4; ++m) { bf16_t* rowp = O + (size_t)(row0 + ai * HALF + m * 16) * PH + col0;
#pragma unroll
                for (int bj = 0; bj < 2; ++bj) { const f32x4 v0 = acc[ai][bj][m][0] * gv[bj][0], v1 = acc[ai][bj][m][1] * gv[bj][1];
                    u32x4 w; w.x = cvt_pk_bf16(v0[0], v0[1]); w.y = cvt_pk_bf16(v0[2], v0[3]); w.z = cvt_pk_bf16(v1[0], v1[1]); w.w = cvt_pk_bf16(v1[2], v1[3]);
                    *(u32x4*)(rowp + bj * HALF) = w; } }
    }
};
template <class Epi, class Sched, bool ALIGN_EPI = false, bool SP2 = false, bool MID = false>
__device__ __forceinline__ void gemm_phase(PG8_LAS unsigned char* lds, const Gemm g, const Sched& S, const Epi& E, int tid_in) {
    int tid_ = tid_in; asm volatile("" : "+v"(tid_));
    const int tid = tid_, wid = __builtin_amdgcn_readfirstlane(tid >> 6), lane = tid & 63, wr = wid >> 2, wc = wid & 3, fr = lane & 15, fq = lane >> 4;
    const int K = g.K, nt = K / BK, LD = g.ld;
    unsigned voffA[2], voffB[2];
#pragma unroll
    for (int i = 0; i < 2; ++i) { int R, C; stage_rc(tid * 16 + i * 8192, R, C); const int Rb = Epi::PERM ? ((R & ~31) + perm32(R & 31)) : R;
        voffA[i] = (unsigned)(R * LD + C) * 2u; voffB[i] = (unsigned)(Rb * LD + C) * 2u; }
    const size_t kstep = (size_t)(BK * 2);
    const size_t hstep = (size_t)HALF * LD * 2;
    const size_t tstep = 2 * hstep;
    const unsigned ldsw = (unsigned)wid * 1024u;
    const int aoff = lds_byte(wr * 64 + fr, fq * 8), boff = lds_byte(wc * 32 + fr, fq * 8);
#define PG8_SA(b, h) (((b) * 2 + (h)) * HTB)
#define PG8_SB(b, h) ((4 + (b) * 2 + (h)) * HTB)
#define PG8_STAGE(bufoff, gbase, voff) do { _Pragma("unroll") for (int _i = 0; _i < 2; ++_i) \
        __builtin_amdgcn_global_load_lds((const unsigned*)((const char*)(gbase) + (voff)[_i]), (PG8_LAS unsigned*)(lds + (bufoff) + ldsw + _i * 8192), 16, 0, 0); } while (0)
#define PG8_LDA(dst, b, h) do { _Pragma("unroll") for (int m = 0; m < 4; ++m) _Pragma("unroll") for (int k = 0; k < 2; ++k) dst[m][k] = *(const PG8_LAS bf16x8*)(lds + PG8_SA(b, h) + aoff + m * 2048 + k * 1024); } while (0)
#define PG8_LDB(dst, b, h) do { _Pragma("unroll") for (int n = 0; n < 2; ++n) _Pragma("unroll") for (int k = 0; k < 2; ++k) dst[n][k] = *(const PG8_LAS bf16x8*)(lds + PG8_SB(b, h) + boff + n * 2048 + k * 1024); } while (0)
#define PG8_MMA(ai, bj, At, Bt) do { __builtin_amdgcn_s_setprio(1); _Pragma("unroll") for (int m = 0; m < 4; ++m) _Pragma("unroll") for (int n = 0; n < 2; ++n) _Pragma("unroll") for (int k = 0; k < 2; ++k) \
        acc[ai][bj][m][n] = __builtin_amdgcn_mfma_f32_16x16x32_bf16(Bt[n][k], At[m][k], acc[ai][bj][m][n], 0, 0, 0); __builtin_amdgcn_s_setprio(0); } while (0)
#define PG8_WAIT_V(n) asm volatile("s_waitcnt vmcnt(" #n ")" ::: "memory")
#define PG8_WAIT_L(n) asm volatile("s_waitcnt lgkmcnt(" #n ")" ::: "memory")
#define PG8_BAR __builtin_amdgcn_s_barrier()
#define PG8_SCHED __builtin_amdgcn_sched_barrier(0)
    Unit cur, nxt; int ui = 0;
    if (!S.next(0, cur)) return;
    f32x4 acc[2][2][4][2];
#pragma unroll
    for (int a = 0; a < 2; ++a)
#pragma unroll
        for (int b = 0; b < 2; ++b)
#pragma unroll
            for (int m = 0; m < 4; ++m)
#pragma unroll
                for (int n = 0; n < 2; ++n) acc[a][b][m][n] = (f32x4){0.f, 0.f, 0.f, 0.f};
    bf16x8 At[4][2], B0[2][2], B1[2][2];
    const char* cA = (const char*)g.A + (size_t)cur.pm * tstep; const char* cB = (const char*)g.Bt + (size_t)cur.pn * tstep;
    S.a_ready(cur);
    if constexpr (SP2) {
        PG8_STAGE(PG8_SB(0, 0), cB, voffB); PG8_STAGE(PG8_SB(0, 1), cB + hstep, voffB); PG8_STAGE(PG8_SA(0, 0), cA, voffA); PG8_STAGE(PG8_SA(0, 1), cA + hstep, voffA);
        if (wr == 1) PG8_BAR;
        PG8_WAIT_V(2); PG8_BAR;
        PG8_STAGE(PG8_SB(1, 0), cB + kstep, voffB); PG8_STAGE(PG8_SA(1, 0), cA + kstep, voffA); PG8_STAGE(PG8_SB(1, 1), cB + hstep + kstep, voffB);
        PG8_WAIT_V(6); PG8_BAR;
    } else {
        PG8_STAGE(PG8_SB(0, 0), cB, voffB); PG8_STAGE(PG8_SA(0, 0), cA, voffA); PG8_STAGE(PG8_SB(0, 1), cB + hstep, voffB); PG8_STAGE(PG8_SA(0, 1), cA + hstep, voffA);
        if (wr == 1) PG8_BAR;
        PG8_WAIT_V(4); PG8_BAR;
        PG8_STAGE(PG8_SB(1, 0), cB + kstep, voffB); PG8_STAGE(PG8_SA(1, 0), cA + kstep, voffA); PG8_STAGE(PG8_SB(1, 1), cB + hstep + kstep, voffB);
        PG8_WAIT_V(6); PG8_BAR;
    }
    for (;;) {
        const bool has_next = S.next(ui + 1, nxt);
        const char* nA = has_next ? (const char*)g.A + (size_t)nxt.pm * tstep : cA; const char* nB = has_next ? (const char*)g.Bt + (size_t)nxt.pn * tstep : cB;
        for (int t = 0; t < nt; t += 2) {
            if constexpr (MID) { if (t == (nt >> 1)) E.mid(acc, cur, wr, wc, fr, fq); }
            const bool last = (t == nt - 2);
            const char* a1 = cA + (size_t)(t + 1) * kstep;
            const char* a2 = last ? nA : cA + (size_t)(t + 2) * kstep; const char* b2 = last ? nB : cB + (size_t)(t + 2) * kstep;
            const char* a3 = a2 + kstep; const char* b3 = b2 + kstep;
            if (last && has_next) S.a_ready(nxt);
            if constexpr (SP2) {
            PG8_LDB(B0, 0, 0); PG8_LDB(B1, 0, 1); PG8_SCHED; PG8_LDA(At, 0, 0); PG8_STAGE(PG8_SA(1, 1), a1 + hstep, voffA);
            PG8_WAIT_V(8); PG8_WAIT_L(0); PG8_BAR; PG8_MMA(0, 0, At, B0); PG8_MMA(0, 1, At, B1); PG8_BAR; PG8_SCHED;
            PG8_LDA(At, 0, 1); PG8_STAGE(PG8_SB(0, 0), b2, voffB); PG8_STAGE(PG8_SB(0, 1), b2 + hstep, voffB); PG8_STAGE(PG8_SA(0, 0), a2, voffA);
            PG8_WAIT_V(8); PG8_WAIT_L(0); PG8_BAR; PG8_MMA(1, 0, At, B0); PG8_MMA(1, 1, At, B1); PG8_BAR; PG8_SCHED;
            PG8_LDB(B0, 1, 0); PG8_LDB(B1, 1, 1); PG8_SCHED; PG8_LDA(At, 1, 0); PG8_STAGE(PG8_SA(0, 1), a2 + hstep, voffA);
            PG8_WAIT_V(8); PG8_WAIT_L(0); PG8_BAR; PG8_MMA(0, 0, At, B0); PG8_MMA(0, 1, At, B1); PG8_BAR; PG8_SCHED;
            PG8_LDA(At, 1, 1); PG8_STAGE(PG8_SB(1, 0), b3, voffB); PG8_STAGE(PG8_SB(1, 1), b3 + hstep, voffB); PG8_STAGE(PG8_SA(1, 0), a3, voffA);
            PG8_WAIT_V(8); PG8_WAIT_L(0); PG8_BAR; PG8_MMA(1, 0, At, B0); PG8_MMA(1, 1, At, B1); PG8_BAR; PG8_SCHED;
            } else {
            PG8_LDB(B0, 0, 0); PG8_SCHED; PG8_LDA(At, 0, 0); PG8_STAGE(PG8_SA(1, 1), a1 + hstep, voffA);
            PG8_WAIT_L(8); PG8_BAR; PG8_WAIT_L(0); PG8_MMA(0, 0, At, B0); PG8_BAR; PG8_SCHED;
            PG8_LDB(B1, 0, 1); PG8_STAGE(PG8_SB(0, 0), b2, voffB);
            PG8_BAR; PG8_WAIT_L(0); PG8_MMA(0, 1, At, B1); PG8_BAR;
            PG8_LDA(At, 0, 1); PG8_STAGE(PG8_SA(0, 0), a2, voffA);
            PG8_BAR; PG8_WAIT_L(0); PG8_MMA(1, 0, At, B0); PG8_BAR; PG8_SCHED;
            PG8_STAGE(PG8_SB(0, 1), b2 + hstep, voffB);
            PG8_WAIT_V(6); PG8_BAR; PG8_MMA(1, 1, At, B1); PG8_BAR;
            PG8_LDB(B0, 1, 0); PG8_SCHED; PG8_LDA(At, 1, 0); PG8_STAGE(PG8_SA(0, 1), a2 + hstep, voffA);
            PG8_WAIT_L(8); PG8_BAR; PG8_WAIT_L(0); PG8_MMA(0, 0, At, B0); PG8_BAR; PG8_SCHED;
            PG8_LDB(B1, 1, 1); PG8_STAGE(PG8_SB(1, 0), b3, voffB);
            PG8_BAR; PG8_WAIT_L(0); PG8_MMA(0, 1, At, B1); PG8_BAR;
            PG8_LDA(At, 1, 1); PG8_STAGE(PG8_SA(1, 0), a3, voffA);
            PG8_BAR; PG8_WAIT_L(0); PG8_MMA(1, 0, At, B0); PG8_BAR; PG8_SCHED;
            PG8_STAGE(PG8_SB(1, 1), b3 + hstep, voffB);
            PG8_WAIT_V(6); PG8_BAR; PG8_MMA(1, 1, At, B1); PG8_BAR;
            }
        }
        if constexpr (ALIGN_EPI) { if (wr == 0) PG8_BAR; }
        if constexpr (!Epi::AFTER_DRAIN) { E(acc, cur, wr, wc, fr, fq); S.done(cur); }
        if (!has_next) break;
#pragma unroll
        for (int a = 0; a < 2; ++a)
#pragma unroll
            for (int b = 0; b < 2; ++b)
#pragma unroll
                for (int m = 0; m < 4; ++m)
#pragma unroll
                    for (int n = 0; n < 2; ++n) acc[a][b][m][n] = (f32x4){0.f, 0.f, 0.f, 0.f};
        cur = nxt; cA = nA; cB = nB; ++ui;
        if constexpr (ALIGN_EPI) { if (wr == 1) PG8_BAR; }
    }
    PG8_WAIT_V(0);
    if constexpr (!ALIGN_EPI) { if (wr == 0) PG8_BAR; }
    PG8_BAR;
    if constexpr (Epi::AFTER_DRAIN) { E.fused(acc, cur, wr, wc, fr, fq, lds, wid, lane); S.done(cur); }
#undef PG8_SA
#undef PG8_SB
#undef PG8_STAGE
#undef PG8_LDA
#undef PG8_LDB
#undef PG8_MMA
#undef PG8_WAIT_V
#undef PG8_WAIT_L
#undef PG8_BAR
#undef PG8_SCHED
}
}
namespace att {
using bf16 = __hip_bfloat16;
constexpr int D = 128, NW = 8, QBLK = 32, KVBLK = 64;
constexpr float SCALE = 0.088388347648318440f;
constexpr float THR = 8.f;
constexpr int SDEPTH = 2;
constexpr size_t SHM_V = KVBLK * D * 2, SHM_K = KVBLK * D * 2, SHM_ATTN = 2 * SHM_V + 2 * SHM_K + NW * 64 * 4;
using bf16x8 = __attribute__((ext_vector_type(8))) short;
using s16x4  = __attribute__((ext_vector_type(4))) short;
using f32x16 = __attribute__((ext_vector_type(16))) float;
using f32x8  = __attribute__((ext_vector_type(8))) float;
using u32x4  = __attribute__((ext_vector_type(4))) unsigned;
#define KSWZ(row, colB) ((row) * 256 + ((colB) ^ (((row) & 7) << 4)))
#define SBAR() __builtin_amdgcn_sched_barrier(0)
__device__ __forceinline__ int crow(int r, int hi) { return (r & 3) + 8 * (r >> 2) + 4 * hi; }
__device__ __forceinline__ unsigned cvtpk(float lo, float hi) {
  unsigned r; asm volatile("v_cvt_pk_bf16_f32 %0, %1, %2" : "=v"(r) : "v"(lo), "v"(hi)); return r;
}
template <typename TIn> struct Stage;
template <> struct Stage<bf16>  { using T = bf16x8;
  __device__ static __forceinline__ T ld8(const bf16* p) { return *reinterpret_cast<const bf16x8*>(p); }
  __device__ static __forceinline__ bf16x8 tobf(T x) { return x; } };
template <> struct Stage<float> { using T = f32x8;
  __device__ static __forceinline__ T ld8(const float* p) { return *reinterpret_cast<const f32x8*>(p); }
  __device__ static __forceinline__ bf16x8 tobf(T x) {
    u32x4 w = {cvtpk(x[0], x[1]), cvtpk(x[2], x[3]), cvtpk(x[4], x[5]), cvtpk(x[6], x[7])}; return *reinterpret_cast<bf16x8*>(&w); } };

__device__ __forceinline__ void partialSM(f32x16& p0, f32x16& p1, float& m_reg, float& mn, float& alpha) {
  constexpr float C = SCALE * 1.4426950408889634f;
  float pmax = p0[0]; for (int r = 1; r < 16; ++r) pmax = fmaxf(pmax, p0[r]); for (int r = 0; r < 16; ++r) pmax = fmaxf(pmax, p1[r]);
  { auto rr = __builtin_amdgcn_permlane32_swap(__float_as_uint(pmax), __float_as_uint(pmax), false, false);
    pmax = fmaxf(__uint_as_float(rr[0]), __uint_as_float(rr[1])); }
  if (__builtin_expect(__all(pmax - m_reg <= THR / SCALE), 1)) { mn = m_reg; alpha = 1.f; }
  else { mn = fmaxf(m_reg, pmax); alpha = __builtin_amdgcn_exp2f((m_reg - mn) * C); m_reg = mn; }
  float mnC = -mn * C;
  for (int r = 0; r < 16; ++r) p0[r] = fmaf(p0[r], C, mnC); for (int r = 0; r < 16; ++r) p1[r] = fmaf(p1[r], C, mnC);
  for (int r = 0; r < 16; ++r) p0[r] = __builtin_amdgcn_exp2f(p0[r]);
}
__device__ __forceinline__ void finishSM(f32x16& p0, f32x16& p1, float alpha, float& l_reg, bf16x8& pa0, bf16x8& pa1, bf16x8& pa2, bf16x8& pa3) {
  for (int r = 0; r < 16; ++r) p1[r] = __builtin_amdgcn_exp2f(p1[r]);
  float ps = 0; for (int r = 0; r < 16; ++r) ps += p0[r]; for (int r = 0; r < 16; ++r) ps += p1[r];
  { auto rr = __builtin_amdgcn_permlane32_swap(__float_as_uint(ps), __float_as_uint(ps), false, false);
    ps = __uint_as_float(rr[0]) + __uint_as_float(rr[1]); }
  l_reg = l_reg * alpha + ps;
#define PK4(P, BASE, OUT) do { unsigned a0 = cvtpk(P[BASE + 0], P[BASE + 1]), a1 = cvtpk(P[BASE + 2], P[BASE + 3]);   \
    unsigned b0 = cvtpk(P[BASE + 4], P[BASE + 5]), b1 = cvtpk(P[BASE + 6], P[BASE + 7]);                              \
    auto r0 = __builtin_amdgcn_permlane32_swap(a0, b0, false, false); auto r1 = __builtin_amdgcn_permlane32_swap(a1, b1, false, false); \
    u32x4 w = {r0[0], r1[0], r0[1], r1[1]}; OUT = *reinterpret_cast<bf16x8*>(&w); } while (0)
  PK4(p0, 0, pa0); PK4(p0, 8, pa1); PK4(p1, 0, pa2); PK4(p1, 8, pa3);
#undef PK4
}
__device__ __forceinline__ void qkt(f32x16& p0, f32x16& p1, const bf16* Ks, const bf16x8* qr, int r32, int hi) {
  p0 = f32x16{}; p1 = f32x16{};
  for (int d0 = 0; d0 < 8; ++d0) { int cb = (d0 * 16 + hi * 8) * 2;
    bf16x8 b0 = *reinterpret_cast<const bf16x8*>((const char*)Ks + KSWZ(r32, cb));
    bf16x8 b1 = *reinterpret_cast<const bf16x8*>((const char*)Ks + KSWZ(32 + r32, cb));
    p0 = __builtin_amdgcn_mfma_f32_32x32x16_bf16(b0, qr[d0], p0, 0, 0, 0);
    p1 = __builtin_amdgcn_mfma_f32_32x32x16_bf16(b1, qr[d0], p1, 0, 0, 0); }
}
__device__ __forceinline__ int v_st(int k, int c) { const int kk = (k & ~0xC) | ((k & 4) << 1) | ((k & 8) >> 1); return ((kk >> 3) * 4 + (c >> 5)) * 512 + ((kk & 7) * 32 + (c & 31)) * 2; }
__device__ __forceinline__ int v_rd_base(int lane) { return ((lane & 3) << 3) | (((lane >> 2) & 3) << 6) | (((lane >> 4) & 1) << 5) | (((lane >> 5) & 1) << 8); }
constexpr int v_rd_off(int d0, int ks, int half) { return d0 * 512 + ks * 4096 + half * 2048; }
template <int OFF> __device__ __forceinline__ s16x4 tr_read(int vb) {
  s16x4 r; asm volatile("ds_read_b64_tr_b16 %0, %1 offset:%2" : "=&v"(r) : "v"(vb), "i"(OFF) : "memory"); return r;
}
template <int D0> __device__ __forceinline__ void pv_one(f32x16& od, int vb, bf16x8 pa0, bf16x8 pa1, bf16x8 pa2, bf16x8 pa3) {
  const s16x4 l0 = tr_read<v_rd_off(D0, 0, 0)>(vb), h0 = tr_read<v_rd_off(D0, 0, 1)>(vb), l1 = tr_read<v_rd_off(D0, 1, 0)>(vb), h1 = tr_read<v_rd_off(D0, 1, 1)>(vb);
  const s16x4 l2 = tr_read<v_rd_off(D0, 2, 0)>(vb), h2 = tr_read<v_rd_off(D0, 2, 1)>(vb), l3 = tr_read<v_rd_off(D0, 3, 0)>(vb), h3 = tr_read<v_rd_off(D0, 3, 1)>(vb);
  asm volatile("s_waitcnt lgkmcnt(0)" ::: "memory"); SBAR();
#define PK(L, H) (bf16x8){L[0], L[1], L[2], L[3], H[0], H[1], H[2], H[3]}
  od = __builtin_amdgcn_mfma_f32_32x32x16_bf16(pa0, PK(l0, h0), od, 0, 0, 0);
  od = __builtin_amdgcn_mfma_f32_32x32x16_bf16(pa1, PK(l1, h1), od, 0, 0, 0);
  od = __builtin_amdgcn_mfma_f32_32x32x16_bf16(pa2, PK(l2, h2), od, 0, 0, 0);
  od = __builtin_amdgcn_mfma_f32_32x32x16_bf16(pa3, PK(l3, h3), od, 0, 0, 0);
#undef PK
}
__device__ __forceinline__ void pv_d0(f32x16* o, int vb, bf16x8 pa0, bf16x8 pa1, bf16x8 pa2, bf16x8 pa3) {
  pv_one<0>(o[0], vb, pa0, pa1, pa2, pa3); pv_one<1>(o[1], vb, pa0, pa1, pa2, pa3); pv_one<2>(o[2], vb, pa0, pa1, pa2, pa3); pv_one<3>(o[3], vb, pa0, pa1, pa2, pa3);
}
__device__ __forceinline__ void na_mask(f32x16& p0, f32x16& p1, const float* T, int tb, int kk, bool rowvalid) {
#pragma unroll
  for (int q = 0; q < 4; ++q) {
#pragma unroll
    for (int r = 4 * q; r < 4 * q + 4; ++r) { const int cr = (r & 3) + 8 * (r >> 2);
      const float b0 = T[tb + cr]; const bool v0 = rowvalid && (unsigned)(cr + kk) < 16u; p0[r] = v0 ? p0[r] + b0 : -INFINITY; }
    asm volatile("" ::: "memory");
#pragma unroll
    for (int r = 4 * q; r < 4 * q + 4; ++r) { const int cr = (r & 3) + 8 * (r >> 2);
      const float b1 = T[tb + 32 + cr]; const bool v1 = rowvalid && (unsigned)(cr + 32 + kk) < 16u; p1[r] = v1 ? p1[r] + b1 : -INFINITY; }
    asm volatile("" ::: "memory");
  }
}
__device__ __forceinline__ void partialSM_fx(f32x16& p0, f32x16& p1, float negMc) {
  (void)negMc;
  for (int r = 0; r < 16; ++r) p0[r] = __builtin_amdgcn_exp2f(p0[r]);
}
__device__ __forceinline__ void finishSM_fx(f32x16& p0, f32x16& p1, float& l_reg, bf16x8& pa0, bf16x8& pa1, bf16x8& pa2, bf16x8& pa3) {
  for (int r = 0; r < 16; ++r) p1[r] = __builtin_amdgcn_exp2f(p1[r]);
  float ps = 0; for (int r = 0; r < 16; ++r) ps += p0[r]; for (int r = 0; r < 16; ++r) ps += p1[r];
  l_reg += ps;
#define PK4(P, BASE, OUT) do { unsigned a0 = cvtpk(P[BASE + 0], P[BASE + 1]), a1 = cvtpk(P[BASE + 2], P[BASE + 3]);   \
    unsigned b0 = cvtpk(P[BASE + 4], P[BASE + 5]), b1 = cvtpk(P[BASE + 6], P[BASE + 7]);                              \
    auto r0 = __builtin_amdgcn_permlane32_swap(a0, b0, false, false); auto r1 = __builtin_amdgcn_permlane32_swap(a1, b1, false, false); \
    u32x4 w = {r0[0], r1[0], r0[1], r1[1]}; OUT = *reinterpret_cast<bf16x8*>(&w); } while (0)
  PK4(p0, 0, pa0); PK4(p0, 8, pa1); PK4(p1, 0, pa2); PK4(p1, 8, pa3);
#undef PK4
}
__device__ __forceinline__ void qkt_i(f32x16& p0, f32x16& p1, const bf16* Ks, const bf16x8* qr, int r32, int hi, float init) {
  for (int r = 0; r < 16; ++r) { p0[r] = init; p1[r] = init; }
  for (int d0 = 0; d0 < 8; ++d0) { int cb = (d0 * 16 + hi * 8) * 2;
    bf16x8 b0 = *reinterpret_cast<const bf16x8*>((const char*)Ks + KSWZ(r32, cb));
    bf16x8 b1 = *reinterpret_cast<const bf16x8*>((const char*)Ks + KSWZ(32 + r32, cb));
    p0 = __builtin_amdgcn_mfma_f32_32x32x16_bf16(b0, qr[d0], p0, 0, 0, 0);
    p1 = __builtin_amdgcn_mfma_f32_32x32x16_bf16(b1, qr[d0], p1, 0, 0, 0); }
}
template <int LDO>
__device__ __forceinline__ void store_o_tile(const f32x16* o, const float* rli, char* lds, int wid, int lane, bf16* Ow) {
  const int r32 = lane & 31, hi = lane >> 5;
  char* T = lds + wid * 8192;
#pragma unroll
  for (int r = 0; r < 16; ++r) { const int orow = crow(r, hi);
#pragma unroll
    for (int d0 = 0; d0 < 4; ++d0) *reinterpret_cast<bf16*>(T + orow * 256 + (d0 * 32 + r32) * 2) = __float2bfloat16(o[d0][r] * rli[r]); }
  asm volatile("s_waitcnt lgkmcnt(0)" ::: "memory");
#pragma unroll
  for (int i = 0; i < 8; ++i) { const int idx = lane + 64 * i, row = idx >> 4, ch = idx & 15;
    const u32x4 w = *reinterpret_cast<const u32x4*>(T + row * 256 + ch * 16);
    *reinterpret_cast<u32x4*>(Ow + (long)row * LDO + ch * 8) = w; }
  asm volatile("s_waitcnt lgkmcnt(0)" ::: "memory");
}
template <int LDQ, int LDK, int LDO, bool NA, int SD, int VOFF>
__device__ __forceinline__ void attn_unit(const bf16* Qb, const bf16* __restrict__ Kh, const bf16* __restrict__ Vh_, bf16* Ob, int NT, char* lds,
                                          const float* __restrict__ rpb  , const float* __restrict__ f1  , int qrow0, int krow0, int tid_in) {
  using St = Stage<bf16>;
  const bf16* __restrict__ Vh = VOFF ? Kh + VOFF : Vh_;
  int tid_ = tid_in; asm volatile("" : "+v"(tid_));
  const int tid = tid_, wid = __builtin_amdgcn_readfirstlane(tid >> 6), lane = tid & 63, r32 = lane & 31, hi = lane >> 5;
  bf16* V_lds = (bf16*)lds; bf16* K_lds = (bf16*)(lds + 2 * SHM_V);
  float* ws = (float*)(lds + 2 * SHM_V + 2 * SHM_K) + wid * 64; float* li_l = ws; float* al_l = ws + 32;
  float* T = (float*)(lds + SHM_ATTN);
  __syncthreads();
  int na_tb0 = 0, na_kk = 0, na_r = 0, na_rs = 0;
  if constexpr (NA) {
    for (int e = tid; e < 15 * 128; e += 512) { const int rr = e >> 7, x = e & 127; T[e] = (x >= 49 && x <= 79) ? rpb[rr * 31 + x - 49] * (1.0f / SCALE) : 0.f;
    }
    const int c = (wid & 1) * 32 + r32; int cs = c - 8; cs = cs < 0 ? 0 : (cs > 48 ? 48 : cs);
    na_tb0 = 64 - c + 4 * hi; na_kk = 4 * hi - cs;
    na_r = qrow0 + (wid >> 1); na_rs = na_r - 4; na_rs = na_rs < 0 ? 0 : (na_rs > 248 ? 248 : na_rs);
  }
  float negMc = 0.f;
  if constexpr (!NA) {
    float mq = fmaxf(fabsf(rpb[lane]), fabsf(rpb[lane + 64])), mk = fmaxf(fabsf(f1[lane]), fabsf(f1[lane + 64]));
#pragma unroll
    for (int o_ = 1; o_ < 64; o_ <<= 1) { mq = fmaxf(mq, __shfl_xor(mq, o_)); mk = fmaxf(mk, __shfl_xor(mk, o_)); }
    const float M = fminf(11.3137085f * 1.01f * mq * mk, 60.f);
    negMc = -M * 1.4426950408889634f;
  }
#define PSM(P0, P1, MN, AL) do { if constexpr (NA) partialSM(P0, P1, m_reg, MN, AL); else partialSM_fx(P0, P1, negMc); } while (0)
#define FSM(P0, P1, AL) do { if constexpr (NA) finishSM(P0, P1, AL, l_reg, pa0, pa1, pa2, pa3); else finishSM_fx(P0, P1, l_reg, pa0, pa1, pa2, pa3); } while (0)
#define NAMASK(P0, P1, ti) do { if constexpr (NA) { SBAR(); const int kr_ = krow0 + (ti); const bool rv_ = (unsigned)(kr_ - na_rs) < 8u; int rr_ = kr_ - na_r + 7; rr_ = rv_ ? rr_ : 0; \
    na_mask(P0, P1, T, na_tb0 + rr_ * 128, na_kk, rv_); SBAR(); } } while (0)
  float m_reg = -1e30f, l_reg = 0; f32x16 o[4] = {}; bf16x8 qr[8];
  const bf16* Qw = Qb + (long)(wid * QBLK + r32) * LDQ + hi * 8;
#pragma unroll
  for (int d0 = 0; d0 < 8; ++d0) qr[d0] = St::ld8(Qw + d0 * 16);
  const int sr = tid >> 4, sc = (tid & 15) * 8, vst0 = v_st(sr, sc), vst1 = v_st(32 + sr, sc);
  const int vb0 = (int)(uintptr_t)V_lds + v_rd_base(lane);
  struct { typename St::T vs0, vs1, ks0, ks1; } sr_[SD];
#define SLOAD(i, k0) do { sr_[i].vs0 = St::ld8(&Vh[(long)((k0) + sr) * LDK + sc]); sr_[i].vs1 = St::ld8(&Vh[(long)((k0) + 32 + sr) * LDK + sc]); \
    sr_[i].ks0 = St::ld8(&Kh[(long)((k0) + sr) * LDK + sc]); sr_[i].ks1 = St::ld8(&Kh[(long)((k0) + 32 + sr) * LDK + sc]); } while (0)
#define SWRITE(b, i) do { *(bf16x8*)((char*)V_lds + (b) * SHM_V + vst0) = St::tobf(sr_[i].vs0);          \
    *(bf16x8*)((char*)V_lds + (b) * SHM_V + vst1) = St::tobf(sr_[i].vs1); int kc = sc * 2;               \
    *(bf16x8*)((char*)K_lds + (b) * SHM_K + KSWZ(sr, kc)) = St::tobf(sr_[i].ks0);                       \
    *(bf16x8*)((char*)K_lds + (b) * SHM_K + KSWZ(32 + sr, kc)) = St::tobf(sr_[i].ks1); } while (0)
#define SWAIT() do { if constexpr (SD == 2) asm volatile("s_waitcnt vmcnt(4)" ::: "memory"); else asm volatile("s_waitcnt vmcnt(0)" ::: "memory"); } while (0)
#define RESC(a) do { if constexpr (NA) if (__any((a) < 1.f)) { if (hi == 0) al_l[r32] = (a); asm volatile("s_waitcnt lgkmcnt(0)" ::: "memory"); \
    for (int d = 0; d < 4; ++d) for (int r = 0; r < 16; ++r) o[d][r] *= al_l[crow(r, hi)]; } } while (0)
  f32x16 pA0, pA1, pB0, pB1; float mnA, mnB, alA, alB; bf16x8 pa0, pa1, pa2, pa3;
  constexpr int SE = 0, SO = SD - 1;
  SLOAD(SE, 0); asm volatile("s_waitcnt vmcnt(0)" ::: "memory"); SWRITE(0, SE); __syncthreads();
  qkt_i(pA0, pA1, K_lds, qr, r32, hi, negMc); NAMASK(pA0, pA1, 0); PSM(pA0, pA1, mnA, alA);
  SLOAD(SO, KVBLK); if constexpr (SD == 2) { if (2 < NT) SLOAD(SE, 2 * KVBLK); }
  SWAIT(); SWRITE(1, SO); __syncthreads();
  for (int j = 1; j + 1 < NT; j += 2) {
    SBAR(); qkt_i(pB0, pB1, (bf16*)((char*)K_lds + SHM_K), qr, r32, hi, negMc);
    FSM(pA0, pA1, alA); SBAR();
    SLOAD(SO, (j + SD) * KVBLK); SBAR();
    pv_d0(o, vb0, pa0, pa1, pa2, pa3); NAMASK(pB0, pB1, j); PSM(pB0, pB1, mnB, alB);
    __syncthreads(); SWAIT(); SWRITE(0, SE);
    RESC(alB); __syncthreads();
    SBAR(); qkt_i(pA0, pA1, K_lds, qr, r32, hi, negMc);
    FSM(pB0, pB1, alB); SBAR();
    if (SD == 1 || j + 3 < NT) SLOAD(SE, (j + 1 + SD) * KVBLK); SBAR();
    pv_d0(o, vb0 + (int)SHM_V, pa0, pa1, pa2, pa3); NAMASK(pA0, pA1, j + 1); PSM(pA0, pA1, mnA, alA);
    __syncthreads(); SWAIT(); SWRITE(1, SO);
    RESC(alA); __syncthreads();
  }
  SBAR(); qkt_i(pB0, pB1, (bf16*)((char*)K_lds + SHM_K), qr, r32, hi, negMc);
  FSM(pA0, pA1, alA); SBAR();
  pv_d0(o, vb0, pa0, pa1, pa2, pa3); NAMASK(pB0, pB1, NT - 1); PSM(pB0, pB1, mnB, alB);
  __syncthreads(); RESC(alB);
  FSM(pB0, pB1, alB); SBAR();
  pv_d0(o, vb0 + (int)SHM_V, pa0, pa1, pa2, pa3);
  if constexpr (!NA) { auto rr_ = __builtin_amdgcn_permlane32_swap(__float_as_uint(l_reg), __float_as_uint(l_reg), false, false); l_reg = __uint_as_float(rr_[0]) + __uint_as_float(rr_[1]); }
  if (hi == 0) li_l[r32] = l_reg; asm volatile("s_waitcnt lgkmcnt(0)" ::: "memory");
  float rli[16];
#pragma unroll
  for (int r = 0; r < 16; ++r) rli[r] = __builtin_amdgcn_rcpf(li_l[crow(r, hi)]);
  __syncthreads();
  store_o_tile<LDO>(o, rli, lds, wid, lane, Ob + (long)(wid * QBLK) * LDO);
#undef SLOAD
#undef SWRITE
#undef SWAIT
#undef RESC
#undef NAMASK
#undef PSM
#undef FSM
}

typedef int v8i_t __attribute__((ext_vector_type(8)));
#define KSWZ8(row, colB) ((row) * 128 + ((colB) ^ ((((row) >> 1) & 7) << 4)))
__device__ __forceinline__ void qkt8(f32x16& p0, f32x16& p1, const char* Ks, const v8i_t* q8, int r32, int hi, float init) {
  for (int r = 0; r < 16; ++r) { p0[r] = init; p1[r] = init; }
#pragma unroll
  for (int s = 0; s < 2; ++s) { const int cb = 64 * s + 32 * hi;
    const u32x4 a00 = *reinterpret_cast<const u32x4*>(Ks + KSWZ8(r32, cb)), a01 = *reinterpret_cast<const u32x4*>(Ks + KSWZ8(r32, cb + 16));
    const u32x4 a10 = *reinterpret_cast<const u32x4*>(Ks + KSWZ8(32 + r32, cb)), a11 = *reinterpret_cast<const u32x4*>(Ks + KSWZ8(32 + r32, cb + 16));
    const v8i_t A0 = {(int)a00.x, (int)a00.y, (int)a00.z, (int)a00.w, (int)a01.x, (int)a01.y, (int)a01.z, (int)a01.w};
    const v8i_t A1 = {(int)a10.x, (int)a10.y, (int)a10.z, (int)a10.w, (int)a11.x, (int)a11.y, (int)a11.z, (int)a11.w};
    p0 = __builtin_amdgcn_mfma_scale_f32_32x32x64_f8f6f4(A0, q8[s], p0, 0, 0, 0, 0, 0, 0);
    p1 = __builtin_amdgcn_mfma_scale_f32_32x32x64_f8f6f4(A1, q8[s], p1, 0, 0, 0, 0, 0, 0); }
}
#define VSWZ8(row, colB) ((row) * 64 + ((colB) ^ ((((row) >> 2) & 3) << 4)))
__device__ __forceinline__ void finishSM_fx8(f32x16& p0, f32x16& p1, float& l_reg, v8i_t& P8) {
  for (int r = 0; r < 16; ++r) p1[r] = __builtin_amdgcn_exp2f(p1[r]);
  float ps = 0; for (int r = 0; r < 16; ++r) ps += p0[r]; for (int r = 0; r < 16; ++r) ps += p1[r];
  l_reg += ps;
#pragma unroll
  for (int i = 0; i < 4; ++i) { int w = 0; w = __builtin_amdgcn_cvt_pk_bf8_f32(p0[4 * i], p0[4 * i + 1], w, false); w = __builtin_amdgcn_cvt_pk_bf8_f32(p0[4 * i + 2], p0[4 * i + 3], w, true); P8[i] = w; }
#pragma unroll
  for (int i = 0; i < 4; ++i) { int w = 0; w = __builtin_amdgcn_cvt_pk_bf8_f32(p1[4 * i], p1[4 * i + 1], w, false); w = __builtin_amdgcn_cvt_pk_bf8_f32(p1[4 * i + 2], p1[4 * i + 3], w, true); P8[4 + i] = w; }
}
__device__ __forceinline__ void pv8(f32x16* o, const char* Vs, const v8i_t P8, int r32, int hi) {
#pragma unroll
  for (int d0 = 0; d0 < 4; ++d0) { const int row = 32 * d0 + r32;
    const u32x4 b0 = *reinterpret_cast<const u32x4*>(Vs + VSWZ8(row, 32 * hi)), b1 = *reinterpret_cast<const u32x4*>(Vs + VSWZ8(row, 32 * hi + 16));
    const v8i_t B = {(int)b0.x, (int)b0.y, (int)b0.z, (int)b0.w, (int)b1.x, (int)b1.y, (int)b1.z, (int)b1.w};
    o[d0] = __builtin_amdgcn_mfma_scale_f32_32x32x64_f8f6f4(P8, B, o[d0], 1  , 0  , 0, 0, 0, 0); }
}
template <int LDQ8, int LDK8, int LDVT, int LDO>
__device__ __forceinline__ void attn_unit_g8(const unsigned char* Q8, const unsigned char* __restrict__ K8h, const unsigned char* __restrict__ V8Th, bf16* Ob, int NT, char* lds,
                                             const float* __restrict__ qnw, const float* __restrict__ knw, int tid_in) {
  int tid_ = tid_in; asm volatile("" : "+v"(tid_));
  const int tid = tid_, wid = __builtin_amdgcn_readfirstlane(tid >> 6), lane = tid & 63, r32 = lane & 31, hi = lane >> 5;
  char* V_lds = lds; char* K_lds = lds + 2 * SHM_V;
  float* ws = (float*)(lds + 2 * SHM_V + 2 * SHM_K) + wid * 64; float* li_l = ws;
  __syncthreads();
  float negMc;
  { float mq = fmaxf(fabsf(qnw[lane]), fabsf(qnw[lane + 64])), mk = fmaxf(fabsf(knw[lane]), fabsf(knw[lane + 64]));
#pragma unroll
    for (int o_ = 1; o_ < 64; o_ <<= 1) { mq = fmaxf(mq, __shfl_xor(mq, o_)); mk = fmaxf(mk, __shfl_xor(mk, o_)); }
    const float M = fminf(11.3137085f * 1.07f * mq * mk, 60.f);
    negMc = __uint_as_float(__builtin_amdgcn_readfirstlane(__float_as_uint(15.0f - M * 1.4426950408889634f))); }
  float l_reg = 0; f32x16 o[4] = {}; v8i_t q8[2];
  { const unsigned char* Qw = Q8 + (long)(wid * QBLK + r32) * LDQ8 + hi * 32;
#pragma unroll
    for (int s = 0; s < 2; ++s) { const u32x4 a = *reinterpret_cast<const u32x4*>(Qw + 64 * s), b = *reinterpret_cast<const u32x4*>(Qw + 64 * s + 16);
      q8[s] = (v8i_t){(int)a.x, (int)a.y, (int)a.z, (int)a.w, (int)b.x, (int)b.y, (int)b.z, (int)b.w}; } }
  const int kr = tid >> 3, kc = (tid & 7) * 16, kst = KSWZ8(kr, kc);
  const int vr = tid >> 2, vc = (tid & 3) * 16, vst = VSWZ8(vr, vc);
  u32x4 vs, ks;
  unsigned vo = (unsigned)(vr * LDVT + vc), ko = (unsigned)(kr * LDK8 + kc);
#define SLOAD(k0) do { vs = *reinterpret_cast<const u32x4*>(V8Th + vo); ks = *reinterpret_cast<const u32x4*>(K8h + ko); vo += KVBLK; ko += KVBLK * LDK8; asm volatile("" : "+v"(vo), "+v"(ko)); } while (0)
#define SWRITE(b) do { *(u32x4*)(V_lds + (b) * SHM_V + vst) = vs; *(u32x4*)(K_lds + (b) * SHM_K + kst) = ks; } while (0)
#define SWAIT() asm volatile("s_waitcnt vmcnt(0)" ::: "memory")
  f32x16 pA0, pA1, pB0, pB1; v8i_t P8;
#define SWRITE4(b) do { *(u32x4*)(V_lds + (b) * 8192 + vst) = vs; *(u32x4*)(K_lds + (b) * 8192 + kst) = ks; } while (0)
#define STEP(PN0, PN1, PO0, PO1, KB, VB, WB, JJ, LOADS) do { \
    SBAR(); qkt8(PN0, PN1, K_lds + (KB) * 8192, q8, r32, hi, negMc); \
    finishSM_fx8(PO0, PO1, l_reg, P8); SBAR(); \
    if (LOADS) SLOAD(((JJ) + 2) * KVBLK); SBAR(); \
    pv8(o, V_lds + (VB) * 8192, P8, r32, hi); partialSM_fx(PN0, PN1, negMc); \
    __syncthreads(); if (LOADS) { SWAIT(); SWRITE4(WB); } } while (0)
  SLOAD(0); SWAIT(); SWRITE4(0);
  SLOAD(KVBLK); SWAIT(); SWRITE4(1); __syncthreads();
  SLOAD(2 * KVBLK);
  qkt8(pA0, pA1, K_lds, q8, r32, hi, negMc); partialSM_fx(pA0, pA1, negMc);
  SWAIT(); SWRITE4(2);
  int j = 1;
  for (; j + 5 < NT; j += 4) {
    STEP(pB0, pB1, pA0, pA1, 1, 0, 3, j, true);
    STEP(pA0, pA1, pB0, pB1, 2, 1, 0, j + 1, true);
    STEP(pB0, pB1, pA0, pA1, 3, 2, 1, j + 2, true);
    STEP(pA0, pA1, pB0, pB1, 0, 3, 2, j + 3, true);
  }
  STEP(pB0, pB1, pA0, pA1, 1, 0, 3, j, true);
  STEP(pA0, pA1, pB0, pB1, 2, 1, 0, j + 1, false);
  SBAR(); qkt8(pB0, pB1, K_lds + 3 * 8192, q8, r32, hi, negMc);
  finishSM_fx8(pA0, pA1, l_reg, P8); SBAR();
  pv8(o, V_lds + 2 * 8192, P8, r32, hi); partialSM_fx(pB0, pB1, negMc);
  finishSM_fx8(pB0, pB1, l_reg, P8); SBAR();
  pv8(o, V_lds + 3 * 8192, P8, r32, hi);
#undef STEP
#undef SWRITE4
  { auto rr_ = __builtin_amdgcn_permlane32_swap(__float_as_uint(l_reg), __float_as_uint(l_reg), false, false); l_reg = __uint_as_float(rr_[0]) + __uint_as_float(rr_[1]); }
  if (hi == 0) li_l[r32] = l_reg; asm volatile("s_waitcnt lgkmcnt(0)" ::: "memory");
  float rli[16];
#pragma unroll
  for (int r = 0; r < 16; ++r) rli[r] = __builtin_amdgcn_rcpf(li_l[crow(r, hi)]);
  __syncthreads();
  store_o_tile<LDO>(o, rli, lds, wid, lane, Ob + (long)(wid * QBLK) * LDO);
#undef SLOAD
#undef SWRITE
#undef SWAIT
}
#undef SBAR
}
namespace cg = cooperative_groups;
#define LAS __attribute__((address_space(3)))
typedef unsigned short bf16_t;
typedef float f32x4 __attribute__((ext_vector_type(4)));
typedef unsigned v4u __attribute__((ext_vector_type(4)));
typedef unsigned v2u __attribute__((ext_vector_type(2)));
constexpr int SEQ = 16384, DM = 2048, DIN = 8704, DFF = 5632, NMOD = 6 * DM;
constexpr float NORM_EPS = 1e-6f;
constexpr size_t MiB = 1u << 20;
constexpr size_t WS_MOD = 0, CTL_ZERO_BYTES = 64 * 1024;
constexpr size_t WS_ROPE = 1 * MiB;
using pg8::PH; using pg8::PA; using pg8::PKV; using pg8::PNB;
constexpr size_t WS_WIN = 2 * MiB, WS_WO = 39 * MiB, WS_WOUT = 48 * MiB, WS_WGU = 57 * MiB, WS_WD = 104 * MiB;
constexpr size_t WS_H = 128 * MiB;
constexpr size_t WS_Q8 = WS_H, WS_K8 = WS_H + 16 * MiB, WS_V8T = WS_H + 20 * MiB;
constexpr size_t WS_QAB = 196 * MiB, WS_KVA = 264 * MiB, WS_KB = 284 * MiB, WS_VB = 320 * MiB, WS_GA = 356 * MiB, WS_GB = 424 * MiB, WS_END = 492 * MiB;
constexpr size_t WS_ACT = 196 * MiB;
static_assert(WS_WIN + (size_t)DIN * PH * 2 <= WS_WO && WS_WO + (size_t)DM * PH * 2 <= WS_WOUT && WS_WOUT + (size_t)DM * PH * 2 <= WS_WGU && WS_WGU + (size_t)2 * DFF * PH * 2 <= WS_WD && WS_WD + (size_t)DM * PA * 2 <= WS_H, "weight map");
static_assert(WS_H + (size_t)SEQ * PH * 2 <= WS_QAB && WS_QAB + (size_t)SEQ * PH * 2 <= WS_KVA && WS_KVA + (size_t)SEQ * PKV * 2 <= WS_KB && WS_KB + (size_t)SEQ * PNB * 2 <= WS_VB && WS_VB + (size_t)SEQ * PNB * 2 <= WS_GA &&
              WS_GA + (size_t)SEQ * PH * 2 <= WS_GB && WS_GB + (size_t)SEQ * PH * 2 <= WS_END && WS_ACT + (size_t)SEQ * PA * 2 <= WS_GB && WS_V8T + 4 * MiB <= WS_QAB, "activation map");
constexpr size_t WS_BAR = 49152;
constexpr int LDS_BYTES = 147456, LDS_MISC = 131072;
constexpr int NPHASE = 11;
#ifndef GEMM_SP2
#define GEMM_SP2 true
#endif
#ifndef GEMM_ALIGN
#define GEMM_ALIGN true
#endif
#ifndef GATT_SD
#define GATT_SD 1
#endif
#ifndef STAGGER_SLEEPS
#define STAGGER_SLEEPS 7
#endif

__device__ __forceinline__ unsigned f2bf(float f) { unsigned u = __builtin_bit_cast(unsigned, f); return (u + 0x7fffu + ((u >> 16) & 1u)) >> 16; }
__device__ __forceinline__ unsigned pk2(float lo, float hi) { return f2bf(lo) | (f2bf(hi) << 16); }
__device__ __forceinline__ float wave_sum(float v) {
#pragma unroll
    for (int o = 1; o < 64; o <<= 1) v += __shfl_xor(v, o);
    return v;
}
__device__ __forceinline__ void transpose_item(const float* __restrict__ W, int N, bf16_t* __restrict__ WT, int ldt, int koff, int mode, LAS float* scr, int item, int lane) {
    const int nblk = N / 32, kb = item / nblk, nb = item % nblk, k0 = 64 * kb, n0 = 32 * nb;
    const int drow0 = mode == 0 ? n0 : ((n0 >> 7) * 256 + (n0 & 127) + (mode == 2 ? 128 : 0));
#pragma unroll 8
    for (int i = 0; i < 32; ++i) { const int kk = 2 * i + (lane >> 5); scr[kk * 33 + (lane & 31)] = W[(size_t)(k0 + kk) * N + n0 + (lane & 31)]; }
    asm volatile("s_waitcnt lgkmcnt(0)" ::: "memory");
    const int c = lane & 7;
#pragma unroll
    for (int j = 0; j < 4; ++j) { const int n = (lane >> 3) + 8 * j; const LAS float* s = scr + (8 * c) * 33 + n;
        v4u o; o.x = pk2(s[0 * 33], s[1 * 33]); o.y = pk2(s[2 * 33], s[3 * 33]); o.z = pk2(s[4 * 33], s[5 * 33]); o.w = pk2(s[6 * 33], s[7 * 33]);
        *(v4u*)(WT + (size_t)(drow0 + n) * ldt + koff + k0 + 8 * c) = o; }
    asm volatile("s_waitcnt lgkmcnt(0)" ::: "memory");
}
__device__ __forceinline__ void gemv_item(const float* __restrict__ cvec, const float* __restrict__ w_ada, const float* __restrict__ b_ada, float* mod, int item, int lane) {
    const int kc = item / 48, jc = item % 48, col = jc * 256 + 4 * lane;
    f32x4 acc = {0.f, 0.f, 0.f, 0.f};
#pragma unroll 8
    for (int kk = 0; kk < 64; ++kk) { const int k = kc * 64 + kk; const float cv = cvec[k]; const float s = cv / (1.f + expf(-cv));
        const f32x4 w = *(const f32x4*)(w_ada + (size_t)k * NMOD + col); acc += w * s; }
    if (kc == 0) acc += *(const f32x4*)(b_ada + col);
#pragma unroll
    for (int e = 0; e < 4; ++e) __hip_atomic_fetch_add(mod + col + e, acc[e], __ATOMIC_RELAXED, __HIP_MEMORY_SCOPE_AGENT);
}
__device__ __forceinline__ void normmod_rows(const float* X, const float* __restrict__ nw, const float* __restrict__ sc, const float* __restrict__ sh, bf16_t* __restrict__ H, int gw, int NGW, int mend, int lane) {
    f32x4 a[8], b[8];
#pragma unroll
    for (int j = 0; j < 8; ++j) { const int col = 4 * lane + 256 * j; const f32x4 w = *(const f32x4*)(nw + col), s = *(const f32x4*)(sc + col); a[j] = w * (s + 1.0f); b[j] = *(const f32x4*)(sh + col); }
    for (int m = gw; m < mend; m += NGW) {
        const f32x4* xr = (const f32x4*)(X + (size_t)m * DM) + lane; f32x4 v[8]; float ss = 0.f;
#pragma unroll
        for (int j = 0; j < 8; ++j) { v[j] = xr[64 * j]; ss += (v[j].x * v[j].x + v[j].y * v[j].y) + (v[j].z * v[j].z + v[j].w * v[j].w); }
        const float rstd = rsqrtf(wave_sum(ss) * (1.0f / DM) + NORM_EPS);
        v2u* o8 = (v2u*)(H + (size_t)m * PH) + lane;
#pragma unroll
        for (int j = 0; j < 8; ++j) { const f32x4 y = v[j] * rstd * a[j] + b[j]; v2u w; w.x = pk2(y.x, y.y); w.y = pk2(y.z, y.w);
            o8[64 * j] = w; }
    }
}
__device__ __forceinline__ f32x4 bf4(v2u w) { f32x4 r; r.x = __uint_as_float(w.x << 16); r.y = __uint_as_float(w.x & 0xffff0000u); r.z = __uint_as_float(w.y << 16); r.w = __uint_as_float(w.y & 0xffff0000u); return r; }
__device__ __forceinline__ void normmod_rows_d(const float* __restrict__ X, const bf16_t* __restrict__ D1, const float* __restrict__ nw, const float* __restrict__ sc, const float* __restrict__ sh, bf16_t* __restrict__ H, int gw, int NGW, int mend, int lane) {
    f32x4 a[8], b[8];
#pragma unroll
    for (int j = 0; j < 8; ++j) { const int col = 4 * lane + 256 * j; const f32x4 w = *(const f32x4*)(nw + col), s = *(const f32x4*)(sc + col); a[j] = w * (s + 1.0f); b[j] = *(const f32x4*)(sh + col); }
    for (int m = gw; m < mend; m += NGW) {
        const f32x4* xr = (const f32x4*)(X + (size_t)m * DM) + lane; const v2u* dr = (const v2u*)(D1 + (size_t)m * PH) + lane; f32x4 v[8]; float ss = 0.f;
#pragma unroll
        for (int j = 0; j < 8; ++j) { v[j] = xr[64 * j] + bf4(dr[64 * j]); ss += (v[j].x * v[j].x + v[j].y * v[j].y) + (v[j].z * v[j].z + v[j].w * v[j].w); }
        const float rstd = rsqrtf(wave_sum(ss) * (1.0f / DM) + NORM_EPS);
        v2u* o8 = (v2u*)(H + (size_t)m * PH) + lane;
#pragma unroll
        for (int j = 0; j < 8; ++j) { const f32x4 y = v[j] * rstd * a[j] + b[j]; v2u w; w.x = pk2(y.x, y.y); w.y = pk2(y.z, y.w); o8[64 * j] = w; }
    }
}
__device__ __forceinline__ void final_rows_d(const float* __restrict__ X, const bf16_t* __restrict__ D1, const bf16_t* __restrict__ D2, float* __restrict__ OUT, const float* __restrict__ fw, int gw, int NGW, int mend, int lane) {
    f32x4 a[8];
#pragma unroll
    for (int j = 0; j < 8; ++j) a[j] = *(const f32x4*)(fw + 4 * lane + 256 * j);
    for (int m = gw; m < mend; m += NGW) {
        const f32x4* xr = (const f32x4*)(X + (size_t)m * DM) + lane; const v2u* d1 = (const v2u*)(D1 + (size_t)m * PH) + lane; const v2u* d2 = (const v2u*)(D2 + (size_t)m * PH) + lane; f32x4 v[8]; float ss = 0.f;
#pragma unroll
        for (int j = 0; j < 8; ++j) { v[j] = (xr[64 * j] + bf4(d1[64 * j])) + bf4(d2[64 * j]); ss += (v[j].x * v[j].x + v[j].y * v[j].y) + (v[j].z * v[j].z + v[j].w * v[j].w); }
        const float rstd = rsqrtf(wave_sum(ss) * (1.0f / DM) + NORM_EPS);
        f32x4* orow = (f32x4*)(OUT + (size_t)m * DM) + lane;
#pragma unroll
        for (int j = 0; j < 8; ++j) orow[64 * j] = v[j] * rstd * a[j];
    }
}
__device__ __forceinline__ void final_rows(float* X, const float* __restrict__ fw, int gw, int NGW, int lane) {
    f32x4 a[8];
#pragma unroll
    for (int j = 0; j < 8; ++j) a[j] = *(const f32x4*)(fw + 4 * lane + 256 * j);
    for (int m = gw; m < SEQ; m += NGW) {
        f32x4* xr = (f32x4*)(X + (size_t)m * DM) + lane; f32x4 v[8]; float ss = 0.f;
#pragma unroll
        for (int j = 0; j < 8; ++j) { v[j] = xr[64 * j]; ss += (v[j].x * v[j].x + v[j].y * v[j].y) + (v[j].z * v[j].z + v[j].w * v[j].w); }
        const float rstd = rsqrtf(wave_sum(ss) * (1.0f / DM) + NORM_EPS);
#pragma unroll
        for (int j = 0; j < 8; ++j) xr[64 * j] = v[j] * rstd * a[j];
    }
}
__device__ __forceinline__ void qknorm_rope(bf16_t* QAB, bf16_t* KVA, unsigned char* __restrict__ Q8, unsigned char* __restrict__ K8, const float* __restrict__ qn, const float* __restrict__ kn, const float* __restrict__ tab, int it0, int its, int ite, int lane) {
    const int li = lane & 15;
    for (int it = it0 + (lane >> 4); it < ite; it += its) {
        const int t = it / 10, hs = it - t * 10;
        bf16_t* p = (hs < 8 ? QAB + (size_t)t * PH + hs * 128 : KVA + (size_t)t * PKV + (hs - 8) * 128) + 8 * li;
        const float* wn = (hs < 8 ? qn : kn) + 8 * li;
        const v4u raw = *(const v4u*)p; float x[8];
#pragma unroll
        for (int e = 0; e < 4; ++e) { x[2 * e] = __uint_as_float(raw[e] << 16); x[2 * e + 1] = __uint_as_float(raw[e] & 0xffff0000u); }
        float ss = 0.f;
#pragma unroll
        for (int e = 0; e < 8; ++e) ss += x[e] * x[e];
        ss += __shfl_xor(ss, 1); ss += __shfl_xor(ss, 2); ss += __shfl_xor(ss, 4); ss += __shfl_xor(ss, 8);
        const float rstd = rsqrtf(ss * (1.0f / 128.0f) + NORM_EPS) * (hs < 8 ? 0.088388347648318440f * 1.4426950408889634f : 1.0f);
        const f32x4 w0 = *(const f32x4*)wn, w1 = *(const f32x4*)(wn + 4);
        const float wv[8] = {w0.x, w0.y, w0.z, w0.w, w1.x, w1.y, w1.z, w1.w};
        const int row = t >> 6, col = t & 63;
        const float* cs = tab + 2 * (li < 8 ? (row * 32 + 4 * li) : ((256 + col) * 32 + 4 * (li - 8)));
        const f32x4 c0 = *(const f32x4*)cs, c1 = *(const f32x4*)(cs + 4);
        const float cv[4] = {c0.x, c0.z, c1.x, c1.z}, sv[4] = {c0.y, c0.w, c1.y, c1.w};
        float r8[8];
#pragma unroll
        for (int e = 0; e < 4; ++e) { const float y0 = x[2 * e] * rstd * wv[2 * e], y1 = x[2 * e + 1] * rstd * wv[2 * e + 1];
            r8[2 * e] = y0 * cv[e] - y1 * sv[e]; r8[2 * e + 1] = y0 * sv[e] + y1 * cv[e]; }
        int pw0 = 0, pw1 = 0;
        pw0 = __builtin_amdgcn_cvt_pk_fp8_f32(r8[0], r8[1], pw0, false); pw0 = __builtin_amdgcn_cvt_pk_fp8_f32(r8[2], r8[3], pw0, true);
        pw1 = __builtin_amdgcn_cvt_pk_fp8_f32(r8[4], r8[5], pw1, false); pw1 = __builtin_amdgcn_cvt_pk_fp8_f32(r8[6], r8[7], pw1, true);
        unsigned char* d8 = (hs < 8 ? Q8 + (size_t)t * 1024 + hs * 128 : K8 + (size_t)t * 256 + (hs - 8) * 128) + 8 * li;
        v2u o8; o8.x = (unsigned)pw0; o8.y = (unsigned)pw1; *(v2u*)d8 = o8;
    }
}

#define XB_TMO      128
#define XB_XCNT(j)  (256  + 64 * (j))
#define XB_XSUB(j)  (1280 + 64 * (j))
#define XB_XGEN(j)  (2304 + 64 * (j))
#define XB_TOP      3328
#define XB_TOPGEN   3392
#define XCD_BAR_WORDS 3456
#define XB_SPIN_CAP (1u << 18)

__device__ __forceinline__ unsigned xb_ld(unsigned* p)              { return __hip_atomic_load(p, __ATOMIC_RELAXED, __HIP_MEMORY_SCOPE_AGENT); }
__device__ __forceinline__ unsigned xb_add(unsigned* p, unsigned v) { return __hip_atomic_fetch_add(p, v, __ATOMIC_RELAXED, __HIP_MEMORY_SCOPE_AGENT); }
__device__ __forceinline__ unsigned xb_xcc_id() { return (unsigned)__builtin_amdgcn_s_getreg((3 << 11) | 20) & 0xFu; }
#define XB_SPIN(cond, bar) do { unsigned _sp = 0; while (cond) { __builtin_amdgcn_s_sleep(1); \
    if ((++_sp & 255u) == 0u) { if (xb_ld(&(bar)[XB_TMO])) break; if (_sp > XB_SPIN_CAP) { atomicAdd(&(bar)[XB_TMO], 1u); break; } } } } while (0)

struct XcdBarrier {
    unsigned* bar; unsigned x;
    volatile LAS unsigned* st;
};

__device__ __forceinline__ XcdBarrier xcd_barrier_post(unsigned* bar, volatile LAS unsigned* st) {
    XcdBarrier b; b.bar = bar; b.x = xb_xcc_id(); b.st = st;
    if (threadIdx.x == 0) st[2] = xb_add(&bar[XB_XCNT(b.x)], 1u);
    return b;
}
__device__ __forceinline__ void xcd_barrier_complete(unsigned* bar, unsigned x, unsigned& nloc, unsigned& nx) {
    const unsigned G = gridDim.x * gridDim.y * gridDim.z;
    unsigned sum, cnt, mine, sp = 0u;
    for (;;) {
        sum = 0u; cnt = 0u; mine = 0u;
#pragma unroll
        for (unsigned j = 0; j < 16; ++j) { const unsigned c = xb_ld(&bar[XB_XCNT(j)]); sum += c; cnt += (c > 0u) ? 1u : 0u; mine = (j == x) ? c : mine; }
        if (sum == G) break;
        __builtin_amdgcn_s_sleep(1);
        if ((++sp & 255u) == 0u) { if (xb_ld(&bar[XB_TMO])) break; if (sp > XB_SPIN_CAP) { atomicAdd(&bar[XB_TMO], 1u); break; } }
    }
    nloc = mine > 0u ? mine : 1u; nx = cnt > 0u ? cnt : 1u;
}

__device__ __forceinline__ void xcd_barrier(const XcdBarrier& b, int tid_) {
    asm volatile("s_waitcnt vmcnt(0)" ::: "memory");
    __syncthreads();
    if (tid_ == 0) {
        unsigned* bar = b.bar;
        __builtin_amdgcn_s_waitcnt(0);
        unsigned nloc = b.st[0], nx = b.st[1];
        if (nloc == 0u) { xcd_barrier_complete(bar, b.x, nloc, nx); b.st[0] = nloc; b.st[1] = nx; }
        const unsigned old = xb_add(&bar[XB_XSUB(b.x)], 1u);
        const unsigned gen = old / nloc;
        if (old + 1u == (gen + 1u) * nloc) {
            __builtin_amdgcn_fence(__ATOMIC_RELEASE, "agent");
            asm volatile("s_waitcnt vmcnt(0)" ::: "memory");
            const unsigned og = xb_add(&bar[XB_TOP], 1u);
            const unsigned tg = og / nx;
            if (og + 1u == (tg + 1u) * nx) xb_add(&bar[XB_TOPGEN], 1u);
            else XB_SPIN(xb_ld(&bar[XB_TOPGEN]) == tg, bar);
            __builtin_amdgcn_fence(__ATOMIC_ACQUIRE, "agent");
            xb_add(&bar[XB_XGEN(b.x)], 1u);
            asm volatile("s_waitcnt vmcnt(0)" ::: "memory");
        } else {
            XB_SPIN(xb_ld(&bar[XB_XGEN(b.x)]) == gen, bar);
            __builtin_amdgcn_fence(__ATOMIC_ACQUIRE, "agent");
            asm volatile("s_waitcnt vmcnt(0)" ::: "memory");
        }
    }
    __syncthreads();
}
#define XB_LSUB(j) (3456 + 16 * (j))
#define XB_LGEN(j) (3712 + 16 * (j))
__device__ __forceinline__ void xcd_barrier_local(const XcdBarrier& b, int tid_) {
    asm volatile("s_waitcnt vmcnt(0)" ::: "memory");
    __syncthreads();
    if (tid_ == 0) {
        unsigned* bar = b.bar;
        __builtin_amdgcn_s_waitcnt(0);
        const unsigned nloc = b.st[0];
        const unsigned old = xb_add(&bar[XB_LSUB(b.x)], 1u);
        const unsigned gen = old / nloc;
        if (old + 1u == (gen + 1u) * nloc) xb_add(&bar[XB_LGEN(b.x)], 1u);
        else XB_SPIN(xb_ld(&bar[XB_LGEN(b.x)]) == gen, bar);
        __builtin_amdgcn_fence(__ATOMIC_ACQUIRE, "agent");
        asm volatile("s_waitcnt vmcnt(0)" ::: "memory");
    }
    __syncthreads();
}
__device__ __forceinline__ void v8t_item(const bf16_t* __restrict__ KVA, unsigned char* __restrict__ V8T, int item, LAS unsigned char* scr, int lane) {
    const int kvh = item >> 8, T = item & 255;
    const bf16_t* src = KVA + (size_t)(64 * T) * PKV + 256 + kvh * 128;
#pragma unroll 4
    for (int i = 0; i < 16; ++i) { const int key = 4 * i + (lane >> 4), c0 = 8 * (lane & 15);
        const v4u raw = *(const v4u*)(src + (size_t)key * PKV + c0);
        int w0 = 0, w1 = 0;
        w0 = __builtin_amdgcn_cvt_pk_fp8_f32(__uint_as_float(raw.x << 16), __uint_as_float(raw.x & 0xffff0000u), w0, false); w0 = __builtin_amdgcn_cvt_pk_fp8_f32(__uint_as_float(raw.y << 16), __uint_as_float(raw.y & 0xffff0000u), w0, true);
        w1 = __builtin_amdgcn_cvt_pk_fp8_f32(__uint_as_float(raw.z << 16), __uint_as_float(raw.z & 0xffff0000u), w1, false); w1 = __builtin_amdgcn_cvt_pk_fp8_f32(__uint_as_float(raw.w << 16), __uint_as_float(raw.w & 0xffff0000u), w1, true);
        const int kq = key & 31, pos = 32 * ((kq >> 2) & 1) + 16 * (key >> 5) + (kq & 3) + 4 * (kq >> 3);
        LAS unsigned char* d = scr + c0 * 68 + pos;
        d[0 * 68] = (unsigned char)(w0); d[1 * 68] = (unsigned char)(w0 >> 8); d[2 * 68] = (unsigned char)(w0 >> 16); d[3 * 68] = (unsigned char)(w0 >> 24);
        d[4 * 68] = (unsigned char)(w1); d[5 * 68] = (unsigned char)(w1 >> 8); d[6 * 68] = (unsigned char)(w1 >> 16); d[7 * 68] = (unsigned char)(w1 >> 24); }
    asm volatile("s_waitcnt lgkmcnt(0)" ::: "memory");
#pragma unroll
    for (int i = 0; i < 8; ++i) { const int idx = lane + 64 * i, col = idx >> 2, ch = idx & 3; const LAS unsigned* s4 = (const LAS unsigned*)(scr + col * 68 + ch * 16);
        v4u w; w.x = s4[0]; w.y = s4[1]; w.z = s4[2]; w.w = s4[3];
        *(v4u*)(V8T + (size_t)(kvh * 128 + col) * 16384 + 64 * T + ch * 16) = w; }
    asm volatile("s_waitcnt lgkmcnt(0)" ::: "memory");
}
struct Args { const float* in[17]; float* out; unsigned char* ws; int ph_lo, ph_hi; };
__global__ void __launch_bounds__(512) fwd(Args args) {
    extern __shared__ __attribute__((aligned(16))) unsigned char lds[];
    cg::grid_group grid = cg::this_grid();
    const int tid0 = threadIdx.x;
    const int G0 = gridDim.x, bx0 = blockIdx.x;
    const int lo = args.ph_lo, hi = args.ph_hi;
    const int wave0 = __builtin_amdgcn_readfirstlane(tid0 >> 6);
    if (hi > 1000) grid.sync();
    volatile LAS unsigned* bst = (volatile LAS unsigned*)((LAS unsigned char*)lds + LDS_MISC);
    if (tid0 < 4) bst[tid0] = tid0 == 3 ? 0xFFFFFFFFu : 0u;
    __syncthreads();
    const XcdBarrier bar = xcd_barrier_post((unsigned*)(args.ws + WS_BAR), bst);
#ifndef PHASE_MASK
#define PHASE_MASK 0x7ff
#endif
#define IN(k) (((PHASE_MASK >> (k)) & 1) && lo <= (k) && (k) < hi)
#define SEAM(k) do { if (IN(k) && IN((k) + 1)) { const int t_ = wave0 * 64 + (int)__builtin_amdgcn_mbcnt_hi(~0u, __builtin_amdgcn_mbcnt_lo(~0u, 0u)); xcd_barrier(bar, t_); } } while (0)
#define SEAML(k) do { if (IN(k) && IN((k) + 1)) { const int t_ = wave0 * 64 + (int)__builtin_amdgcn_mbcnt_hi(~0u, __builtin_amdgcn_mbcnt_lo(~0u, 0u)); if (bst[3] != 0xFFFFFFFFu) xcd_barrier_local(bar, t_); else xcd_barrier(bar, t_); } } while (0)
    typedef const __attribute__((address_space(4))) Args* ArgP;
#define ARGP() ({ ArgP p_ = (ArgP)__builtin_amdgcn_kernarg_segment_ptr(); asm volatile("" : "+s"(p_)); p_; })
#define WSP(off, T) ((T*)(A->ws + (off)))
#define OPQ() int G = G0, bx = bx0; asm volatile("" : "+s"(G), "+s"(bx)); int tid = wave0 * 64 + (int)__builtin_amdgcn_mbcnt_hi(~0u, __builtin_amdgcn_mbcnt_lo(~0u, 0u)); asm volatile("" : "+v"(tid)); const int lane = tid & 63, wave = __builtin_amdgcn_readfirstlane(tid >> 6), gw = bx * 8 + wave, NGW = G * 8; (void)gw; (void)NGW; (void)lane; const unsigned vm_ = bst[3]; const bool g8_ = (G & 7) == 0; const int vbx = (vm_ != 0xFFFFFFFFu) ? (int)__builtin_amdgcn_readfirstlane(vm_) : bx; const int cls = vbx & 7, rnk = vbx >> 3; (void)cls; (void)rnk; const int rw0 = g8_ ? cls * (SEQ / 8) + rnk * 8 + wave : gw, rws = g8_ ? G : NGW, rwe = g8_ ? (cls + 1) * (SEQ / 8) : SEQ; (void)rw0; (void)rws; (void)rwe

    if (IN(0)) { ArgP A = ARGP(); OPQ();
        const float* cvec = A->in[1]; const float* w_ada = A->in[2]; const float* b_ada = A->in[3]; const float* w_in = A->in[5]; const float* w_oa = A->in[9]; const float* w_ob = A->in[10];
        const float* w_out = A->in[11]; const float* w_g = A->in[13]; const float* w_u = A->in[14]; const float* w_d = A->in[15]; float* mod = WSP(WS_MOD, float); float* tab = WSP(WS_ROPE, float);
        bf16_t* WinT = WSP(WS_WIN, bf16_t); bf16_t* WoT = WSP(WS_WO, bf16_t); bf16_t* WoutT = WSP(WS_WOUT, bf16_t); bf16_t* WguT = WSP(WS_WGU, bf16_t); bf16_t* WdT = WSP(WS_WD, bf16_t);
        LAS float* scr = (LAS float*)((LAS unsigned char*)lds + wave * 16384);
        constexpr int I_GEMV = 32 * 48, I_IN = (DM / 64) * (DIN / 32), I_OA = (1024 / 64) * (DM / 32), I_OUT = (DM / 64) * (DM / 32), I_G = (DM / 64) * (DFF / 32), I_D = (DFF / 64) * (DM / 32);
        constexpr int NITEMS = I_GEMV + I_IN + 2 * I_OA + I_OUT + I_D;
        for (int it = gw; it < NITEMS; it += NGW) {
            int r = it;
            if (r < I_GEMV) { gemv_item(cvec, w_ada, b_ada, mod, r, lane); continue; } r -= I_GEMV;
            if (r < I_IN) { transpose_item(w_in, DIN, WinT, PH, 0, 0, scr, r, lane); continue; } r -= I_IN;
            if (r < I_OA) { transpose_item(w_oa, DM, WoT, PH, 0, 0, scr, r, lane); continue; } r -= I_OA;
            if (r < I_OA) { transpose_item(w_ob, DM, WoT, PH, 1024, 0, scr, r, lane); continue; } r -= I_OA;
            if (r < I_OUT) { transpose_item(w_out, DM, WoutT, PH, 0, 0, scr, r, lane); continue; } r -= I_OUT;
            transpose_item(w_d, DM, WdT, PA, 0, 0, scr, r, lane);
        }
        for (int e = bx * 512 + tid; e < 320 * 32; e += G * 512) { const int pos = e >> 5, j = e & 31; const float p = (float)(pos < 256 ? pos : pos - 256);
            const float inv = powf(10000.0f, -(float)(2 * j) / 64.0f); const float ang = p * inv; tab[2 * e] = cosf(ang); tab[2 * e + 1] = sinf(ang);
        }
    }
    SEAM(0);
    if (IN(0) && IN(1)) {
        const int t_ = wave0 * 64 + (int)__builtin_amdgcn_mbcnt_hi(~0u, __builtin_amdgcn_mbcnt_lo(~0u, 0u));
        if (t_ == 0) { unsigned nx_ = 0u, below_ = 0u, ok_ = ((G0 & 7) == 0) ? 1u : 0u; const unsigned per_ = (unsigned)G0 >> 3;
#pragma unroll
            for (unsigned j_ = 0; j_ < 16; ++j_) { const unsigned c_ = xb_ld(&bar.bar[XB_XCNT(j_)]); if (c_) { ++nx_; if (c_ != per_) ok_ = 0u; if (j_ < bar.x) ++below_; } }
            const unsigned rk_ = bst[2];
            bst[3] = (ok_ && nx_ == 8u && rk_ < per_) ? (rk_ * 8u + below_) : 0xFFFFFFFFu; }
        __syncthreads();
    }
    if (IN(1)) { ArgP A = ARGP(); OPQ(); float* mod = WSP(WS_MOD, float); normmod_rows(A->in[0], A->in[4], mod + 2048, mod + 0, WSP(WS_H, bf16_t), rw0, rws, rwe, lane); }
    SEAML(1);
    if (IN(2)) { ArgP A = ARGP(); OPQ();
        pg8::Gemm g{WSP(WS_H, bf16_t), WSP(WS_WIN, bf16_t), SEQ, DIN, DM, PH}; pg8::StaticOrder S; S.init(SEQ, DIN, G, vbx);
        pg8::EpiProj E{WSP(WS_QAB, bf16_t), WSP(WS_KVA, bf16_t), WSP(WS_KB, bf16_t), WSP(WS_VB, bf16_t), WSP(WS_GA, bf16_t), WSP(WS_GB, bf16_t)};
        pg8::gemm_phase<pg8::EpiProj, pg8::StaticOrder, GEMM_ALIGN, GEMM_SP2, false>((LAS unsigned char*)lds, g, S, E, tid);
        {
            const int first = S.nwg % G;
            if (vbx >= first) {
                constexpr int I_G2 = (DM / 64) * (DFF / 32);
                LAS float* scr = (LAS float*)((LAS unsigned char*)lds + wave * 16384);
                const float* w_g = A->in[13]; const float* w_u = A->in[14]; bf16_t* WguT = WSP(WS_WGU, bf16_t);
                for (int it = (vbx - first) * 8 + wave; it < 2 * I_G2; it += (G - first) * 8) {
                    if (it < I_G2) transpose_item(w_g, DFF, WguT, PH, 0, 1, scr, it, lane); else transpose_item(w_u, DFF, WguT, PH, 0, 2, scr, it - I_G2, lane);
                }
            }
        }
    }
    SEAM(2);
    if (IN(3)) { ArgP A = ARGP(); OPQ();
        if ((wave & 3) == 0) { LAS unsigned char* scr = (LAS unsigned char*)lds + wave * 16384; if (g8_) { for (int tt = rnk; tt < 32; tt += (G >> 3)) v8t_item(WSP(WS_KVA, bf16_t), WSP(WS_V8T, unsigned char), (wave >> 2) * 256 + cls * 32 + tt, scr, lane); }
            else for (int it = bx * 2 + (wave >> 2); it < 512; it += G * 2) v8t_item(WSP(WS_KVA, bf16_t), WSP(WS_V8T, unsigned char), it, scr, lane); }
        qknorm_rope(WSP(WS_QAB, bf16_t), WSP(WS_KVA, bf16_t), WSP(WS_Q8, unsigned char), WSP(WS_K8, unsigned char), A->in[6], A->in[7], WSP(WS_ROPE, float), g8_ ? cls * (SEQ / 8) * 10 + (rnk * 8 + wave) * 4 : gw * 4, g8_ ? G * 4 : NGW * 4, g8_ ? (cls + 1) * (SEQ / 8) * 10 : SEQ * 10, lane); }
    SEAM(3);
    if (IN(4)) { ArgP A = ARGP(); OPQ();
        using abf = att::bf16; bf16_t* QAB = WSP(WS_QAB, bf16_t); bf16_t* KVA = WSP(WS_KVA, bf16_t); bf16_t* KB = WSP(WS_KB, bf16_t); bf16_t* VB = WSP(WS_VB, bf16_t); const float* rpb = A->in[8];
        for (int u = bx; u < 512; u += G) { const int h = u >> 6, qb = u & 63, kvh = h >> 2;
            att::attn_unit_g8<1024, 256, 16384, PH>(WSP(WS_Q8, unsigned char) + (size_t)qb * 256 * 1024 + h * 128, WSP(WS_K8, unsigned char) + kvh * 128, WSP(WS_V8T, unsigned char) + (size_t)kvh * 128 * 16384,
                                                    (abf*)QAB + (size_t)qb * 256 * PH + h * 128, SEQ / 64, (char*)lds, A->in[6], A->in[7], tid);
        }
        for (int v = bx; v < 512; v += G) { const int h = v >> 6, qb = v & 63; int r_lo = 4 * qb - 4; r_lo = r_lo < 0 ? 0 : (r_lo > 244 ? 244 : r_lo);
            att::attn_unit<PH, PNB, PH, true, 1, 0>((const abf*)QAB + (size_t)qb * 256 * PH + 1024 + h * 128, (const abf*)KB + (size_t)r_lo * 64 * PNB + h * 128, (const abf*)VB + (size_t)r_lo * 64 * PNB + h * 128,
                                                   (abf*)QAB + (size_t)qb * 256 * PH + 1024 + h * 128, 12, (char*)lds, rpb + h * 15 * 31, nullptr, 4 * qb, r_lo, tid);
        }
        __syncthreads();
    }
    SEAM(4);
    if (IN(5)) { ArgP A = ARGP(); OPQ();
        pg8::Gemm g{WSP(WS_QAB, bf16_t), WSP(WS_WO, bf16_t), SEQ, DM, DM, PH}; pg8::StaticOrder S; S.init(SEQ, DM, G, vbx);
        pg8::EpiMerged E{WSP(WS_GA, bf16_t), WSP(WS_GB, bf16_t), WSP(WS_H, bf16_t)};
        pg8::gemm_phase<pg8::EpiMerged, pg8::StaticOrder, GEMM_ALIGN, GEMM_SP2, true>((LAS unsigned char*)lds, g, S, E, tid);
    }
    SEAML(5);
    if (IN(6)) { ArgP A = ARGP(); OPQ();
        pg8::Gemm g{WSP(WS_H, bf16_t), WSP(WS_WOUT, bf16_t), SEQ, DM, DM, PH}; pg8::StaticOrder S; S.init(SEQ, DM, G, vbx);
        pg8::EpiDelta E{WSP(WS_GB, bf16_t), WSP(WS_MOD, float) + 4096};
        pg8::gemm_phase<pg8::EpiDelta, pg8::StaticOrder, GEMM_ALIGN, GEMM_SP2, false>((LAS unsigned char*)lds, g, S, E, tid);
    }
    SEAML(6);
    if (IN(7)) { ArgP A = ARGP(); OPQ(); float* mod = WSP(WS_MOD, float); normmod_rows_d(A->in[0], WSP(WS_GB, bf16_t), A->in[12], mod + 8192, mod + 6144, WSP(WS_H, bf16_t), rw0, rws, rwe, lane); }
    SEAM(7);
    if (IN(8)) { ArgP A = ARGP(); OPQ();
        pg8::Gemm g{WSP(WS_H, bf16_t), WSP(WS_WGU, bf16_t), SEQ, 2 * DFF, DM, PH}; pg8::StaticOrder S; S.init(SEQ, 2 * DFF, G, vbx);
        pg8::EpiSwiglu E{WSP(WS_ACT, bf16_t)};
        pg8::gemm_phase<pg8::EpiSwiglu, pg8::StaticOrder, GEMM_ALIGN, GEMM_SP2, false>((LAS unsigned char*)lds, g, S, E, tid);
    }
    SEAML(8);
    if (IN(9)) { ArgP A = ARGP(); OPQ();
        pg8::Gemm g{WSP(WS_ACT, bf16_t), WSP(WS_WD, bf16_t), SEQ, DM, DFF, PA}; pg8::StaticOrder S; S.init(SEQ, DM, G, vbx);
        pg8::EpiDelta E{WSP(WS_H, bf16_t), WSP(WS_MOD, float) + 10240};
        pg8::gemm_phase<pg8::EpiDelta, pg8::StaticOrder, GEMM_ALIGN, GEMM_SP2, false>((LAS unsigned char*)lds, g, S, E, tid);
    }
    SEAML(9);
    if (IN(10)) { ArgP A = ARGP(); OPQ(); final_rows_d(A->in[0], WSP(WS_GB, bf16_t), WSP(WS_H, bf16_t), A->out, A->in[16], rw0, rws, rwe, lane); }
#undef IN
#undef SEAM
}

#ifndef N_LAUNCHES
#define N_LAUNCHES 1
#endif
extern "C" void kernel_launch(void* const* d_in, const int* in_sizes, int n_in, void* d_out, int out_size, void* d_ws, size_t ws_size, hipStream_t stream) {
    static int grid = 0;
    if (grid == 0) {
        if (n_in != 17 || in_sizes[0] != SEQ * DM || out_size != SEQ * DM || ws_size < WS_END) { fprintf(stderr, "kernel_launch: unexpected shapes: n_in %d in0 %d out %d ws %zu (need %zu)\n", n_in, n_in > 0 ? in_sizes[0] : -1, out_size, ws_size, (size_t)WS_END); grid = -1; return; }
        int dev = 0, cus = 0, per_cu = 0;
        if (hipGetDevice(&dev) != hipSuccess || hipDeviceGetAttribute(&cus, hipDeviceAttributeMultiprocessorCount, dev) != hipSuccess) { fprintf(stderr, "kernel_launch: device query failed\n"); grid = -1; return; }
        if (hipFuncSetAttribute((const void*)fwd, hipFuncAttributeMaxDynamicSharedMemorySize, LDS_BYTES) != hipSuccess) { fprintf(stderr, "kernel_launch: hipFuncSetAttribute failed\n"); grid = -1; return; }
        if (hipOccupancyMaxActiveBlocksPerMultiprocessor(&per_cu, (const void*)fwd, 512, LDS_BYTES) != hipSuccess || per_cu < 1) { fprintf(stderr, "kernel_launch: occupancy query says %d\n", per_cu); per_cu = 1; }
        (void)hipGetLastError();
        grid = cus * per_cu;
        fprintf(stderr, "kernel_launch: grid %d (cus %d x %d)\n", grid, cus, per_cu);
    }
    if (grid < 0) return;
    if (hipMemsetAsync((char*)d_ws + WS_MOD, 0, CTL_ZERO_BYTES, stream) != hipSuccess) { fprintf(stderr, "kernel_launch: memset failed\n"); return; }
    Args a{};
    for (int i = 0; i < 17; ++i) a.in[i] = (const float*)d_in[i];
    a.out = (float*)d_out; a.ws = (unsigned char*)d_ws;
    if (N_LAUNCHES == 1) {
        a.ph_lo = 0; a.ph_hi = NPHASE;
        void* kargs[] = {&a};
        const hipError_t e = hipLaunchCooperativeKernel((const void*)fwd, dim3(grid), dim3(512), kargs, LDS_BYTES, stream);
        if (e != hipSuccess) fprintf(stderr, "kernel_launch: cooperative launch failed: %s (grid %d)\n", hipGetErrorString(e), grid);
    } else {
        for (int p = 0; p < NPHASE; ++p) { a.ph_lo = p; a.ph_hi = p + 1;
            hipLaunchKernelGGL(fwd, dim3(grid), dim3(512), LDS_BYTES, stream, a);
            const hipError_t le = hipPeekAtLastError();
            if (le != hipSuccess) { fprintf(stderr, "kernel_launch: launch %d failed: %s\n", p, hipGetErrorName(le)); break; } }
    }
}
```

```cpp
#include <hip/hip_runtime.h>
#include <hip/hip_bf16.h>
#include <hip/hip_cooperative_groups.h>
#include <cstdio>
#include <cstdint>
#include <cmath>
#define N_LAUNCHES 1
namespace pg8 {
#define PG8_LAS __attribute__((address_space(3)))
typedef unsigned short bf16_t;
typedef short bf16x8 __attribute__((ext_vector_type(8)));
typedef float f32x4 __attribute__((ext_vector_type(4)));
typedef unsigned u32x4 __attribute__((ext_vector_type(4)));
constexpr int BM = 256, BK = 64, HALF = 128, HTB = HALF * BK * 2  , STAGE_BYTES = 8 * HTB, NXCD = 8, WGM = 4;

__host__ __device__ __forceinline__ int lds_byte(int r, int c) { const int st = (r >> 4) * 2 + (c >> 5), rr = r & 15, cc = c & 31, ob = rr * 64 + cc * 2; return st * 1024 + (ob ^ (((ob >> 9) & 1) << 5)); }
__host__ __device__ __forceinline__ void stage_rc(int b, int& R, int& C) { const int st = b / 1024, sb = b % 1024, swz = sb ^ (((sb >> 9) & 1) << 5); R = (st >> 1) * 16 + swz / 64; C = (st & 1) * 32 + (swz % 64) / 2; }
__host__ __device__ __forceinline__ int perm32(int rho) { const int n = rho >> 4, i = rho & 15; return 8 * (i >> 2) + 4 * n + (i & 3); }

struct Unit { int pm, pn; };
struct Gemm { const bf16_t* A; const bf16_t* Bt; int M, N, K, ld; };

struct StaticOrder {
    int nM, nN, nwg, G, c;
    __host__ __device__ void init(int M, int N, int G_, int c_) { nM = M / BM; nN = N / BM; nwg = nM * nN; G = G_; c = c_; }
    __host__ __device__ bool next(int i, Unit& u) const {
        const long L = (long)i * G + c; if (L >= nwg) return false;
        int wgid = (int)L; { const int q = nwg / NXCD, r = nwg % NXCD, xcd = wgid % NXCD, off = wgid / NXCD; wgid = (xcd < r ? xcd * (q + 1) : r * (q + 1) + (xcd - r) * q) + off; }
        const int nig = WGM * nN, gid = wgid / nig, fm = gid * WGM, gsz = (nM - fm) < WGM ? (nM - fm) : WGM;
        u.pm = fm + ((wgid % nig) % gsz); u.pn = ((wgid % nig) / gsz + (c & 7) * (nN >> 3)) % nN; return true;
    }
    __device__ __forceinline__ void a_ready(const Unit&) const {}
    __device__ __forceinline__ void done(const Unit&) const {}
};

__device__ __forceinline__ unsigned cvt_pk_bf16(float lo, float hi) { unsigned r; asm volatile("v_cvt_pk_bf16_f32 %0, %1, %2" : "=v"(r) : "v"(lo), "v"(hi)); return r; }
constexpr int PH = 2176  , PA = 5760  , PKV = 640  , PNB = 1152  ;
__device__ __forceinline__ float bflo(unsigned w) { return __uint_as_float(w << 16); }
__device__ __forceinline__ float bfhi(unsigned w) { return __uint_as_float(w & 0xffff0000u); }
struct EpiProj {
    static constexpr bool PERM = true, AFTER_DRAIN = false;
    bf16_t *QAB, *KVA, *KB, *VB, *GA, *GB;
    __device__ __forceinline__ void operator()(const f32x4 (&acc)[2][2][4][2], const Unit& u, int wr, int wc, int fr, int fq) const {
        const int pn = u.pn; bf16_t* base; int ldc, colt;
        if (pn < 4) { base = QAB; ldc = PH; colt = pn * 256; }
        else if (pn < 6) { base = KVA; ldc = PKV; colt = (pn - 4) * 256; }
        else if (pn < 10) { base = QAB; ldc = PH; colt = 1024 + (pn - 6) * 256; }
        else if (pn < 14) { base = KB; ldc = PNB; colt = (pn - 10) * 256; }
        else if (pn < 18) { base = VB; ldc = PNB; colt = (pn - 14) * 256; }
        else if (pn < 26) { base = GA; ldc = PH; colt = (pn - 18) * 256; }
        else { base = GB; ldc = PH; colt = (pn - 26) * 256; }
        const int row0 = u.pm * BM + wr * 64 + fr, col0 = colt + wc * 32 + 8 * fq;
#pragma unroll
        for (int ai = 0; ai < 2; ++ai)
#pragma unroll
            for (int m = 0; m < 4; ++m) { bf16_t* rowp = base + (size_t)(row0 + ai * HALF + m * 16) * ldc + col0;
#pragma unroll
                for (int bj = 0; bj < 2; ++bj) { const f32x4 v0 = acc[ai][bj][m][0], v1 = acc[ai][bj][m][1];
                    u32x4 w; w.x = cvt_pk_bf16(v0[0], v0[1]); w.y = cvt_pk_bf16(v0[2], v0[3]); w.z = cvt_pk_bf16(v1[0], v1[1]); w.w = cvt_pk_bf16(v1[2], v1[3]);
                    *(u32x4*)(rowp + bj * HALF) = w; } }
    }
};
struct EpiMerged {
    static constexpr bool PERM = true, AFTER_DRAIN = false;
    const bf16_t *GA, *GB; bf16_t* O;
    __device__ __forceinline__ void mid(f32x4 (&acc)[2][2][4][2], const Unit& u, int wr, int wc, int fr, int fq) const {
        int row0 = u.pm * BM + wr * 64 + fr; const int col0 = u.pn * BM + wc * 32 + 8 * fq;
        asm volatile("" : "+v"(row0));
#pragma unroll
        for (int ai = 0; ai < 2; ++ai)
#pragma unroll
            for (int m = 0; m < 4; ++m)
#pragma unroll
                for (int bj = 0; bj < 2; ++bj) { const size_t off = (size_t)(row0 + ai * HALF + m * 16) * PH + col0 + bj * HALF;
                    const u32x4 a = *(const u32x4*)(GA + off), b = *(const u32x4*)(GB + off);
#pragma unroll
                    for (int e = 0; e < 4; ++e) { const float ga0 = bflo(a[e]), ga1 = bfhi(a[e]), gb0 = bflo(b[e]), gb1 = bfhi(b[e]);
                        const float r0 = (1.f + __expf(-gb0)) * __builtin_amdgcn_rcpf(1.f + __expf(-ga0)), r1 = (1.f + __expf(-gb1)) * __builtin_amdgcn_rcpf(1.f + __expf(-ga1));
                        acc[ai][bj][m][e >> 1][(e & 1) * 2] *= r0; acc[ai][bj][m][e >> 1][(e & 1) * 2 + 1] *= r1; }
                    if (bj == 1 && (m & 1)) asm volatile("" ::: "memory"); }
    }
    __device__ __forceinline__ void operator()(const f32x4 (&acc)[2][2][4][2], const Unit& u, int wr, int wc, int fr, int fq) const {
        const int row0 = u.pm * BM + wr * 64 + fr, col0 = u.pn * BM + wc * 32 + 8 * fq;
#pragma unroll
        for (int ai = 0; ai < 2; ++ai)
#pragma unroll
            for (int m = 0; m < 4; ++m)
#pragma unroll
                for (int bj = 0; bj < 2; ++bj) { const size_t off = (size_t)(row0 + ai * HALF + m * 16) * PH + col0 + bj * HALF;
                    const u32x4 b = *(const u32x4*)(GB + off); float o[8];
#pragma unroll
                    for (int e = 0; e < 4; ++e) { const float gb0 = bflo(b[e]), gb1 = bfhi(b[e]);
                        o[2 * e] = acc[ai][bj][m][e >> 1][(e & 1) * 2] * __builtin_amdgcn_rcpf(1.f + __expf(-gb0)); o[2 * e + 1] = acc[ai][bj][m][e >> 1][(e & 1) * 2 + 1] * __builtin_amdgcn_rcpf(1.f + __expf(-gb1)); }
                    u32x4 w; w.x = cvt_pk_bf16(o[0], o[1]); w.y = cvt_pk_bf16(o[2], o[3]); w.z = cvt_pk_bf16(o[4], o[5]); w.w = cvt_pk_bf16(o[6], o[7]);
                    *(u32x4*)(O + off) = w; }
    }
};
struct EpiResid {
    static constexpr bool PERM = false, AFTER_DRAIN = false;
    const float* base; float* out; const float* g;
    __device__ __forceinline__ void operator()(const f32x4 (&acc)[2][2][4][2], const Unit& u, int wr, int wc, int fr, int fq) const {
        const int row0 = u.pm * BM + wr * 64 + fr, col0 = u.pn * BM + wc * 32 + 4 * fq;
        f32x4 gv[2][2];
#pragma unroll
        for (int bj = 0; bj < 2; ++bj)
#pragma unroll
            for (int n = 0; n < 2; ++n) gv[bj][n] = *(const f32x4*)(g + col0 + bj * HALF + n * 16);
#pragma unroll
        for (int ai = 0; ai < 2; ++ai)
#pragma unroll
            for (int m = 0; m < 4; ++m) { const size_t off = (size_t)(row0 + ai * HALF + m * 16) * 2048 + col0;
#pragma unroll
                for (int bj = 0; bj < 2; ++bj)
#pragma unroll
                    for (int n = 0; n < 2; ++n) { const f32x4 bs = *(const f32x4*)(base + off + bj * HALF + n * 16);
                        *(f32x4*)(out + off + bj * HALF + n * 16) = bs + gv[bj][n] * acc[ai][bj][m][n]; } }
    }
};
struct EpiSwiglu {
    static constexpr bool PERM = true, AFTER_DRAIN = false;
    bf16_t* O;
    __device__ __forceinline__ void operator()(const f32x4 (&acc)[2][2][4][2], const Unit& u, int wr, int wc, int fr, int fq) const {
        const int row0 = u.pm * BM + wr * 64 + fr, col0 = u.pn * HALF + wc * 32 + 8 * fq;
#pragma unroll
        for (int ai = 0; ai < 2; ++ai)
#pragma unroll
            for (int m = 0; m < 4; ++m) { float o[8];
#pragma unroll
                for (int n = 0; n < 2; ++n)
#pragma unroll
                    for (int e = 0; e < 4; ++e) { const float gt = acc[ai][0][m][n][e], up = acc[ai][1][m][n][e]; o[4 * n + e] = gt * up * __builtin_amdgcn_rcpf(1.f + __expf(-gt)); }
                u32x4 w; w.x = cvt_pk_bf16(o[0], o[1]); w.y = cvt_pk_bf16(o[2], o[3]); w.z = cvt_pk_bf16(o[4], o[5]); w.w = cvt_pk_bf16(o[6], o[7]);
                *(u32x4*)(O + (size_t)(row0 + ai * HALF + m * 16) * PA + col0) = w; }
    }
};

struct EpiNull {
    static constexpr bool PERM = false, AFTER_DRAIN = false;
    float* out;
    __device__ __forceinline__ void operator()(const f32x4 (&acc)[2][2][4][2], const Unit& u, int wr, int wc, int fr, int fq) const {
        f32x4 s = {0.f, 0.f, 0.f, 0.f};
#pragma unroll
        for (int ai = 0; ai < 2; ++ai)
#pragma unroll
            for (int bj = 0; bj < 2; ++bj)
#pragma unroll
                for (int m = 0; m < 4; ++m)
#pragma unroll
                    for (int n = 0; n < 2; ++n) s += acc[ai][bj][m][n];
        if (s[0] + s[1] + s[2] + s[3] == 123456.789f) out[u.pm] = 1.f;
    }
};

struct EpiDelta {
    static constexpr bool PERM = true, AFTER_DRAIN = false;
    bf16_t* O; const float* g;
    __device__ __forceinline__ void operator()(const f32x4 (&acc)[2][2][4][2], const Unit& u, int wr, int wc, int fr, int fq) const {
        const int row0 = u.pm * BM + wr * 64 + fr, col0 = u.pn * BM + wc * 32 + 8 * fq;
        f32x4 gv[2][2];
#pragma unroll
        for (int bj = 0; bj < 2; ++bj)
#pragma unroll
            for (int n = 0; n < 2; ++n) gv[bj][n] = *(const f32x4*)(g + col0 + bj * HALF + 4 * n);
#pragma unroll
        for (int ai = 0; ai < 2; ++ai)
#pragma unroll
            for (int m = 0; m < 4; ++m) { bf16_t* rowp = O + (size_t)(row0 + ai * HALF + m * 16) * PH + col0;
#pragma unroll
                for (int bj = 0; bj < 2; ++bj) { const f32x4 v0 = acc[ai][bj][m][0] * gv[bj][0], v1 = acc[ai][bj][m][1] * gv[bj][1];
                    u32x4 w; w.x = cvt_pk_bf16(v0[0], v0[1]); w.y = cvt_pk_bf16(v0[2], v0[3]); w.z = cvt_pk_bf16(v1[0], v1[1]); w.w = cvt_pk_bf16(v1[2], v1[3]);
                    *(u32x4*)(rowp + bj * HALF) = w; } }
    }
};
template <class Epi, class Sched, bool ALIGN_EPI = false, bool SP2 = false, bool MID = false>
__device__ __forceinline__ void gemm_phase(PG8_LAS unsigned char* lds, const Gemm g, const Sched& S, const Epi& E, int tid_in) {
    int tid_ = tid_in; asm volatile("" : "+v"(tid_));
    const int tid = tid_, wid = __builtin_amdgcn_readfirstlane(tid >> 6), lane = tid & 63, wr = wid >> 2, wc = wid & 3, fr = lane & 15, fq = lane >> 4;
    const int K = g.K, nt = K / BK, LD = g.ld;
    unsigned voffA[2], voffB[2];
#pragma unroll
    for (int i = 0; i < 2; ++i) { int R, C; stage_rc(tid * 16 + i * 8192, R, C); const int Rb = Epi::PERM ? ((R & ~31) + perm32(R & 31)) : R;
        voffA[i] = (unsigned)(R * LD + C) * 2u; voffB[i] = (unsigned)(Rb * LD + C) * 2u; }
    const size_t kstep = (size_t)(BK * 2);
    const size_t hstep = (size_t)HALF * LD * 2;
    const size_t tstep = 2 * hstep;
    const unsigned ldsw = (unsigned)wid * 1024u;
    const int aoff = lds_byte(wr * 64 + fr, fq * 8), boff = lds_byte(wc * 32 + fr, fq * 8);
#define PG8_SA(b, h) (((b) * 2 + (h)) * HTB)
#define PG8_SB(b, h) ((4 + (b) * 2 + (h)) * HTB)
#define PG8_STAGE(bufoff, gbase, voff) do { _Pragma("unroll") for (int _i = 0; _i < 2; ++_i) \
        __builtin_amdgcn_global_load_lds((const unsigned*)((const char*)(gbase) + (voff)[_i]), (PG8_LAS unsigned*)(lds + (bufoff) + ldsw + _i * 8192), 16, 0, 0); } while (0)
#define PG8_LDA(dst, b, h) do { _Pragma("unroll") for (int m = 0; m < 4; ++m) _Pragma("unroll") for (int k = 0; k < 2; ++k) dst[m][k] = *(const PG8_LAS bf16x8*)(lds + PG8_SA(b, h) + aoff + m * 2048 + k * 1024); } while (0)
#define PG8_LDB(dst, b, h) do { _Pragma("unroll") for (int n = 0; n < 2; ++n) _Pragma("unroll") for (int k = 0; k < 2; ++k) dst[n][k] = *(const PG8_LAS bf16x8*)(lds + PG8_SB(b, h) + boff + n * 2048 + k * 1024); } while (0)
#define PG8_MMA(ai, bj, At, Bt) do { __builtin_amdgcn_s_setprio(1); _Pragma("unroll") for (int m = 0; m < 4; ++m) _Pragma("unroll") for (int n = 0; n < 2; ++n) _Pragma("unroll") for (int k = 0; k < 2; ++k) \
        acc[ai][bj][m][n] = __builtin_amdgcn_mfma_f32_16x16x32_bf16(Bt[n][k], At[m][k], acc[ai][bj][m][n], 0, 0, 0); __builtin_amdgcn_s_setprio(0); } while (0)
#define PG8_WAIT_V(n) asm volatile("s_waitcnt vmcnt(" #n ")" ::: "memory")
#define PG8_WAIT_L(n) asm volatile("s_waitcnt lgkmcnt(" #n ")" ::: "memory")
#define PG8_BAR __builtin_amdgcn_s_barrier()
#define PG8_SCHED __builtin_amdgcn_sched_barrier(0)
    Unit cur, nxt; int ui = 0;
    if (!S.next(0, cur)) return;
    f32x4 acc[2][2][4][2];
#pragma unroll
    for (int a = 0; a < 2; ++a)
#pragma unroll
        for (int b = 0; b < 2; ++b)
#pragma unroll
            for (int m = 0; m < 4; ++m)
#pragma unroll
                for (int n = 0; n < 2; ++n) acc[a][b][m][n] = (f32x4){0.f, 0.f, 0.f, 0.f};
    bf16x8 At[4][2], B0[2][2], B1[2][2];
    const char* cA = (const char*)g.A + (size_t)cur.pm * tstep; const char* cB = (const char*)g.Bt + (size_t)cur.pn * tstep;
    S.a_ready(cur);
    if constexpr (SP2) {
        PG8_STAGE(PG8_SB(0, 0), cB, voffB); PG8_STAGE(PG8_SB(0, 1), cB + hstep, voffB); PG8_STAGE(PG8_SA(0, 0), cA, voffA); PG8_STAGE(PG8_SA(0, 1), cA + hstep, voffA);
        if (wr == 1) PG8_BAR;
        PG8_WAIT_V(2); PG8_BAR;
        PG8_STAGE(PG8_SB(1, 0), cB + kstep, voffB); PG8_STAGE(PG8_SA(1, 0), cA + kstep, voffA); PG8_STAGE(PG8_SB(1, 1), cB + hstep + kstep, voffB);
        PG8_WAIT_V(6); PG8_BAR;
    } else {
        PG8_STAGE(PG8_SB(0, 0), cB, voffB); PG8_STAGE(PG8_SA(0, 0), cA, voffA); PG8_STAGE(PG8_SB(0, 1), cB + hstep, voffB); PG8_STAGE(PG8_SA(0, 1), cA + hstep, voffA);
        if (wr == 1) PG8_BAR;
        PG8_WAIT_V(4); PG8_BAR;
        PG8_STAGE(PG8_SB(1, 0), cB + kstep, voffB); PG8_STAGE(PG8_SA(1, 0), cA + kstep, voffA); PG8_STAGE(PG8_SB(1, 1), cB + hstep + kstep, voffB);
        PG8_WAIT_V(6); PG8_BAR;
    }
    for (;;) {
        const bool has_next = S.next(ui + 1, nxt);
        const char* nA = has_next ? (const char*)g.A + (size_t)nxt.pm * tstep : cA; const char* nB = has_next ? (const char*)g.Bt + (size_t)nxt.pn * tstep : cB;
        for (int t = 0; t < nt; t += 2) {
            if constexpr (MID) { if (t == (nt >> 1)) E.mid(acc, cur, wr, wc, fr, fq); }
            const bool last = (t == nt - 2);
            const char* a1 = cA + (size_t)(t + 1) * kstep;
            const char* a2 = last ? nA : cA + (size_t)(t + 2) * kstep; const char* b2 = last ? nB : cB + (size_t)(t + 2) * kstep;
            const char* a3 = a2 + kstep; const char* b3 = b2 + kstep;
            if (last && has_next) S.a_ready(nxt);
            if constexpr (SP2) {
            PG8_LDB(B0, 0, 0); PG8_LDB(B1, 0, 1); PG8_SCHED; PG8_LDA(At, 0, 0); PG8_STAGE(PG8_SA(1, 1), a1 + hstep, voffA);
            PG8_WAIT_V(8); PG8_WAIT_L(0); PG8_BAR; PG8_MMA(0, 0, At, B0); PG8_MMA(0, 1, At, B1); PG8_BAR; PG8_SCHED;
            PG8_LDA(At, 0, 1); PG8_STAGE(PG8_SB(0, 0), b2, voffB); PG8_STAGE(PG8_SB(0, 1), b2 + hstep, voffB); PG8_STAGE(PG8_SA(0, 0), a2, voffA);
            PG8_WAIT_V(8); PG8_WAIT_L(0); PG8_BAR; PG8_MMA(1, 0, At, B0); PG8_MMA(1, 1, At, B1); PG8_BAR; PG8_SCHED;
            PG8_LDB(B0, 1, 0); PG8_LDB(B1, 1, 1); PG8_SCHED; PG8_LDA(At, 1, 0); PG8_STAGE(PG8_SA(0, 1), a2 + hstep, voffA);
            PG8_WAIT_V(8); PG8_WAIT_L(0); PG8_BAR; PG8_MMA(0, 0, At, B0); PG8_MMA(0, 1, At, B1); PG8_BAR; PG8_SCHED;
            PG8_LDA(At, 1, 1); PG8_STAGE(PG8_SB(1, 0), b3, voffB); PG8_STAGE(PG8_SB(1, 1), b3 + hstep, voffB); PG8_STAGE(PG8_SA(1, 0), a3, voffA);
            PG8_WAIT_V(8); PG8_WAIT_L(0); PG8_BAR; PG8_MMA(1, 0, At, B0); PG8_MMA(1, 1, At, B1); PG8_BAR; PG8_SCHED;
            } else {
            PG8_LDB(B0, 0, 0); PG8_SCHED; PG8_LDA(At, 0, 0); PG8_STAGE(PG8_SA(1, 1), a1 + hstep, voffA);
            PG8_WAIT_L(8); PG8_BAR; PG8_WAIT_L(0); PG8_MMA(0, 0, At, B0); PG8_BAR; PG8_SCHED;
            PG8_LDB(B1, 0, 1); PG8_STAGE(PG8_SB(0, 0), b2, voffB);
            PG8_BAR; PG8_WAIT_L(0); PG8_MMA(0, 1, At, B1); PG8_BAR;
            PG8_LDA(At, 0, 1); PG8_STAGE(PG8_SA(0, 0), a2, voffA);
            PG8_BAR; PG8_WAIT_L(0); PG8_MMA(1, 0, At, B0); PG8_BAR; PG8_SCHED;
            PG8_STAGE(PG8_SB(0, 1), b2 + hstep, voffB);
            PG8_WAIT_V(6); PG8_BAR; PG8_MMA(1, 1, At, B1); PG8_BAR;
            PG8_LDB(B0, 1, 0); PG8_SCHED; PG8_LDA(At, 1, 0); PG8_STAGE(PG8_SA(0, 1), a2 + hstep, voffA);
            PG8_WAIT_L(8); PG8_BAR; PG8_WAIT_L(0); PG8_MMA(0, 0, At, B0); PG8_BAR; PG8_SCHED;
            PG8_LDB(B1, 1, 1); PG8_STAGE(PG8_SB(1, 0), b3, voffB);
            PG8_BAR; PG8_WAIT_L(0); PG8_MMA(0, 1, At, B1); PG8_BAR;
            PG8_LDA(At, 1, 1); PG8_STAGE(PG8_SA(1, 0), a3, voffA);
            PG8_BAR; PG8_WAIT_L(0); PG8_MMA(1, 0, At, B0); PG8_BAR; PG8_SCHED;
            PG8_STAGE(PG8_SB(1, 1), b3 + hstep, voffB);
            PG8_WAIT_V(6); PG8_BAR; PG8_MMA(1, 1, At, B1); PG8_BAR;
            }
        }
        if constexpr (ALIGN_EPI) { if (wr == 0) PG8_BAR; }
        if constexpr (!Epi::AFTER_DRAIN) { E(acc, cur, wr, wc, fr, fq); S.done(cur); }
        if (!has_next) break;
#pragma unroll
        for (int a = 0; a < 2; ++a)
#pragma unroll
            for (int b = 0; b < 2; ++b)
#pragma unroll
                for (int m = 0; m < 4; ++m)
#pragma unroll
                    for (int n = 0; n < 2; ++n) acc[a][b][m][n] = (f32x4){0.f, 0.f, 0.f, 0.f};
        cur = nxt; cA = nA; cB = nB; ++ui;
        if constexpr (ALIGN_EPI) { if (wr == 1) PG8_BAR; }
    }
    PG8_WAIT_V(0);
    if constexpr (!ALIGN_EPI) { if (wr == 0) PG8_BAR; }
    PG8_BAR;
    if constexpr (Epi::AFTER_DRAIN) { E.fused(acc, cur, wr, wc, fr, fq, lds, wid, lane); S.done(cur); }
#undef PG8_SA
#undef PG8_SB
#undef PG8_STAGE
#undef PG8_LDA
#undef PG8_LDB
#undef PG8_MMA
#undef PG8_WAIT_V
#undef PG8_WAIT_L
#undef PG8_BAR
#undef PG8_SCHED
}
}
namespace att {
using bf16 = __hip_bfloat16;
constexpr int D = 128, NW = 8, QBLK = 32, KVBLK = 64;
constexpr float SCALE = 0.088388347648318440f;
constexpr float THR = 8.f;
constexpr int SDEPTH = 2;
constexpr size_t SHM_V = KVBLK * D * 2, SHM_K = KVBLK * D * 2, SHM_ATTN = 2 * SHM_V + 2 * SHM_K + NW * 64 * 4;
using bf16x8 = __attribute__((ext_vector_type(8))) short;
using s16x4  = __attribute__((ext_vector_type(4))) short;
using f32x16 = __attribute__((ext_vector_type(16))) float;
using f32x8  = __attribute__((ext_vector_type(8))) float;
using u32x4  = __attribute__((ext_vector_type(4))) unsigned;
#define KSWZ(row, colB) ((row) * 256 + ((colB) ^ (((row) & 7) << 4)))
#define SBAR() __builtin_amdgcn_sched_barrier(0)
__device__ __forceinline__ int crow(int r, int hi) { return (r & 3) + 8 * (r >> 2) + 4 * hi; }
__device__ __forceinline__ unsigned cvtpk(float lo, float hi) {
  unsigned r; asm volatile("v_cvt_pk_bf16_f32 %0, %1, %2" : "=v"(r) : "v"(lo), "v"(hi)); return r;
}
template <typename TIn> struct Stage;
template <> struct Stage<bf16>  { using T = bf16x8;
  __device__ static __forceinline__ T ld8(const bf16* p) { return *reinterpret_cast<const bf16x8*>(p); }
  __device__ static __forceinline__ bf16x8 tobf(T x) { return x; } };
template <> struct Stage<float> { using T = f32x8;
  __device__ static __forceinline__ T ld8(const float* p) { return *reinterpret_cast<const f32x8*>(p); }
  __device__ static __forceinline__ bf16x8 tobf(T x) {
    u32x4 w = {cvtpk(x[0], x[1]), cvtpk(x[2], x[3]), cvtpk(x[4], x[5]), cvtpk(x[6], x[7])}; return *reinterpret_cast<bf16x8*>(&w); } };

__device__ __forceinline__ void partialSM(f32x16& p0, f32x16& p1, float& m_reg, float& mn, float& alpha) {
  constexpr float C = SCALE * 1.4426950408889634f;
  float pmax = p0[0]; for (int r = 1; r < 16; ++r) pmax = fmaxf(pmax, p0[r]); for (int r = 0; r < 16; ++r) pmax = fmaxf(pmax, p1[r]);
  { auto rr = __builtin_amdgcn_permlane32_swap(__float_as_uint(pmax), __float_as_uint(pmax), false, false);
    pmax = fmaxf(__uint_as_float(rr[0]), __uint_as_float(rr[1])); }
  if (__builtin_expect(__all(pmax - m_reg <= THR / SCALE), 1)) { mn = m_reg; alpha = 1.f; }
  else { mn = fmaxf(m_reg, pmax); alpha = __builtin_amdgcn_exp2f((m_reg - mn) * C); m_reg = mn; }
  float mnC = -mn * C;
  for (int r = 0; r < 16; ++r) p0[r] = fmaf(p0[r], C, mnC); for (int r = 0; r < 16; ++r) p1[r] = fmaf(p1[r], C, mnC);
  for (int r = 0; r < 16; ++r) p0[r] = __builtin_amdgcn_exp2f(p0[r]);
}
__device__ __forceinline__ void finishSM(f32x16& p0, f32x16& p1, float alpha, float& l_reg, bf16x8& pa0, bf16x8& pa1, bf16x8& pa2, bf16x8& pa3) {
  for (int r = 0; r < 16; ++r) p1[r] = __builtin_amdgcn_exp2f(p1[r]);
  float ps = 0; for (int r = 0; r < 16; ++r) ps += p0[r]; for (int r = 0; r < 16; ++r) ps += p1[r];
  { auto rr = __builtin_amdgcn_permlane32_swap(__float_as_uint(ps), __float_as_uint(ps), false, false);
    ps = __uint_as_float(rr[0]) + __uint_as_float(rr[1]); }
  l_reg = l_reg * alpha + ps;
#define PK4(P, BASE, OUT) do { unsigned a0 = cvtpk(P[BASE + 0], P[BASE + 1]), a1 = cvtpk(P[BASE + 2], P[BASE + 3]);   \
    unsigned b0 = cvtpk(P[BASE + 4], P[BASE + 5]), b1 = cvtpk(P[BASE + 6], P[BASE + 7]);                              \
    auto r0 = __builtin_amdgcn_permlane32_swap(a0, b0, false, false); auto r1 = __builtin_amdgcn_permlane32_swap(a1, b1, false, false); \
    u32x4 w = {r0[0], r1[0], r0[1], r1[1]}; OUT = *reinterpret_cast<bf16x8*>(&w); } while (0)
  PK4(p0, 0, pa0); PK4(p0, 8, pa1); PK4(p1, 0, pa2); PK4(p1, 8, pa3);
#undef PK4
}
__device__ __forceinline__ void qkt(f32x16& p0, f32x16& p1, const bf16* Ks, const bf16x8* qr, int r32, int hi) {
  p0 = f32x16{}; p1 = f32x16{};
  for (int d0 = 0; d0 < 8; ++d0) { int cb = (d0 * 16 + hi * 8) * 2;
    bf16x8 b0 = *reinterpret_cast<const bf16x8*>((const char*)Ks + KSWZ(r32, cb));
    bf16x8 b1 = *reinterpret_cast<const bf16x8*>((const char*)Ks + KSWZ(32 + r32, cb));
    p0 = __builtin_amdgcn_mfma_f32_32x32x16_bf16(b0, qr[d0], p0, 0, 0, 0);
    p1 = __builtin_amdgcn_mfma_f32_32x32x16_bf16(b1, qr[d0], p1, 0, 0, 0); }
}
__device__ __forceinline__ int v_st(int k, int c) { const int kk = (k & ~0xC) | ((k & 4) << 1) | ((k & 8) >> 1); return ((kk >> 3) * 4 + (c >> 5)) * 512 + ((kk & 7) * 32 + (c & 31)) * 2; }
__device__ __forceinline__ int v_rd_base(int lane) { return ((lane & 3) << 3) | (((lane >> 2) & 3) << 6) | (((lane >> 4) & 1) << 5) | (((lane >> 5) & 1) << 8); }
constexpr int v_rd_off(int d0, int ks, int half) { return d0 * 512 + ks * 4096 + half * 2048; }
template <int OFF> __device__ __forceinline__ s16x4 tr_read(int vb) {
  s16x4 r; asm volatile("ds_read_b64_tr_b16 %0, %1 offset:%2" : "=&v"(r) : "v"(vb), "i"(OFF) : "memory"); return r;
}
template <int D0> __device__ __forceinline__ void pv_one(f32x16& od, int vb, bf16x8 pa0, bf16x8 pa1, bf16x8 pa2, bf16x8 pa3) {
  const s16x4 l0 = tr_read<v_rd_off(D0, 0, 0)>(vb), h0 = tr_read<v_rd_off(D0, 0, 1)>(vb), l1 = tr_read<v_rd_off(D0, 1, 0)>(vb), h1 = tr_read<v_rd_off(D0, 1, 1)>(vb);
  const s16x4 l2 = tr_read<v_rd_off(D0, 2, 0)>(vb), h2 = tr_read<v_rd_off(D0, 2, 1)>(vb), l3 = tr_read<v_rd_off(D0, 3, 0)>(vb), h3 = tr_read<v_rd_off(D0, 3, 1)>(vb);
  asm volatile("s_waitcnt lgkmcnt(0)" ::: "memory"); SBAR();
#define PK(L, H) (bf16x8){L[0], L[1], L[2], L[3], H[0], H[1], H[2], H[3]}
  od = __builtin_amdgcn_mfma_f32_32x32x16_bf16(pa0, PK(l0, h0), od, 0, 0, 0);
  od = __builtin_amdgcn_mfma_f32_32x32x16_bf16(pa1, PK(l1, h1), od, 0, 0, 0);
  od = __builtin_amdgcn_mfma_f32_32x32x16_bf16(pa2, PK(l2, h2), od, 0, 0, 0);
  od = __builtin_amdgcn_mfma_f32_32x32x16_bf16(pa3, PK(l3, h3), od, 0, 0, 0);
#undef PK
}
__device__ __forceinline__ void pv_d0(f32x16* o, int vb, bf16x8 pa0, bf16x8 pa1, bf16x8 pa2, bf16x8 pa3) {
  pv_one<0>(o[0], vb, pa0, pa1, pa2, pa3); pv_one<1>(o[1], vb, pa0, pa1, pa2, pa3); pv_one<2>(o[2], vb, pa0, pa1, pa2, pa3); pv_one<3>(o[3], vb, pa0, pa1, pa2, pa3);
}
__device__ __forceinline__ void na_mask(f32x16& p0, f32x16& p1, const float* T, int tb, int kk, bool rowvalid) {
#pragma unroll
  for (int q = 0; q < 4; ++q) {
#pragma unroll
    for (int r = 4 * q; r < 4 * q + 4; ++r) { const int cr = (r & 3) + 8 * (r >> 2);
      const float b0 = T[tb + cr]; const bool v0 = rowvalid && (unsigned)(cr + kk) < 16u; p0[r] = v0 ? p0[r] + b0 : -INFINITY; }
    asm volatile("" ::: "memory");
#pragma unroll
    for (int r = 4 * q; r < 4 * q + 4; ++r) { const int cr = (r & 3) + 8 * (r >> 2);
      const float b1 = T[tb + 32 + cr]; const bool v1 = rowvalid && (unsigned)(cr + 32 + kk) < 16u; p1[r] = v1 ? p1[r] + b1 : -INFINITY; }
    asm volatile("" ::: "memory");
  }
}
__device__ __forceinline__ void partialSM_fx(f32x16& p0, f32x16& p1, float negMc) {
  (void)negMc;
  for (int r = 0; r < 16; ++r) p0[r] = __builtin_amdgcn_exp2f(p0[r]);
}
__device__ __forceinline__ void finishSM_fx(f32x16& p0, f32x16& p1, float& l_reg, bf16x8& pa0, bf16x8& pa1, bf16x8& pa2, bf16x8& pa3) {
  for (int r = 0; r < 16; ++r) p1[r] = __builtin_amdgcn_exp2f(p1[r]);
  float ps = 0; for (int r = 0; r < 16; ++r) ps += p0[r]; for (int r = 0; r < 16; ++r) ps += p1[r];
  l_reg += ps;
#define PK4(P, BASE, OUT) do { unsigned a0 = cvtpk(P[BASE + 0], P[BASE + 1]), a1 = cvtpk(P[BASE + 2], P[BASE + 3]);   \
    unsigned b0 = cvtpk(P[BASE + 4], P[BASE + 5]), b1 = cvtpk(P[BASE + 6], P[BASE + 7]);                              \
    auto r0 = __builtin_amdgcn_permlane32_swap(a0, b0, false, false); auto r1 = __builtin_amdgcn_permlane32_swap(a1, b1, false, false); \
    u32x4 w = {r0[0], r1[0], r0[1], r1[1]}; OUT = *reinterpret_cast<bf16x8*>(&w); } while (0)
  PK4(p0, 0, pa0); PK4(p0, 8, pa1); PK4(p1, 0, pa2); PK4(p1, 8, pa3);
#undef PK4
}
__device__ __forceinline__ void qkt_i(f32x16& p0, f32x16& p1, const bf16* Ks, const bf16x8* qr, int r32, int hi, float init) {
  for (int r = 0; r < 16; ++r) { p0[r] = init; p1[r] = init; }
  for (int d0 = 0; d0 < 8; ++d0) { int cb = (d0 * 16 + hi * 8) * 2;
    bf16x8 b0 = *reinterpret_cast<const bf16x8*>((const char*)Ks + KSWZ(r32, cb));
    bf16x8 b1 = *reinterpret_cast<const bf16x8*>((const char*)Ks + KSWZ(32 + r32, cb));
    p0 = __builtin_amdgcn_mfma_f32_32x32x16_bf16(b0, qr[d0], p0, 0, 0, 0);
    p1 = __builtin_amdgcn_mfma_f32_32x32x16_bf16(b1, qr[d0], p1, 0, 0, 0); }
}
template <int LDO>
__device__ __forceinline__ void store_o_tile(const f32x16* o, const float* rli, char* lds, int wid, int lane, bf16* Ow) {
  const int r32 = lane & 31, hi = lane >> 5;
  char* T = lds + wid * 8192;
#pragma unroll
  for (int r = 0; r < 16; ++r) { const int orow = crow(r, hi);
#pragma unroll
    for (int d0 = 0; d0 < 4; ++d0) *reinterpret_cast<bf16*>(T + orow * 256 + (d0 * 32 + r32) * 2) = __float2bfloat16(o[d0][r] * rli[r]); }
  asm volatile("s_waitcnt lgkmcnt(0)" ::: "memory");
#pragma unroll
  for (int i = 0; i < 8; ++i) { const int idx = lane + 64 * i, row = idx >> 4, ch = idx & 15;
    const u32x4 w = *reinterpret_cast<const u32x4*>(T + row * 256 + ch * 16);
    *reinterpret_cast<u32x4*>(Ow + (long)row * LDO + ch * 8) = w; }
  asm volatile("s_waitcnt lgkmcnt(0)" ::: "memory");
}
template <int LDQ, int LDK, int LDO, bool NA, int SD, int VOFF>
__device__ __forceinline__ void attn_unit(const bf16* Qb, const bf16* __restrict__ Kh, const bf16* __restrict__ Vh_, bf16* Ob, int NT, char* lds,
                                          const float* __restrict__ rpb  , const float* __restrict__ f1  , int qrow0, int krow0, int tid_in) {
  using St = Stage<bf16>;
  const bf16* __restrict__ Vh = VOFF ? Kh + VOFF : Vh_;
  int tid_ = tid_in; asm volatile("" : "+v"(tid_));
  const int tid = tid_, wid = __builtin_amdgcn_readfirstlane(tid >> 6), lane = tid & 63, r32 = lane & 31, hi = lane >> 5;
  bf16* V_lds = (bf16*)lds; bf16* K_lds = (bf16*)(lds + 2 * SHM_V);
  float* ws = (float*)(lds + 2 * SHM_V + 2 * SHM_K) + wid * 64; float* li_l = ws; float* al_l = ws + 32;
  float* T = (float*)(lds + SHM_ATTN);
  __syncthreads();
  int na_tb0 = 0, na_kk = 0, na_r = 0, na_rs = 0;
  if constexpr (NA) {
    for (int e = tid; e < 15 * 128; e += 512) { const int rr = e >> 7, x = e & 127; T[e] = (x >= 49 && x <= 79) ? rpb[rr * 31 + x - 49] * (1.0f / SCALE) : 0.f;
    }
    const int c = (wid & 1) * 32 + r32; int cs = c - 8; cs = cs < 0 ? 0 : (cs > 48 ? 48 : cs);
    na_tb0 = 64 - c + 4 * hi; na_kk = 4 * hi - cs;
    na_r = qrow0 + (wid >> 1); na_rs = na_r - 4; na_rs = na_rs < 0 ? 0 : (na_rs > 248 ? 248 : na_rs);
  }
  float negMc = 0.f;
  if constexpr (!NA) {
    float mq = fmaxf(fabsf(rpb[lane]), fabsf(rpb[lane + 64])), mk = fmaxf(fabsf(f1[lane]), fabsf(f1[lane + 64]));
#pragma unroll
    for (int o_ = 1; o_ < 64; o_ <<= 1) { mq = fmaxf(mq, __shfl_xor(mq, o_)); mk = fmaxf(mk, __shfl_xor(mk, o_)); }
    const float M = fminf(11.3137085f * 1.01f * mq * mk, 60.f);
    negMc = -M * 1.4426950408889634f;
  }
#define PSM(P0, P1, MN, AL) do { if constexpr (NA) partialSM(P0, P1, m_reg, MN, AL); else partialSM_fx(P0, P1, negMc); } while (0)
#define FSM(P0, P1, AL) do { if constexpr (NA) finishSM(P0, P1, AL, l_reg, pa0, pa1, pa2, pa3); else finishSM_fx(P0, P1, l_reg, pa0, pa1, pa2, pa3); } while (0)
#define NAMASK(P0, P1, ti) do { if constexpr (NA) { SBAR(); const int kr_ = krow0 + (ti); const bool rv_ = (unsigned)(kr_ - na_rs) < 8u; int rr_ = kr_ - na_r + 7; rr_ = rv_ ? rr_ : 0; \
    na_mask(P0, P1, T, na_tb0 + rr_ * 128, na_kk, rv_); SBAR(); } } while (0)
  float m_reg = -1e30f, l_reg = 0; f32x16 o[4] = {}; bf16x8 qr[8];
  const bf16* Qw = Qb + (long)(wid * QBLK + r32) * LDQ + hi * 8;
#pragma unroll
  for (int d0 = 0; d0 < 8; ++d0) qr[d0] = St::ld8(Qw + d0 * 16);
  const int sr = tid >> 4, sc = (tid & 15) * 8, vst0 = v_st(sr, sc), vst1 = v_st(32 + sr, sc);
  const int vb0 = (int)(uintptr_t)V_lds + v_rd_base(lane);
  struct { typename St::T vs0, vs1, ks0, ks1; } sr_[SD];
#define SLOAD(i, k0) do { sr_[i].vs0 = St::ld8(&Vh[(long)((k0) + sr) * LDK + sc]); sr_[i].vs1 = St::ld8(&Vh[(long)((k0) + 32 + sr) * LDK + sc]); \
    sr_[i].ks0 = St::ld8(&Kh[(long)((k0) + sr) * LDK + sc]); sr_[i].ks1 = St::ld8(&Kh[(long)((k0) + 32 + sr) * LDK + sc]); } while (0)
#define SWRITE(b, i) do { *(bf16x8*)((char*)V_lds + (b) * SHM_V + vst0) = St::tobf(sr_[i].vs0);          \
    *(bf16x8*)((char*)V_lds + (b) * SHM_V + vst1) = St::tobf(sr_[i].vs1); int kc = sc * 2;               \
    *(bf16x8*)((char*)K_lds + (b) * SHM_K + KSWZ(sr, kc)) = St::tobf(sr_[i].ks0);                       \
    *(bf16x8*)((char*)K_lds + (b) * SHM_K + KSWZ(32 + sr, kc)) = St::tobf(sr_[i].ks1); } while (0)
#define SWAIT() do { if constexpr (SD == 2) asm volatile("s_waitcnt vmcnt(4)" ::: "memory"); else asm volatile("s_waitcnt vmcnt(0)" ::: "memory"); } while (0)
#define RESC(a) do { if constexpr (NA) if (__any((a) < 1.f)) { if (hi == 0) al_l[r32] = (a); asm volatile("s_waitcnt lgkmcnt(0)" ::: "memory"); \
    for (int d = 0; d < 4; ++d) for (int r = 0; r < 16; ++r) o[d][r] *= al_l[crow(r, hi)]; } } while (0)
  f32x16 pA0, pA1, pB0, pB1; float mnA, mnB, alA, alB; bf16x8 pa0, pa1, pa2, pa3;
  constexpr int SE = 0, SO = SD - 1;
  SLOAD(SE, 0); asm volatile("s_waitcnt vmcnt(0)" ::: "memory"); SWRITE(0, SE); __syncthreads();
  qkt_i(pA0, pA1, K_lds, qr, r32, hi, negMc); NAMASK(pA0, pA1, 0); PSM(pA0, pA1, mnA, alA);
  SLOAD(SO, KVBLK); if constexpr (SD == 2) { if (2 < NT) SLOAD(SE, 2 * KVBLK); }
  SWAIT(); SWRITE(1, SO); __syncthreads();
  for (int j = 1; j + 1 < NT; j += 2) {
    SBAR(); qkt_i(pB0, pB1, (bf16*)((char*)K_lds + SHM_K), qr, r32, hi, negMc);
    FSM(pA0, pA1, alA); SBAR();
    SLOAD(SO, (j + SD) * KVBLK); SBAR();
    pv_d0(o, vb0, pa0, pa1, pa2, pa3); NAMASK(pB0, pB1, j); PSM(pB0, pB1, mnB, alB);
    __syncthreads(); SWAIT(); SWRITE(0, SE);
    RESC(alB); __syncthreads();
    SBAR(); qkt_i(pA0, pA1, K_lds, qr, r32, hi, negMc);
    FSM(pB0, pB1, alB); SBAR();
    if (SD == 1 || j + 3 < NT) SLOAD(SE, (j + 1 + SD) * KVBLK); SBAR();
    pv_d0(o, vb0 + (int)SHM_V, pa0, pa1, pa2, pa3); NAMASK(pA0, pA1, j + 1); PSM(pA0, pA1, mnA, alA);
    __syncthreads(); SWAIT(); SWRITE(1, SO);
    RESC(alA); __syncthreads();
  }
  SBAR(); qkt_i(pB0, pB1, (bf16*)((char*)K_lds + SHM_K), qr, r32, hi, negMc);
  FSM(pA0, pA1, alA); SBAR();
  pv_d0(o, vb0, pa0, pa1, pa2, pa3); NAMASK(pB0, pB1, NT - 1); PSM(pB0, pB1, mnB, alB);
  __syncthreads(); RESC(alB);
  FSM(pB0, pB1, alB); SBAR();
  pv_d0(o, vb0 + (int)SHM_V, pa0, pa1, pa2, pa3);
  if constexpr (!NA) { auto rr_ = __builtin_amdgcn_permlane32_swap(__float_as_uint(l_reg), __float_as_uint(l_reg), false, false); l_reg = __uint_as_float(rr_[0]) + __uint_as_float(rr_[1]); }
  if (hi == 0) li_l[r32] = l_reg; asm volatile("s_waitcnt lgkmcnt(0)" ::: "memory");
  float rli[16];
#pragma unroll
  for (int r = 0; r < 16; ++r) rli[r] = __builtin_amdgcn_rcpf(li_l[crow(r, hi)]);
  __syncthreads();
  store_o_tile<LDO>(o, rli, lds, wid, lane, Ob + (long)(wid * QBLK) * LDO);
#undef SLOAD
#undef SWRITE
#undef SWAIT
#undef RESC
#undef NAMASK
#undef PSM
#undef FSM
}

typedef int v8i_t __attribute__((ext_vector_type(8)));
#define KSWZ8(row, colB) ((row) * 128 + ((colB) ^ ((((row) >> 1) & 7) << 4)))
__device__ __forceinline__ void qkt8(f32x16& p0, f32x16& p1, const char* Ks, const v8i_t* q8, int r32, int hi, float init) {
  for (int r = 0; r < 16; ++r) { p0[r] = init; p1[r] = init; }
#pragma unroll
  for (int s = 0; s < 2; ++s) { const int cb = 64 * s + 32 * hi;
    const u32x4 a00 = *reinterpret_cast<const u32x4*>(Ks + KSWZ8(r32, cb)), a01 = *reinterpret_cast<const u32x4*>(Ks + KSWZ8(r32, cb + 16));
    const u32x4 a10 = *reinterpret_cast<const u32x4*>(Ks + KSWZ8(32 + r32, cb)), a11 = *reinterpret_cast<const u32x4*>(Ks + KSWZ8(32 + r32, cb + 16));
    const v8i_t A0 = {(int)a00.x, (int)a00.y, (int)a00.z, (int)a00.w, (int)a01.x, (int)a01.y, (int)a01.z, (int)a01.w};
    const v8i_t A1 = {(int)a10.x, (int)a10.y, (int)a10.z, (int)a10.w, (int)a11.x, (int)a11.y, (int)a11.z, (int)a11.w};
    p0 = __builtin_amdgcn_mfma_scale_f32_32x32x64_f8f6f4(A0, q8[s], p0, 0, 0, 0, 0, 0, 0);
    p1 = __builtin_amdgcn_mfma_scale_f32_32x32x64_f8f6f4(A1, q8[s], p1, 0, 0, 0, 0, 0, 0); }
}
#define VSWZ8(row, colB) ((row) * 64 + ((colB) ^ ((((row) >> 2) & 3) << 4)))
__device__ __forceinline__ void finishSM_fx8(f32x16& p0, f32x16& p1, float& l_reg, v8i_t& P8) {
  for (int r = 0; r < 16; ++r) p1[r] = __builtin_amdgcn_exp2f(p1[r]);
  float ps = 0; for (int r = 0; r < 16; ++r) ps += p0[r]; for (int r = 0; r < 16; ++r) ps += p1[r];
  l_reg += ps;
#pragma unroll
  for (int i = 0; i < 4; ++i) { int w = 0; w = __builtin_amdgcn_cvt_pk_bf8_f32(p0[4 * i], p0[4 * i + 1], w, false); w = __builtin_amdgcn_cvt_pk_bf8_f32(p0[4 * i + 2], p0[4 * i + 3], w, true); P8[i] = w; }
#pragma unroll
  for (int i = 0; i < 4; ++i) { int w = 0; w = __builtin_amdgcn_cvt_pk_bf8_f32(p1[4 * i], p1[4 * i + 1], w, false); w = __builtin_amdgcn_cvt_pk_bf8_f32(p1[4 * i + 2], p1[4 * i + 3], w, true); P8[4 + i] = w; }
}
__device__ __forceinline__ void pv8(f32x16* o, const char* Vs, const v8i_t P8, int r32, int hi) {
#pragma unroll
  for (int d0 = 0; d0 < 4; ++d0) { const int row = 32 * d0 + r32;
    const u32x4 b0 = *reinterpret_cast<const u32x4*>(Vs + VSWZ8(row, 32 * hi)), b1 = *reinterpret_cast<const u32x4*>(Vs + VSWZ8(row, 32 * hi + 16));
    const v8i_t B = {(int)b0.x, (int)b0.y, (int)b0.z, (int)b0.w, (int)b1.x, (int)b1.y, (int)b1.z, (int)b1.w};
    o[d0] = __builtin_amdgcn_mfma_scale_f32_32x32x64_f8f6f4(P8, B, o[d0], 1  , 0  , 0, 0, 0, 0); }
}
template <int LDQ8, int LDK8, int LDVT, int LDO>
__device__ __forceinline__ void attn_unit_g8(const unsigned char* Q8, const unsigned char* __restrict__ K8h, const unsigned char* __restrict__ V8Th, bf16* Ob, int NT, char* lds,
                                             const float* __restrict__ qnw, const float* __restrict__ knw, int tid_in) {
  int tid_ = tid_in; asm volatile("" : "+v"(tid_));
  const int tid = tid_, wid = __builtin_amdgcn_readfirstlane(tid >> 6), lane = tid & 63, r32 = lane & 31, hi = lane >> 5;
  char* V_lds = lds; char* K_lds = lds + 2 * SHM_V;
  float* ws = (float*)(lds + 2 * SHM_V + 2 * SHM_K) + wid * 64; float* li_l = ws;
  __syncthreads();
  float negMc;
  { float mq = fmaxf(fabsf(qnw[lane]), fabsf(qnw[lane + 64])), mk = fmaxf(fabsf(knw[lane]), fabsf(knw[lane + 64]));
#pragma unroll
    for (int o_ = 1; o_ < 64; o_ <<= 1) { mq = fmaxf(mq, __shfl_xor(mq, o_)); mk = fmaxf(mk, __shfl_xor(mk, o_)); }
    const float M = fminf(11.3137085f * 1.07f * mq * mk, 60.f);
    negMc = __uint_as_float(__builtin_amdgcn_readfirstlane(__float_as_uint(15.0f - M * 1.4426950408889634f))); }
  float l_reg = 0; f32x16 o[4] = {}; v8i_t q8[2];
  { const unsigned char* Qw = Q8 + (long)(wid * QBLK + r32) * LDQ8 + hi * 32;
#pragma unroll
    for (int s = 0; s < 2; ++s) { const u32x4 a = *reinterpret_cast<const u32x4*>(Qw + 64 * s), b = *reinterpret_cast<const u32x4*>(Qw + 64 * s + 16);
      q8[s] = (v8i_t){(int)a.x, (int)a.y, (int)a.z, (int)a.w, (int)b.x, (int)b.y, (int)b.z, (int)b.w}; } }
  const int kr = tid >> 3, kc = (tid & 7) * 16, kst = KSWZ8(kr, kc);
  const int vr = tid >> 2, vc = (tid & 3) * 16, vst = VSWZ8(vr, vc);
  u32x4 vs, ks;
  unsigned vo = (unsigned)(vr * LDVT + vc), ko = (unsigned)(kr * LDK8 + kc);
#define SLOAD(k0) do { vs = *reinterpret_cast<const u32x4*>(V8Th + vo); ks = *reinterpret_cast<const u32x4*>(K8h + ko); vo += KVBLK; ko += KVBLK * LDK8; asm volatile("" : "+v"(vo), "+v"(ko)); } while (0)
#define SWRITE(b) do { *(u32x4*)(V_lds + (b) * SHM_V + vst) = vs; *(u32x4*)(K_lds + (b) * SHM_K + kst) = ks; } while (0)
#define SWAIT() asm volatile("s_waitcnt vmcnt(0)" ::: "memory")
  f32x16 pA0, pA1, pB0, pB1; v8i_t P8;
#define SWRITE4(b) do { *(u32x4*)(V_lds + (b) * 8192 + vst) = vs; *(u32x4*)(K_lds + (b) * 8192 + kst) = ks; } while (0)
#define STEP(PN0, PN1, PO0, PO1, KB, VB, WB, JJ, LOADS) do { \
    SBAR(); qkt8(PN0, PN1, K_lds + (KB) * 8192, q8, r32, hi, negMc); \
    finishSM_fx8(PO0, PO1, l_reg, P8); SBAR(); \
    if (LOADS) SLOAD(((JJ) + 2) * KVBLK); SBAR(); \
    pv8(o, V_lds + (VB) * 8192, P8, r32, hi); partialSM_fx(PN0, PN1, negMc); \
    __syncthreads(); if (LOADS) { SWAIT(); SWRITE4(WB); } } while (0)
  SLOAD(0); SWAIT(); SWRITE4(0);
  SLOAD(KVBLK); SWAIT(); SWRITE4(1); __syncthreads();
  SLOAD(2 * KVBLK);
  qkt8(pA0, pA1, K_lds, q8, r32, hi, negMc); partialSM_fx(pA0, pA1, negMc);
  SWAIT(); SWRITE4(2);
  int j = 1;
  for (; j + 5 < NT; j += 4) {
    STEP(pB0, pB1, pA0, pA1, 1, 0, 3, j, true);
    STEP(pA0, pA1, pB0, pB1, 2, 1, 0, j + 1, true);
    STEP(pB0, pB1, pA0, pA1, 3, 2, 1, j + 2, true);
    STEP(pA0, pA1, pB0, pB1, 0, 3, 2, j + 3, true);
  }
  STEP(pB0, pB1, pA0, pA1, 1, 0, 3, j, true);
  STEP(pA0, pA1, pB0, pB1, 2, 1, 0, j + 1, false);
  SBAR(); qkt8(pB0, pB1, K_lds + 3 * 8192, q8, r32, hi, negMc);
  finishSM_fx8(pA0, pA1, l_reg, P8); SBAR();
  pv8(o, V_lds + 2 * 8192, P8, r32, hi); partialSM_fx(pB0, pB1, negMc);
  finishSM_fx8(pB0, pB1, l_reg, P8); SBAR();
  pv8(o, V_lds + 3 * 8192, P8, r32, hi);
#undef STEP
#undef SWRITE4
  { auto rr_ = __builtin_amdgcn_permlane32_swap(__float_as_uint(l_reg), __float_as_uint(l_reg), false, false); l_reg = __uint_as_float(rr_[0]) + __uint_as_float(rr_[1]); }
  if (hi == 0) li_l[r32] = l_reg; asm volatile("s_waitcnt lgkmcnt(0)" ::: "memory");
  float rli[16];
#pragma unroll
  for (int r = 0; r < 16; ++r) rli[r] = __builtin_amdgcn_rcpf(li_l[crow(r, hi)]);
  __syncthreads();
  store_o_tile<LDO>(o, rli, lds, wid, lane, Ob + (long)(wid * QBLK) * LDO);
#undef SLOAD
#undef SWRITE
#undef SWAIT
}
#undef SBAR
}
namespace cg = cooperative_groups;
#define LAS __attribute__((address_space(3)))
typedef unsigned short bf16_t;
typedef float f32x4 __attribute__((ext_vector_type(4)));
typedef unsigned v4u __attribute__((ext_vector_type(4)));
typedef unsigned v2u __attribute__((ext_vector_type(2)));
constexpr int SEQ = 16384, DM = 2048, DIN = 8704, DFF = 5632, NMOD = 6 * DM;
constexpr float NORM_EPS = 1e-6f;
constexpr size_t MiB = 1u << 20;
constexpr size_t WS_MOD = 0, CTL_ZERO_BYTES = 64 * 1024;
constexpr size_t WS_ROPE = 1 * MiB;
using pg8::PH; using pg8::PA; using pg8::PKV; using pg8::PNB;
constexpr size_t WS_WIN = 2 * MiB, WS_WO = 39 * MiB, WS_WOUT = 48 * MiB, WS_WGU = 57 * MiB, WS_WD = 104 * MiB;
constexpr size_t WS_H = 128 * MiB;
constexpr size_t WS_Q8 = WS_H, WS_K8 = WS_H + 16 * MiB, WS_V8T = WS_H + 20 * MiB;
constexpr size_t WS_QAB = 196 * MiB, WS_KVA = 264 * MiB, WS_KB = 284 * MiB, WS_VB = 320 * MiB, WS_GA = 356 * MiB, WS_GB = 424 * MiB, WS_END = 492 * MiB;
constexpr size_t WS_ACT = 196 * MiB;
static_assert(WS_WIN + (size_t)DIN * PH * 2 <= WS_WO && WS_WO + (size_t)DM * PH * 2 <= WS_WOUT && WS_WOUT + (size_t)DM * PH * 2 <= WS_WGU && WS_WGU + (size_t)2 * DFF * PH * 2 <= WS_WD && WS_WD + (size_t)DM * PA * 2 <= WS_H, "weight map");
static_assert(WS_H + (size_t)SEQ * PH * 2 <= WS_QAB && WS_QAB + (size_t)SEQ * PH * 2 <= WS_KVA && WS_KVA + (size_t)SEQ * PKV * 2 <= WS_KB && WS_KB + (size_t)SEQ * PNB * 2 <= WS_VB && WS_VB + (size_t)SEQ * PNB * 2 <= WS_GA &&
              WS_GA + (size_t)SEQ * PH * 2 <= WS_GB && WS_GB + (size_t)SEQ * PH * 2 <= WS_END && WS_ACT + (size_t)SEQ * PA * 2 <= WS_GB && WS_V8T + 4 * MiB <= WS_QAB, "activation map");
constexpr size_t WS_BAR = 49152;
constexpr int LDS_BYTES = 147456, LDS_MISC = 131072;
constexpr int NPHASE = 11;
#ifndef GEMM_SP2
#define GEMM_SP2 true
#endif
#ifndef GEMM_ALIGN
#define GEMM_ALIGN true
#endif
#ifndef GATT_SD
#define GATT_SD 1
#endif
#ifndef STAGGER_SLEEPS
#define STAGGER_SLEEPS 7
#endif

__device__ __forceinline__ unsigned f2bf(float f) { unsigned u = __builtin_bit_cast(unsigned, f); return (u + 0x7fffu + ((u >> 16) & 1u)) >> 16; }
__device__ __forceinline__ unsigned pk2(float lo, float hi) { return f2bf(lo) | (f2bf(hi) << 16); }
__device__ __forceinline__ float wave_sum(float v) {
#pragma unroll
    for (int o = 1; o < 64; o <<= 1) v += __shfl_xor(v, o);
    return v;
}
__device__ __forceinline__ void transpose_item(const float* __restrict__ W, int N, bf16_t* __restrict__ WT, int ldt, int koff, int mode, LAS float* scr, int item, int lane) {
    const int nblk = N / 32, kb = item / nblk, nb = item % nblk, k0 = 64 * kb, n0 = 32 * nb;
    const int drow0 = mode == 0 ? n0 : ((n0 >> 7) * 256 + (n0 & 127) + (mode == 2 ? 128 : 0));
#pragma unroll 8
    for (int i = 0; i < 32; ++i) { const int kk = 2 * i + (lane >> 5); scr[kk * 33 + (lane & 31)] = W[(size_t)(k0 + kk) * N + n0 + (lane & 31)]; }
    asm volatile("s_waitcnt lgkmcnt(0)" ::: "memory");
    const int c = lane & 7;
#pragma unroll
    for (int j = 0; j < 4; ++j) { const int n = (lane >> 3) + 8 * j; const LAS float* s = scr + (8 * c) * 33 + n;
        v4u o; o.x = pk2(s[0 * 33], s[1 * 33]); o.y = pk2(s[2 * 33], s[3 * 33]); o.z = pk2(s[4 * 33], s[5 * 33]); o.w = pk2(s[6 * 33], s[7 * 33]);
        *(v4u*)(WT + (size_t)(drow0 + n) * ldt + koff + k0 + 8 * c) = o; }
    asm volatile("s_waitcnt lgkmcnt(0)" ::: "memory");
}
__device__ __forceinline__ void gemv_item(const float* __restrict__ cvec, const float* __restrict__ w_ada, const float* __restrict__ b_ada, float* mod, int item, int lane) {
    const int kc = item / 48, jc = item % 48, col = jc * 256 + 4 * lane;
    f32x4 acc = {0.f, 0.f, 0.f, 0.f};
#pragma unroll 8
    for (int kk = 0; kk < 32; ++kk) { const int k = kc * 32 + kk; const float cv = cvec[k]; const float s = cv / (1.f + expf(-cv));
        const f32x4 w = *(const f32x4*)(w_ada + (size_t)k * NMOD + col); acc += w * s; }
    if (kc == 0) acc += *(const f32x4*)(b_ada + col);
#pragma unroll
    for (int e = 0; e < 4; ++e) __hip_atomic_fetch_add(mod + col + e, acc[e], __ATOMIC_RELAXED, __HIP_MEMORY_SCOPE_AGENT);
}
__device__ __forceinline__ void normmod_rows(const float* X, const float* __restrict__ nw, const float* __restrict__ sc, const float* __restrict__ sh, bf16_t* __restrict__ H, int gw, int NGW, int mend, int lane) {
    f32x4 a[8], b[8];
#pragma unroll
    for (int j = 0; j < 8; ++j) { const int col = 4 * lane + 256 * j; const f32x4 w = *(const f32x4*)(nw + col), s = *(const f32x4*)(sc + col); a[j] = w * (s + 1.0f); b[j] = *(const f32x4*)(sh + col); }
    for (int m = gw; m < mend; m += NGW) {
        const f32x4* xr = (const f32x4*)(X + (size_t)m * DM) + lane; f32x4 v[8]; float ss = 0.f;
#pragma unroll
        for (int j = 0; j < 8; ++j) { v[j] = xr[64 * j]; ss += (v[j].x * v[j].x + v[j].y * v[j].y) + (v[j].z * v[j].z + v[j].w * v[j].w); }
        const float rstd = rsqrtf(wave_sum(ss) * (1.0f / DM) + NORM_EPS);
        v2u* o8 = (v2u*)(H + (size_t)m * PH) + lane;
#pragma unroll
        for (int j = 0; j < 8; ++j) { const f32x4 y = v[j] * rstd * a[j] + b[j]; v2u w; w.x = pk2(y.x, y.y); w.y = pk2(y.z, y.w);
            o8[64 * j] = w; }
    }
}
__device__ __forceinline__ f32x4 bf4(v2u w) { f32x4 r; r.x = __uint_as_float(w.x << 16); r.y = __uint_as_float(w.x & 0xffff0000u); r.z = __uint_as_float(w.y << 16); r.w = __uint_as_float(w.y & 0xffff0000u); return r; }
__device__ __forceinline__ void normmod_rows_d(const float* __restrict__ X, const bf16_t* __restrict__ D1, const float* __restrict__ nw, const float* __restrict__ sc, const float* __restrict__ sh, bf16_t* __restrict__ H, int gw, int NGW, int mend, int lane) {
    f32x4 a[8], b[8];
#pragma unroll
    for (int j = 0; j < 8; ++j) { const int col = 4 * lane + 256 * j; const f32x4 w = *(const f32x4*)(nw + col), s = *(const f32x4*)(sc + col); a[j] = w * (s + 1.0f); b[j] = *(const f32x4*)(sh + col); }
    for (int m = gw; m < mend; m += NGW) {
        const f32x4* xr = (const f32x4*)(X + (size_t)m * DM) + lane; const v2u* dr = (const v2u*)(D1 + (size_t)m * PH) + lane; f32x4 v[8]; float ss = 0.f;
#pragma unroll
        for (int j = 0; j < 8; ++j) { v[j] = xr[64 * j] + bf4(dr[64 * j]); ss += (v[j].x * v[j].x + v[j].y * v[j].y) + (v[j].z * v[j].z + v[j].w * v[j].w); }
        const float rstd = rsqrtf(wave_sum(ss) * (1.0f / DM) + NORM_EPS);
        v2u* o8 = (v2u*)(H + (size_t)m * PH) + lane;
#pragma unroll
        for (int j = 0; j < 8; ++j) { const f32x4 y = v[j] * rstd * a[j] + b[j]; v2u w; w.x = pk2(y.x, y.y); w.y = pk2(y.z, y.w); o8[64 * j] = w; }
    }
}
__device__ __forceinline__ void final_rows_d(const float* __restrict__ X, const bf16_t* __restrict__ D1, const bf16_t* __restrict__ D2, float* __restrict__ OUT, const float* __restrict__ fw, int gw, int NGW, int mend, int lane) {
    f32x4 a[8];
#pragma unroll
    for (int j = 0; j < 8; ++j) a[j] = *(const f32x4*)(fw + 4 * lane + 256 * j);
    for (int m = gw; m < mend; m += NGW) {
        const f32x4* xr = (const f32x4*)(X + (size_t)m * DM) + lane; const v2u* d1 = (const v2u*)(D1 + (size_t)m * PH) + lane; const v2u* d2 = (const v2u*)(D2 + (size_t)m * PH) + lane; f32x4 v[8]; float ss = 0.f;
#pragma unroll
        for (int j = 0; j < 8; ++j) { v[j] = (xr[64 * j] + bf4(d1[64 * j])) + bf4(d2[64 * j]); ss += (v[j].x * v[j].x + v[j].y * v[j].y) + (v[j].z * v[j].z + v[j].w * v[j].w); }
        const float rstd = rsqrtf(wave_sum(ss) * (1.0f / DM) + NORM_EPS);
        f32x4* orow = (f32x4*)(OUT + (size_t)m * DM) + lane;
#pragma unroll
        for (int j = 0; j < 8; ++j) orow[64 * j] = v[j] * rstd * a[j];
    }
}
__device__ __forceinline__ void final_rows(float* X, const float* __restrict__ fw, int gw, int NGW, int lane) {
    f32x4 a[8];
#pragma unroll
    for (int j = 0; j < 8; ++j) a[j] = *(const f32x4*)(fw + 4 * lane + 256 * j);
    for (int m = gw; m < SEQ; m += NGW) {
        f32x4* xr = (f32x4*)(X + (size_t)m * DM) + lane; f32x4 v[8]; float ss = 0.f;
#pragma unroll
        for (int j = 0; j < 8; ++j) { v[j] = xr[64 * j]; ss += (v[j].x * v[j].x + v[j].y * v[j].y) + (v[j].z * v[j].z + v[j].w * v[j].w); }
        const float rstd = rsqrtf(wave_sum(ss) * (1.0f / DM) + NORM_EPS);
#pragma unroll
        for (int j = 0; j < 8; ++j) xr[64 * j] = v[j] * rstd * a[j];
    }
}
__device__ __forceinline__ void qknorm_rope(bf16_t* QAB, bf16_t* KVA, unsigned char* __restrict__ Q8, unsigned char* __restrict__ K8, const float* __restrict__ qn, const float* __restrict__ kn, const float* __restrict__ tab, int it0, int its, int ite, int lane) {
    const int li = lane & 15;
    for (int it = it0 + (lane >> 4); it < ite; it += its) {
        const int t = it / 10, hs = it - t * 10;
        bf16_t* p = (hs < 8 ? QAB + (size_t)t * PH + hs * 128 : KVA + (size_t)t * PKV + (hs - 8) * 128) + 8 * li;
        const float* wn = (hs < 8 ? qn : kn) + 8 * li;
        const v4u raw = *(const v4u*)p; float x[8];
#pragma unroll
        for (int e = 0; e < 4; ++e) { x[2 * e] = __uint_as_float(raw[e] << 16); x[2 * e + 1] = __uint_as_float(raw[e] & 0xffff0000u); }
        float ss = 0.f;
#pragma unroll
        for (int e = 0; e < 8; ++e) ss += x[e] * x[e];
        ss += __shfl_xor(ss, 1); ss += __shfl_xor(ss, 2); ss += __shfl_xor(ss, 4); ss += __shfl_xor(ss, 8);
        const float rstd = rsqrtf(ss * (1.0f / 128.0f) + NORM_EPS) * (hs < 8 ? 0.088388347648318440f * 1.4426950408889634f : 1.0f);
        const f32x4 w0 = *(const f32x4*)wn, w1 = *(const f32x4*)(wn + 4);
        const float wv[8] = {w0.x, w0.y, w0.z, w0.w, w1.x, w1.y, w1.z, w1.w};
        const int row = t >> 6, col = t & 63;
        const float* cs = tab + 2 * (li < 8 ? (row * 32 + 4 * li) : ((256 + col) * 32 + 4 * (li - 8)));
        const f32x4 c0 = *(const f32x4*)cs, c1 = *(const f32x4*)(cs + 4);
        const float cv[4] = {c0.x, c0.z, c1.x, c1.z}, sv[4] = {c0.y, c0.w, c1.y, c1.w};
        float r8[8];
#pragma unroll
        for (int e = 0; e < 4; ++e) { const float y0 = x[2 * e] * rstd * wv[2 * e], y1 = x[2 * e + 1] * rstd * wv[2 * e + 1];
            r8[2 * e] = y0 * cv[e] - y1 * sv[e]; r8[2 * e + 1] = y0 * sv[e] + y1 * cv[e]; }
        int pw0 = 0, pw1 = 0;
        pw0 = __builtin_amdgcn_cvt_pk_fp8_f32(r8[0], r8[1], pw0, false); pw0 = __builtin_amdgcn_cvt_pk_fp8_f32(r8[2], r8[3], pw0, true);
        pw1 = __builtin_amdgcn_cvt_pk_fp8_f32(r8[4], r8[5], pw1, false); pw1 = __builtin_amdgcn_cvt_pk_fp8_f32(r8[6], r8[7], pw1, true);
        unsigned char* d8 = (hs < 8 ? Q8 + (size_t)t * 1024 + hs * 128 : K8 + (size_t)t * 256 + (hs - 8) * 128) + 8 * li;
        v2u o8; o8.x = (unsigned)pw0; o8.y = (unsigned)pw1; *(v2u*)d8 = o8;
    }
}

#define XB_TMO      128
#define XB_XCNT(j)  (256  + 64 * (j))
#define XB_XSUB(j)  (1280 + 64 * (j))
#define XB_XGEN(j)  (2304 + 64 * (j))
#define XB_TOP      3328
#define XB_TOPGEN   3392
#define XCD_BAR_WORDS 3456
#define XB_SPIN_CAP (1u << 18)

__device__ __forceinline__ unsigned xb_ld(unsigned* p)              { return __hip_atomic_load(p, __ATOMIC_RELAXED, __HIP_MEMORY_SCOPE_AGENT); }
__device__ __forceinline__ unsigned xb_add(unsigned* p, unsigned v) { return __hip_atomic_fetch_add(p, v, __ATOMIC_RELAXED, __HIP_MEMORY_SCOPE_AGENT); }
__device__ __forceinline__ unsigned xb_xcc_id() { return (unsigned)__builtin_amdgcn_s_getreg((3 << 11) | 20) & 0xFu; }
#define XB_SPIN(cond, bar) do { unsigned _sp = 0; while (cond) { __builtin_amdgcn_s_sleep(1); \
    if ((++_sp & 255u) == 0u) { if (xb_ld(&(bar)[XB_TMO])) break; if (_sp > XB_SPIN_CAP) { atomicAdd(&(bar)[XB_TMO], 1u); break; } } } } while (0)

struct XcdBarrier {
    unsigned* bar; unsigned x;
    volatile LAS unsigned* st;
};

__device__ __forceinline__ XcdBarrier xcd_barrier_post(unsigned* bar, volatile LAS unsigned* st) {
    XcdBarrier b; b.bar = bar; b.x = xb_xcc_id(); b.st = st;
    if (threadIdx.x == 0) st[2] = xb_add(&bar[XB_XCNT(b.x)], 1u);
    return b;
}
__device__ __forceinline__ void xcd_barrier_complete(unsigned* bar, unsigned x, unsigned& nloc, unsigned& nx) {
    const unsigned G = gridDim.x * gridDim.y * gridDim.z;
    unsigned sum, cnt, mine, sp = 0u;
    for (;;) {
        sum = 0u; cnt = 0u; mine = 0u;
#pragma unroll
        for (unsigned j = 0; j < 16; ++j) { const unsigned c = xb_ld(&bar[XB_XCNT(j)]); sum += c; cnt += (c > 0u) ? 1u : 0u; mine = (j == x) ? c : mine; }
        if (sum == G) break;
        __builtin_amdgcn_s_sleep(1);
        if ((++sp & 255u) == 0u) { if (xb_ld(&bar[XB_TMO])) break; if (sp > XB_SPIN_CAP) { atomicAdd(&bar[XB_TMO], 1u); break; } }
    }
    nloc = mine > 0u ? mine : 1u; nx = cnt > 0u ? cnt : 1u;
}

__device__ __forceinline__ void xcd_barrier(const XcdBarrier& b, int tid_) {
    asm volatile("s_waitcnt vmcnt(0)" ::: "memory");
    __syncthreads();
    if (tid_ == 0) {
        unsigned* bar = b.bar;
        __builtin_amdgcn_s_waitcnt(0);
        unsigned nloc = b.st[0], nx = b.st[1];
        if (nloc == 0u) { xcd_barrier_complete(bar, b.x, nloc, nx); b.st[0] = nloc; b.st[1] = nx; }
        const unsigned old = xb_add(&bar[XB_XSUB(b.x)], 1u);
        const unsigned gen = old / nloc;
        if (old + 1u == (gen + 1u) * nloc) {
            __builtin_amdgcn_fence(__ATOMIC_RELEASE, "agent");
            asm volatile("s_waitcnt vmcnt(0)" ::: "memory");
            const unsigned og = xb_add(&bar[XB_TOP], 1u);
            const unsigned tg = og / nx;
            if (og + 1u == (tg + 1u) * nx) xb_add(&bar[XB_TOPGEN], 1u);
            else XB_SPIN(xb_ld(&bar[XB_TOPGEN]) == tg, bar);
            __builtin_amdgcn_fence(__ATOMIC_ACQUIRE, "agent");
            xb_add(&bar[XB_XGEN(b.x)], 1u);
            asm volatile("s_waitcnt vmcnt(0)" ::: "memory");
        } else {
            XB_SPIN(xb_ld(&bar[XB_XGEN(b.x)]) == gen, bar);
            __builtin_amdgcn_fence(__ATOMIC_ACQUIRE, "agent");
            asm volatile("s_waitcnt vmcnt(0)" ::: "memory");
        }
    }
    __syncthreads();
}
#define XB_LSUB(j) (3456 + 16 * (j))
#define XB_LGEN(j) (3712 + 16 * (j))
__device__ __forceinline__ void xcd_barrier_local(const XcdBarrier& b, int tid_) {
    asm volatile("s_waitcnt vmcnt(0)" ::: "memory");
    __syncthreads();
    if (tid_ == 0) {
        unsigned* bar = b.bar;
        __builtin_amdgcn_s_waitcnt(0);
        const unsigned nloc = b.st[0];
        const unsigned old = xb_add(&bar[XB_LSUB(b.x)], 1u);
        const unsigned gen = old / nloc;
        if (old + 1u == (gen + 1u) * nloc) xb_add(&bar[XB_LGEN(b.x)], 1u);
        else XB_SPIN(xb_ld(&bar[XB_LGEN(b.x)]) == gen, bar);
        __builtin_amdgcn_fence(__ATOMIC_ACQUIRE, "agent");
        asm volatile("s_waitcnt vmcnt(0)" ::: "memory");
    }
    __syncthreads();
}
__device__ __forceinline__ void v8t_item(const bf16_t* __restrict__ KVA, unsigned char* __restrict__ V8T, int item, LAS unsigned char* scr, int lane) {
    const int kvh = item >> 8, T = item & 255;
    const bf16_t* src = KVA + (size_t)(64 * T) * PKV + 256 + kvh * 128;
#pragma unroll 4
    for (int i = 0; i < 16; ++i) { const int key = 4 * i + (lane >> 4), c0 = 8 * (lane & 15);
        const v4u raw = *(const v4u*)(src + (size_t)key * PKV + c0);
        int w0 = 0, w1 = 0;
        w0 = __builtin_amdgcn_cvt_pk_fp8_f32(__uint_as_float(raw.x << 16), __uint_as_float(raw.x & 0xffff0000u), w0, false); w0 = __builtin_amdgcn_cvt_pk_fp8_f32(__uint_as_float(raw.y << 16), __uint_as_float(raw.y & 0xffff0000u), w0, true);
        w1 = __builtin_amdgcn_cvt_pk_fp8_f32(__uint_as_float(raw.z << 16), __uint_as_float(raw.z & 0xffff0000u), w1, false); w1 = __builtin_amdgcn_cvt_pk_fp8_f32(__uint_as_float(raw.w << 16), __uint_as_float(raw.w & 0xffff0000u), w1, true);
        const int kq = key & 31, pos = 32 * ((kq >> 2) & 1) + 16 * (key >> 5) + (kq & 3) + 4 * (kq >> 3);
        LAS unsigned char* d = scr + c0 * 68 + pos;
        d[0 * 68] = (unsigned char)(w0); d[1 * 68] = (unsigned char)(w0 >> 8); d[2 * 68] = (unsigned char)(w0 >> 16); d[3 * 68] = (unsigned char)(w0 >> 24);
        d[4 * 68] = (unsigned char)(w1); d[5 * 68] = (unsigned char)(w1 >> 8); d[6 * 68] = (unsigned char)(w1 >> 16); d[7 * 68] = (unsigned char)(w1 >> 24); }
    asm volatile("s_waitcnt lgkmcnt(0)" ::: "memory");
#pragma unroll
    for (int i = 0; i < 8; ++i) { const int idx = lane + 64 * i, col = idx >> 2, ch = idx & 3; const LAS unsigned* s4 = (const LAS unsigned*)(scr + col * 68 + ch * 16);
        v4u w; w.x = s4[0]; w.y = s4[1]; w.z = s4[2]; w.w = s4[3];
        *(v4u*)(V8T + (size_t)(kvh * 128 + col) * 16384 + 64 * T + ch * 16) = w; }
    asm volatile("s_waitcnt lgkmcnt(0)" ::: "memory");
}
struct Args { const float* in[17]; float* out; unsigned char* ws; int ph_lo, ph_hi; };
__global__ void __launch_bounds__(512) fwd(Args args) {
    extern __shared__ __attribute__((aligned(16))) unsigned char lds[];
    cg::grid_group grid = cg::this_grid();
    const int tid0 = threadIdx.x;
    const int G0 = gridDim.x, bx0 = blockIdx.x;
    const int lo = args.ph_lo, hi = args.ph_hi;
    const int wave0 = __builtin_amdgcn_readfirstlane(tid0 >> 6);
    if (hi > 1000) grid.sync();
    volatile LAS unsigned* bst = (volatile LAS unsigned*)((LAS unsigned char*)lds + LDS_MISC);
    if (tid0 < 4) bst[tid0] = tid0 == 3 ? 0xFFFFFFFFu : 0u;
    __syncthreads();
    const XcdBarrier bar = xcd_barrier_post((unsigned*)(args.ws + WS_BAR), bst);
#ifndef PHASE_MASK
#define PHASE_MASK 0x7ff
#endif
#define IN(k) (((PHASE_MASK >> (k)) & 1) && lo <= (k) && (k) < hi)
#define SEAM(k) do { if (IN(k) && IN((k) + 1)) { const int t_ = wave0 * 64 + (int)__builtin_amdgcn_mbcnt_hi(~0u, __builtin_amdgcn_mbcnt_lo(~0u, 0u)); xcd_barrier(bar, t_); } } while (0)
#define SEAML(k) do { if (IN(k) && IN((k) + 1)) { const int t_ = wave0 * 64 + (int)__builtin_amdgcn_mbcnt_hi(~0u, __builtin_amdgcn_mbcnt_lo(~0u, 0u)); if (bst[3] != 0xFFFFFFFFu) xcd_barrier_local(bar, t_); else xcd_barrier(bar, t_); } } while (0)
    typedef const __attribute__((address_space(4))) Args* ArgP;
#define ARGP() ({ ArgP p_ = (ArgP)__builtin_amdgcn_kernarg_segment_ptr(); asm volatile("" : "+s"(p_)); p_; })
#define WSP(off, T) ((T*)(A->ws + (off)))
#define OPQ() int G = G0, bx = bx0; asm volatile("" : "+s"(G), "+s"(bx)); int tid = wave0 * 64 + (int)__builtin_amdgcn_mbcnt_hi(~0u, __builtin_amdgcn_mbcnt_lo(~0u, 0u)); asm volatile("" : "+v"(tid)); const int lane = tid & 63, wave = __builtin_amdgcn_readfirstlane(tid >> 6), gw = bx * 8 + wave, NGW = G * 8; (void)gw; (void)NGW; (void)lane; const unsigned vm_ = bst[3]; const bool g8_ = (G & 7) == 0; const int vbx = (vm_ != 0xFFFFFFFFu) ? (int)__builtin_amdgcn_readfirstlane(vm_) : bx; const int cls = vbx & 7, rnk = vbx >> 3; (void)cls; (void)rnk; const int rw0 = g8_ ? cls * (SEQ / 8) + rnk * 8 + wave : gw, rws = g8_ ? G : NGW, rwe = g8_ ? (cls + 1) * (SEQ / 8) : SEQ; (void)rw0; (void)rws; (void)rwe

    if (IN(0)) { ArgP A = ARGP(); OPQ();
        const float* cvec = A->in[1]; const float* w_ada = A->in[2]; const float* b_ada = A->in[3]; const float* w_in = A->in[5]; const float* w_oa = A->in[9]; const float* w_ob = A->in[10];
        const float* w_out = A->in[11]; const float* w_g = A->in[13]; const float* w_u = A->in[14]; const float* w_d = A->in[15]; float* mod = WSP(WS_MOD, float); float* tab = WSP(WS_ROPE, float);
        bf16_t* WinT = WSP(WS_WIN, bf16_t); bf16_t* WoT = WSP(WS_WO, bf16_t); bf16_t* WoutT = WSP(WS_WOUT, bf16_t); bf16_t* WguT = WSP(WS_WGU, bf16_t); bf16_t* WdT = WSP(WS_WD, bf16_t);
        LAS float* scr = (LAS float*)((LAS unsigned char*)lds + wave * 16384);
        constexpr int I_GEMV = 64 * 48, I_IN = (DM / 64) * (DIN / 32), I_OA = (1024 / 64) * (DM / 32), I_OUT = (DM / 64) * (DM / 32), I_G = (DM / 64) * (DFF / 32), I_D = (DFF / 64) * (DM / 32);
        constexpr int NITEMS = I_GEMV + I_IN + 2 * I_OA + I_OUT + I_D;
        for (int it = gw; it < NITEMS; it += NGW) {
            int r = it;
            if (r < I_GEMV) { gemv_item(cvec, w_ada, b_ada, mod, r, lane); continue; } r -= I_GEMV;
            if (r < I_IN) { transpose_item(w_in, DIN, WinT, PH, 0, 0, scr, r, lane); continue; } r -= I_IN;
            if (r < I_OA) { transpose_item(w_oa, DM, WoT, PH, 0, 0, scr, r, lane); continue; } r -= I_OA;
            if (r < I_OA) { transpose_item(w_ob, DM, WoT, PH, 1024, 0, scr, r, lane); continue; } r -= I_OA;
            if (r < I_OUT) { transpose_item(w_out, DM, WoutT, PH, 0, 0, scr, r, lane); continue; } r -= I_OUT;
            transpose_item(w_d, DM, WdT, PA, 0, 0, scr, r, lane);
        }
        for (int e = bx * 512 + tid; e < 320 * 32; e += G * 512) { const int pos = e >> 5, j = e & 31; const float p = (float)(pos < 256 ? pos : pos - 256);
            const float inv = powf(10000.0f, -(float)(2 * j) / 64.0f); const float ang = p * inv; tab[2 * e] = cosf(ang); tab[2 * e + 1] = sinf(ang);
        }
    }
    SEAM(0);
    if (IN(0) && IN(1)) {
        const int t_ = wave0 * 64 + (int)__builtin_amdgcn_mbcnt_hi(~0u, __builtin_amdgcn_mbcnt_lo(~0u, 0u));
        if (t_ == 0) { unsigned nx_ = 0u, below_ = 0u, ok_ = ((G0 & 7) == 0) ? 1u : 0u; const unsigned per_ = (unsigned)G0 >> 3;
#pragma unroll
            for (unsigned j_ = 0; j_ < 16; ++j_) { const unsigned c_ = xb_ld(&bar.bar[XB_XCNT(j_)]); if (c_) { ++nx_; if (c_ != per_) ok_ = 0u; if (j_ < bar.x) ++below_; } }
            const unsigned rk_ = bst[2];
            bst[3] = (ok_ && nx_ == 8u && rk_ < per_) ? (rk_ * 8u + below_) : 0xFFFFFFFFu; }
        __syncthreads();
    }
    if (IN(1)) { ArgP A = ARGP(); OPQ(); float* mod = WSP(WS_MOD, float); normmod_rows(A->in[0], A->in[4], mod + 2048, mod + 0, WSP(WS_H, bf16_t), rw0, rws, rwe, lane); }
    SEAML(1);
    if (IN(2)) { ArgP A = ARGP(); OPQ();
        pg8::Gemm g{WSP(WS_H, bf16_t), WSP(WS_WIN, bf16_t), SEQ, DIN, DM, PH}; pg8::StaticOrder S; S.init(SEQ, DIN, G, vbx);
        pg8::EpiProj E{WSP(WS_QAB, bf16_t), WSP(WS_KVA, bf16_t), WSP(WS_KB, bf16_t), WSP(WS_VB, bf16_t), WSP(WS_GA, bf16_t), WSP(WS_GB, bf16_t)};
        pg8::gemm_phase<pg8::EpiProj, pg8::StaticOrder, GEMM_ALIGN, GEMM_SP2, false>((LAS unsigned char*)lds, g, S, E, tid);
        {
            const int first = S.nwg % G;
            if (vbx >= first) {
                constexpr int I_G2 = (DM / 64) * (DFF / 32);
                LAS float* scr = (LAS float*)((LAS unsigned char*)lds + wave * 16384);
                const float* w_g = A->in[13]; const float* w_u = A->in[14]; bf16_t* WguT = WSP(WS_WGU, bf16_t);
                for (int it = (vbx - first) * 8 + wave; it < 2 * I_G2; it += (G - first) * 8) {
                    if (it < I_G2) transpose_item(w_g, DFF, WguT, PH, 0, 1, scr, it, lane); else transpose_item(w_u, DFF, WguT, PH, 0, 2, scr, it - I_G2, lane);
                }
            }
        }
    }
    SEAM(2);
    if (IN(3)) { ArgP A = ARGP(); OPQ();
        if ((wave & 3) == 0) { LAS unsigned char* scr = (LAS unsigned char*)lds + wave * 16384; if (g8_) { for (int tt = rnk; tt < 32; tt += (G >> 3)) v8t_item(WSP(WS_KVA, bf16_t), WSP(WS_V8T, unsigned char), (wave >> 2) * 256 + cls * 32 + tt, scr, lane); }
            else for (int it = bx * 2 + (wave >> 2); it < 512; it += G * 2) v8t_item(WSP(WS_KVA, bf16_t), WSP(WS_V8T, unsigned char), it, scr, lane); }
        qknorm_rope(WSP(WS_QAB, bf16_t), WSP(WS_KVA, bf16_t), WSP(WS_Q8, unsigned char), WSP(WS_K8, unsigned char), A->in[6], A->in[7], WSP(WS_ROPE, float), g8_ ? cls * (SEQ / 8) * 10 + (rnk * 8 + wave) * 4 : gw * 4, g8_ ? G * 4 : NGW * 4, g8_ ? (cls + 1) * (SEQ / 8) * 10 : SEQ * 10, lane); }
    SEAM(3);
    if (IN(4)) { ArgP A = ARGP(); OPQ();
        using abf = att::bf16; bf16_t* QAB = WSP(WS_QAB, bf16_t); bf16_t* KVA = WSP(WS_KVA, bf16_t); bf16_t* KB = WSP(WS_KB, bf16_t); bf16_t* VB = WSP(WS_VB, bf16_t); const float* rpb = A->in[8];
        for (int u = bx; u < 512; u += G) { const int h = u >> 6, qb = u & 63, kvh = h >> 2;
            att::attn_unit_g8<1024, 256, 16384, PH>(WSP(WS_Q8, unsigned char) + (size_t)qb * 256 * 1024 + h * 128, WSP(WS_K8, unsigned char) + kvh * 128, WSP(WS_V8T, unsigned char) + (size_t)kvh * 128 * 16384,
                                                    (abf*)QAB + (size_t)qb * 256 * PH + h * 128, SEQ / 64, (char*)lds, A->in[6], A->in[7], tid);
        }
        for (int v = bx; v < 512; v += G) { const int h = v >> 6, qb = v & 63; int r_lo = 4 * qb - 4; r_lo = r_lo < 0 ? 0 : (r_lo > 244 ? 244 : r_lo);
            att::attn_unit<PH, PNB, PH, true, 1, 0>((const abf*)QAB + (size_t)qb * 256 * PH + 1024 + h * 128, (const abf*)KB + (size_t)r_lo * 64 * PNB + h * 128, (const abf*)VB + (size_t)r_lo * 64 * PNB + h * 128,
                                                   (abf*)QAB + (size_t)qb * 256 * PH + 1024 + h * 128, 12, (char*)lds, rpb + h * 15 * 31, nullptr, 4 * qb, r_lo, tid);
        }
        __syncthreads();
    }
    SEAM(4);
    if (IN(5)) { ArgP A = ARGP(); OPQ();
        pg8::Gemm g{WSP(WS_QAB, bf16_t), WSP(WS_WO, bf16_t), SEQ, DM, DM, PH}; pg8::StaticOrder S; S.init(SEQ, DM, G, vbx);
        pg8::EpiMerged E{WSP(WS_GA, bf16_t), WSP(WS_GB, bf16_t), WSP(WS_H, bf16_t)};
        pg8::gemm_phase<pg8::EpiMerged, pg8::StaticOrder, GEMM_ALIGN, GEMM_SP2, true>((LAS unsigned char*)lds, g, S, E, tid);
    }
    SEAML(5);
    if (IN(6)) { ArgP A = ARGP(); OPQ();
        pg8::Gemm g{WSP(WS_H, bf16_t), WSP(WS_WOUT, bf16_t), SEQ, DM, DM, PH}; pg8::StaticOrder S; S.init(SEQ, DM, G, vbx);
        pg8::EpiDelta E{WSP(WS_GB, bf16_t), WSP(WS_MOD, float) + 4096};
        pg8::gemm_phase<pg8::EpiDelta, pg8::StaticOrder, GEMM_ALIGN, GEMM_SP2, false>((LAS unsigned char*)lds, g, S, E, tid);
    }
    SEAML(6);
    if (IN(7)) { ArgP A = ARGP(); OPQ(); float* mod = WSP(WS_MOD, float); normmod_rows_d(A->in[0], WSP(WS_GB, bf16_t), A->in[12], mod + 8192, mod + 6144, WSP(WS_H, bf16_t), rw0, rws, rwe, lane); }
    SEAM(7);
    if (IN(8)) { ArgP A = ARGP(); OPQ();
        pg8::Gemm g{WSP(WS_H, bf16_t), WSP(WS_WGU, bf16_t), SEQ, 2 * DFF, DM, PH}; pg8::StaticOrder S; S.init(SEQ, 2 * DFF, G, vbx);
        pg8::EpiSwiglu E{WSP(WS_ACT, bf16_t)};
        pg8::gemm_phase<pg8::EpiSwiglu, pg8::StaticOrder, GEMM_ALIGN, GEMM_SP2, false>((LAS unsigned char*)lds, g, S, E, tid);
    }
    SEAML(8);
    if (IN(9)) { ArgP A = ARGP(); OPQ();
        pg8::Gemm g{WSP(WS_ACT, bf16_t), WSP(WS_WD, bf16_t), SEQ, DM, DFF, PA}; pg8::StaticOrder S; S.init(SEQ, DM, G, vbx);
        pg8::EpiDelta E{WSP(WS_H, bf16_t), WSP(WS_MOD, float) + 10240};
        pg8::gemm_phase<pg8::EpiDelta, pg8::StaticOrder, GEMM_ALIGN, GEMM_SP2, false>((LAS unsigned char*)lds, g, S, E, tid);
    }
    SEAML(9);
    if (IN(10)) { ArgP A = ARGP(); OPQ(); final_rows_d(A->in[0], WSP(WS_GB, bf16_t), WSP(WS_H, bf16_t), A->out, A->in[16], rw0, rws, rwe, lane); }
#undef IN
#undef SEAM
}

#ifndef N_LAUNCHES
#define N_LAUNCHES 1
#endif
extern "C" void kernel_launch(void* const* d_in, const int* in_sizes, int n_in, void* d_out, int out_size, void* d_ws, size_t ws_size, hipStream_t stream) {
    static int grid = 0;
    if (grid == 0) {
        if (n_in != 17 || in_sizes[0] != SEQ * DM || out_size != SEQ * DM || ws_size < WS_END) { fprintf(stderr, "kernel_launch: unexpected shapes: n_in %d in0 %d out %d ws %zu (need %zu)\n", n_in, n_in > 0 ? in_sizes[0] : -1, out_size, ws_size, (size_t)WS_END); grid = -1; return; }
        int dev = 0, cus = 0, per_cu = 0;
        if (hipGetDevice(&dev) != hipSuccess || hipDeviceGetAttribute(&cus, hipDeviceAttributeMultiprocessorCount, dev) != hipSuccess) { fprintf(stderr, "kernel_launch: device query failed\n"); grid = -1; return; }
        if (hipFuncSetAttribute((const void*)fwd, hipFuncAttributeMaxDynamicSharedMemorySize, LDS_BYTES) != hipSuccess) { fprintf(stderr, "kernel_launch: hipFuncSetAttribute failed\n"); grid = -1; return; }
        if (hipOccupancyMaxActiveBlocksPerMultiprocessor(&per_cu, (const void*)fwd, 512, LDS_BYTES) != hipSuccess || per_cu < 1) { fprintf(stderr, "kernel_launch: occupancy query says %d\n", per_cu); per_cu = 1; }
        (void)hipGetLastError();
        grid = cus * per_cu;
        fprintf(stderr, "kernel_launch: grid %d (cus %d x %d)\n", grid, cus, per_cu);
    }
    if (grid < 0) return;
    if (hipMemsetAsync((char*)d_ws + WS_MOD, 0, CTL_ZERO_BYTES, stream) != hipSuccess) { fprintf(stderr, "kernel_launch: memset failed\n"); return; }
    Args a{};
    for (int i = 0; i < 17; ++i) a.in[i] = (const float*)d_in[i];
    a.out = (float*)d_out; a.ws = (unsigned char*)d_ws;
    if (N_LAUNCHES == 1) {
        a.ph_lo = 0; a.ph_hi = NPHASE;
        void* kargs[] = {&a};
        const hipError_t e = hipLaunchCooperativeKernel((const void*)fwd, dim3(grid), dim3(512), kargs, LDS_BYTES, stream);
        if (e != hipSuccess) fprintf(stderr, "kernel_launch: cooperative launch failed: %s (grid %d)\n", hipGetErrorString(e), grid);
    } else {
        for (int p = 0; p < NPHASE; ++p) { a.ph_lo = p; a.ph_hi = p + 1;
            hipLaunchKernelGGL(fwd, dim3(grid), dim3(512), LDS_BYTES, stream, a);
            const hipError_t le = hipPeekAtLastError();
            if (le != hipSuccess) { fprintf(stderr, "kernel_launch: launch %d failed: %s\n", p, hipGetErrorName(le)); break; } }
    }
}
```
